# Optimizing an MI355X kernel written in HIP

```python
import math
import jax
import jax.numpy as jnp
from jax import lax
import numpy as np

D_MODEL = 1024
BATCH = 4
SEQ = 4096
DEPTH = 4
DEC_BATCH = 128
DEC_SEQ = 8
PAST_LEN = 8192
PAGE_SIZE = 128

F32 = jnp.float32
N_EVEN = (DEPTH + 1) // 2
N_ODD = DEPTH // 2
PLE_DIM = 256
NORM_EPS = 1e-6
MASK_NEG = -1e30
F_FLOOR = 1e-30
DEEPNORM_ALPHA = (2 * DEPTH) ** 0.25
DEEPNORM_BETA = (8 * DEPTH) ** -0.25

A_HEADS = 4
A_DK = 128
A_DV = 128
A_CONV = 4
A_CHUNK = 64
A_QK = A_HEADS * A_DK
A_VW = A_HEADS * A_DV
A_CONV_CH = 2 * A_QK + A_VW

B_HEADS = 8
B_KV_HEADS = 2
B_HD = 64
B_GROUP = B_HEADS // B_KV_HEADS
B_QW = B_HEADS * B_HD
B_KVW = B_KV_HEADS * B_HD
WINDOW = 128
ROT_DIM = B_HD // 4
ROPE_THETA = 500000.0

OFF_A_GATE = A_CONV_CH
OFF_A_DECAY = OFF_A_GATE + A_VW
OFF_A_BETA = OFF_A_DECAY + A_HEADS
OFF_B_Q = OFF_A_BETA + A_HEADS
OFF_B_K = OFF_B_Q + B_QW
OFF_B_V = OFF_B_K + B_KVW
OFF_B_GATE = OFF_B_V + B_KVW
EVEN_IN = OFF_B_GATE + B_QW
EVEN_SPLITS = (OFF_A_GATE, OFF_A_DECAY, OFF_A_BETA, OFF_B_Q, OFF_B_K, OFF_B_V, OFF_B_GATE)

C_HEADS = 8
C_DK = D_MODEL // C_HEADS
C_DV = D_MODEL // C_HEADS
C_CHUNK = 32
ODD_IN = 4 * D_MODEL

kernel_name = 'hybrid_deltanet_swa_hgrn2_step'


def layer_norm(x, g, b):
    xf = x.astype(F32)
    mu = jnp.mean(xf, -1, keepdims=True)
    xc = xf - mu
    var = jnp.mean(xc * xc, -1, keepdims=True)
    return (xc * lax.rsqrt(var + NORM_EPS) * g.astype(F32) + b.astype(F32)).astype(x.dtype)


def rms_norm(x, g):
    xf = x.astype(F32)
    return (xf * lax.rsqrt(jnp.mean(xf * xf, -1, keepdims=True) + NORM_EPS) * g.astype(F32)).astype(x.dtype)


def l2_normalize(t):
    tf = t.astype(F32)
    return (tf * lax.rsqrt(jnp.sum(tf * tf, -1, keepdims=True) + NORM_EPS)).astype(t.dtype)


def masked_exp(mask, d):
    return jnp.where(mask, jnp.exp(jnp.where(mask, d, 0.0)), 0.0)


def causal_conv(x, buf, w):
    l = x.shape[1]
    xp = jnp.concatenate([buf.astype(x.dtype), x], axis=1)
    y = sum(xp[:, j:j + l] * w[j] for j in range(A_CONV))
    return jax.nn.silu(y), xp[:, xp.shape[1] - (A_CONV - 1):]


def rotary(x, pos):
    inv = ROPE_THETA ** (-jnp.arange(0, ROT_DIM, 2, dtype=F32) / ROT_DIM)
    ang = pos.astype(F32)[:, None] * inv[None, :]
    cos = jnp.cos(ang)[None, :, None, :]
    sin = jnp.sin(ang)[None, :, None, :]
    xf = x.astype(F32)
    x1 = xf[..., :ROT_DIM // 2]
    x2 = xf[..., ROT_DIM // 2:ROT_DIM]
    rot = jnp.concatenate([x1 * cos - x2 * sin, x2 * cos + x1 * sin], -1).astype(x.dtype)
    return jnp.concatenate([rot, x[..., ROT_DIM:]], -1)


def pad_chunks(t, c, nc, l):
    t = jnp.pad(t, [(0, 0), (0, nc * c - l)] + [(0, 0)] * (t.ndim - 2))
    t = t.reshape((t.shape[0], nc, c) + t.shape[2:])
    return jnp.moveaxis(t, 3, 1)


def unchunk(o, l):
    nc, n, h, c, dv = o.shape
    return o.transpose(1, 0, 3, 2, 4).reshape(n, nc * c, h, dv)[:, :l]


def gated_delta_rule(q, k, v, g, beta, s0):
    n, l, h, dk = q.shape
    out_dtype = v.dtype
    c = min(A_CHUNK, l)
    nc = -(-l // c)
    q, k, v, g, beta = (pad_chunks(t.astype(F32), c, nc, l) for t in (q, k, v, g, beta))
    q = q * dk ** -0.5
    G = jnp.cumsum(g, axis=-1)
    idx = jnp.arange(c)
    causal = idx[:, None] >= idx[None, :]
    strict = idx[:, None] > idx[None, :]
    decay = masked_exp(causal, G[..., :, None] - G[..., None, :])
    kb = k * beta[..., None]
    a_mat = jnp.where(strict, jnp.einsum('nhcid,nhcjd->nhcij', kb, k) * decay, 0.0)
    eye = jnp.eye(c, dtype=F32)
    t_inv = lax.linalg.triangular_solve(a_mat + eye, jnp.broadcast_to(eye, a_mat.shape), left_side=True, lower=True)
    eG = jnp.exp(G)
    u = jnp.einsum('nhcij,nhcje->nhcie', t_inv, v * beta[..., None])
    w = jnp.einsum('nhcij,nhcjd->nhcid', t_inv, kb * eG[..., None])
    qk = jnp.einsum('nhcid,nhcjd->nhcij', q, k) * decay
    q_dec = q * eG[..., None]
    k_dec = k * jnp.exp(G[..., -1:] - G)[..., None]
    g_last = eG[..., -1]

    def step(s, xs):
        qk_c, q_c, k_c, u_c, w_c, gl = xs
        v_new = u_c - jnp.einsum('nhid,nhde->nhie', w_c, s)
        o = jnp.einsum('nhid,nhde->nhie', q_c, s) + jnp.einsum('nhij,nhje->nhie', qk_c, v_new)
        s = s * gl[..., None, None] + jnp.einsum('nhid,nhie->nhde', k_c, v_new)
        return s, o

    xs = tuple(jnp.moveaxis(t, 2, 0) for t in (qk, q_dec, k_dec, u, w, g_last))
    s, o = lax.scan(step, s0.astype(F32), xs)
    return unchunk(o, l).astype(out_dtype), s.astype(s0.dtype)


def hgrn2_recurrence(q, k, v, logf, s0):
    n, l, h, dk = q.shape
    out_dtype = v.dtype
    c = min(C_CHUNK, l)
    nc = -(-l // c)
    q, k, v, logf = (pad_chunks(t.astype(F32), c, nc, l) for t in (q, k, v, logf))
    q = q * dk ** -0.5
    G = jnp.cumsum(logf, axis=-2)
    idx = jnp.arange(c)
    causal = (idx[:, None] >= idx[None, :])[..., None]

    def step(s, xs):
        q_c, k_c, v_c, G_c = xs
        dec = masked_exp(causal, G_c[:, :, :, None, :] - G_c[:, :, None, :, :])
        a = jnp.einsum('nhid,nhijd,nhjd->nhij', q_c, dec, k_c)
        o = jnp.einsum('nhid,nhde->nhie', q_c * jnp.exp(G_c), s) + jnp.einsum('nhij,nhje->nhie', a, v_c)
        gl = G_c[:, :, -1]
        s = s * jnp.exp(gl)[..., None] + jnp.einsum('nhid,nhie->nhde', k_c * jnp.exp(gl[:, :, None] - G_c), v_c)
        return s, o

    xs = tuple(jnp.moveaxis(t, 2, 0) for t in (q, k, v, G))
    s, o = lax.scan(step, s0.astype(F32), xs)
    return unchunk(o, l).astype(out_dtype), s.astype(s0.dtype)


def sink_attention(q, k, v, mask, sinks):
    s = jnp.einsum('...qhgd,...khd->...hgqk', q, k).astype(F32) * B_HD ** -0.5
    s = jnp.where(mask, s, MASK_NEG)
    sink = sinks.astype(F32).reshape(B_KV_HEADS, B_GROUP, 1, 1)
    m = jnp.maximum(jnp.max(s, -1, keepdims=True), sink)
    p = jnp.where(mask, jnp.exp(s - m), 0.0)
    probs = p / (jnp.sum(p, -1, keepdims=True) + jnp.exp(sink - m))
    return jnp.einsum('...hgqk,...khd->...qhgd', probs.astype(v.dtype), v)


def swa_prompt(q, k, v, sinks):
    n, l = q.shape[:2]
    nb = l // WINDOW
    qb = q.reshape(n, nb, WINDOW, B_KV_HEADS, B_GROUP, B_HD)
    kb = k.reshape(n, nb, WINDOW, B_KV_HEADS, B_HD)
    vb = v.reshape(n, nb, WINDOW, B_KV_HEADS, B_HD)
    shift = lambda t: jnp.concatenate([jnp.zeros_like(t[:, :1]), t[:, :-1]], axis=1)
    kx = jnp.concatenate([shift(kb), kb], axis=2)
    vx = jnp.concatenate([shift(vb), vb], axis=2)
    qi = jnp.arange(WINDOW)[:, None] + WINDOW
    kj = jnp.arange(2 * WINDOW)[None, :]
    rel = qi - kj
    band = (rel >= 0) & (rel <= WINDOW)
    valid = (jnp.arange(nb)[:, None, None] > 0) | (kj >= WINDOW)[None]
    mask = (band[None] & valid)[:, None, None]
    return sink_attention(qb, kx, vx, mask, sinks).reshape(n, l, B_QW)


def swa_sample(q, k, v, k_buf, v_buf, sinks):
    n, l = q.shape[:2]
    kx = jnp.concatenate([k_buf.astype(k.dtype), k], axis=1)
    vx = jnp.concatenate([v_buf.astype(v.dtype), v], axis=1)
    qi = jnp.arange(l)[:, None] + WINDOW
    kj = jnp.arange(WINDOW + l)[None, :]
    rel = qi - kj
    mask = (rel >= 0) & (rel <= WINDOW)
    o = sink_attention(q.reshape(n, l, B_KV_HEADS, B_GROUP, B_HD), kx, vx, mask, sinks)
    return o.reshape(n, l, B_QW), kx[:, l:], vx[:, l:]


def even_mixer(x, pos, conv_buf, s0, win_k, win_v, w_in, conv_w, a_log, dt_bias, norm_g, sinks, w_out):
    n, l, _ = x.shape
    qkv_a, gate_a, a_in, b_in, q_b, k_b, v_b, gate_b = jnp.split(x @ w_in, EVEN_SPLITS, axis=-1)
    qkv_a, new_conv = causal_conv(qkv_a, conv_buf, conv_w)
    q_a, k_a, v_a = jnp.split(qkv_a, (A_QK, 2 * A_QK), axis=-1)
    q_a = l2_normalize(q_a.reshape(n, l, A_HEADS, A_DK))
    k_a = l2_normalize(k_a.reshape(n, l, A_HEADS, A_DK))
    v_a = v_a.reshape(n, l, A_HEADS, A_DV)
    log_decay = -jnp.exp(a_log.astype(F32)) * jax.nn.softplus(a_in.astype(F32) + dt_bias.astype(F32))
    beta = jax.nn.sigmoid(b_in.astype(F32))
    o_a, new_s = gated_delta_rule(q_a, k_a, v_a, log_decay, beta, s0)
    o_a = rms_norm(o_a, norm_g).reshape(n, l, A_VW) * jax.nn.silu(gate_a)
    q_b = rotary(q_b.reshape(n, l, B_HEADS, B_HD), pos)
    k_b = rotary(k_b.reshape(n, l, B_KV_HEADS, B_HD), pos)
    v_b = v_b.reshape(n, l, B_KV_HEADS, B_HD)
    if win_k is None:
        o_b = swa_prompt(q_b, k_b, v_b, sinks)
        new_k, new_v = k_b[:, l - WINDOW:], v_b[:, l - WINDOW:]
    else:
        o_b, new_k, new_v = swa_sample(q_b, k_b, v_b, win_k, win_v, sinks)
    o_b = o_b * jax.nn.silu(gate_b)
    y = jnp.concatenate([o_a, o_b], axis=-1) @ w_out
    return y, new_conv, new_s, new_k, new_v


def odd_mixer(x, s0, lb, w_in, norm_g, w_out):
    n, l, _ = x.shape
    q, f, i, gate = jnp.split(x @ w_in, 4, axis=-1)
    q = jax.nn.silu(q).reshape(n, l, C_HEADS, C_DK)
    zf = f.astype(F32)
    fg = lb + (1.0 - lb) * jax.nn.sigmoid(zf)
    logf = jnp.log(jnp.maximum(fg, F_FLOOR)).reshape(n, l, C_HEADS, C_DK)
    k = ((1.0 - lb) * jax.nn.sigmoid(-zf)).reshape(n, l, C_HEADS, C_DK)
    v = i.reshape(n, l, C_HEADS, C_DV)
    o, new_s = hgrn2_recurrence(q, k, v, logf, s0)
    o = rms_norm(o, norm_g).reshape(n, l, D_MODEL) * jax.nn.silu(gate)
    return o @ w_out, new_s


def post_layer(x, y, p, g, b, w_ple_proj, w_ple_gate):
    h = layer_norm(DEEPNORM_ALPHA * x + y, g, b)
    return h + jax.nn.sigmoid(h @ w_ple_gate) * (p @ w_ple_proj)


def setup_inputs(seed: int = 0) -> dict:
    key = jax.random.key(seed)
    ks = jax.random.split(key, 32)
    nrm = lambda k, shape, scale=1.0: scale * jax.random.normal(k, shape, dtype=F32)
    a_log = jnp.log(jax.random.uniform(ks[11], (N_EVEN, A_HEADS), F32, 1.0, 16.0))
    dt = jnp.exp(jax.random.uniform(ks[12], (N_EVEN, A_HEADS), F32, math.log(1e-3), math.log(1e-1)))
    dt_bias = dt + jnp.log(-jnp.expm1(-dt))
    return {
        'x_prompt': nrm(ks[0], (BATCH, SEQ, D_MODEL)),
        'x_sample': nrm(ks[1], (DEC_BATCH, DEC_SEQ, D_MODEL)),
        'state_conv_a': nrm(ks[2], (N_EVEN, DEC_BATCH, A_CONV - 1, A_CONV_CH)),
        'state_delta_a': nrm(ks[3], (N_EVEN, DEC_BATCH, A_HEADS, A_DK, A_DV), 0.3),
        'cache_win_k': nrm(ks[4], (N_EVEN, DEC_BATCH, WINDOW, B_KV_HEADS, B_HD)),
        'cache_win_v': nrm(ks[5], (N_EVEN, DEC_BATCH, WINDOW, B_KV_HEADS, B_HD)),
        'state_hgrn_c': nrm(ks[6], (N_ODD, DEC_BATCH, C_HEADS, C_DK, C_DV), 0.3),
        'p_prompt': nrm(ks[7], (DEPTH, BATCH, SEQ, PLE_DIM)),
        'p_sample': nrm(ks[8], (DEPTH, DEC_BATCH, DEC_SEQ, PLE_DIM)),
        'w_in_even': nrm(ks[9], (N_EVEN, D_MODEL, EVEN_IN), D_MODEL ** -0.5),
        'conv_w_a': nrm(ks[10], (N_EVEN, A_CONV, A_CONV_CH), A_CONV ** -0.5),
        'a_log': a_log,
        'dt_bias': dt_bias,
        'norm_a': 1.0 + nrm(ks[13], (N_EVEN, A_DV), 0.02),
        'sinks_b': nrm(ks[14], (N_EVEN, B_HEADS)),
        'w_out_even': nrm(ks[15], (N_EVEN, D_MODEL, D_MODEL), DEEPNORM_BETA * D_MODEL ** -0.5),
        'w_in_odd': nrm(ks[16], (N_ODD, D_MODEL, ODD_IN), D_MODEL ** -0.5),
        'lb_raw': 1.0 + nrm(ks[17], (N_ODD, D_MODEL), 0.1),
        'norm_c': 1.0 + nrm(ks[18], (N_ODD, C_DV), 0.02),
        'w_out_odd': nrm(ks[19], (N_ODD, D_MODEL, D_MODEL), DEEPNORM_BETA * D_MODEL ** -0.5),
        'ln_g': 1.0 + nrm(ks[20], (DEPTH, D_MODEL), 0.02),
        'ln_b': nrm(ks[21], (DEPTH, D_MODEL), 0.02),
        'w_ple_proj': nrm(ks[22], (DEPTH, PLE_DIM, D_MODEL), PLE_DIM ** -0.5),
        'w_ple_gate': nrm(ks[23], (DEPTH, D_MODEL, D_MODEL), D_MODEL ** -0.5),
    }


def reference(x_prompt, x_sample, state_conv_a, state_delta_a, cache_win_k, cache_win_v, state_hgrn_c,
              p_prompt, p_sample, w_in_even, conv_w_a, a_log, dt_bias, norm_a, sinks_b, w_out_even,
              w_in_odd, lb_raw, norm_c, w_out_odd, ln_g, ln_b, w_ple_proj, w_ple_gate):
    n_p, l_p = x_prompt.shape[:2]
    l_s = x_sample.shape[1]
    pos_p = jnp.arange(l_p)
    pos_s = PAST_LEN + jnp.arange(l_s)
    lb_sm = jax.nn.softmax(lb_raw.astype(F32), axis=0)
    lb_all = jnp.cumsum(lb_sm, axis=0) - lb_sm[0]
    conv_p, conv_s, delta_p, delta_s = [], [], [], []
    wk_p, wk_s, wv_p, wv_s, hg_p, hg_s = [], [], [], [], [], []
    hp, hs = x_prompt, x_sample
    for layer in range(DEPTH):
        j = layer // 2
        if layer % 2 == 0:
            wts = (w_in_even[j], conv_w_a[j], a_log[j], dt_bias[j], norm_a[j], sinks_b[j], w_out_even[j])
            conv0 = jnp.zeros((n_p, A_CONV - 1, A_CONV_CH), hp.dtype)
            s0 = jnp.zeros((n_p, A_HEADS, A_DK, A_DV), hp.dtype)
            yp, c1, s1, k1, v1 = even_mixer(hp, pos_p, conv0, s0, None, None, *wts)
            ys, c2, s2, k2, v2 = even_mixer(hs, pos_s, state_conv_a[j], state_delta_a[j],
                                            cache_win_k[j], cache_win_v[j], *wts)
            conv_p.append(c1); conv_s.append(c2)
            delta_p.append(s1); delta_s.append(s2)
            wk_p.append(k1); wk_s.append(k2)
            wv_p.append(v1); wv_s.append(v2)
        else:
            s0 = jnp.zeros((n_p, C_HEADS, C_DK, C_DV), hp.dtype)
            yp, s1 = odd_mixer(hp, s0, lb_all[j], w_in_odd[j], norm_c[j], w_out_odd[j])
            ys, s2 = odd_mixer(hs, state_hgrn_c[j], lb_all[j], w_in_odd[j], norm_c[j], w_out_odd[j])
            hg_p.append(s1); hg_s.append(s2)
        hp = post_layer(hp, yp, p_prompt[layer], ln_g[layer], ln_b[layer], w_ple_proj[layer], w_ple_gate[layer])
        hs = post_layer(hs, ys, p_sample[layer], ln_g[layer], ln_b[layer], w_ple_proj[layer], w_ple_gate[layer])
    return (hp, hs, jnp.stack(conv_p), jnp.stack(conv_s), jnp.stack(delta_p), jnp.stack(delta_s),
            jnp.stack(wk_p), jnp.stack(wk_s), jnp.stack(wv_p), jnp.stack(wv_s), jnp.stack(hg_p), jnp.stack(hg_s))
```

```cpp
#include <hip/hip_runtime.h>
#include <stdint.h>
#include <math.h>

typedef unsigned short bf16_t;
typedef __attribute__((ext_vector_type(8))) short bf16x8;
typedef __attribute__((ext_vector_type(4))) float f32x4;

constexpr int D = 1024;
constexpr int NB = 4, SEQ = 4096, NS = 128, LS = 8;
constexpr int TP = NB * SEQ;
constexpr int TS = NS * LS;
constexpr int T = TP + TS;
constexpr int PLE = 256;
constexpr int EVEN_IN = 3336, EVEN_LD = 3456, ODD_LD = 4096;
constexpr int CONV_CH = 1536;
constexpr int C_QKV = 0, C_GA = 1536, C_QB = 2048, C_KB = 2560, C_VB = 2688, C_GB = 2816, C_AB = 3328;
constexpr float ALPHA = 1.681792830507429f;
constexpr float EPS = 1e-6f;

__device__ __forceinline__ bf16_t f2bf(float f) {
    unsigned u = __float_as_uint(f);
    u += 0x7fffu + ((u >> 16) & 1u);
    return (bf16_t)(u >> 16);
}
__device__ __forceinline__ float bf2f(bf16_t h) { return __uint_as_float(((unsigned)h) << 16); }
__device__ __forceinline__ float sigmoidf_(float x) { return 1.0f / (1.0f + __expf(-x)); }
__device__ __forceinline__ float siluf_(float x) { return x / (1.0f + __expf(-x)); }
__device__ __forceinline__ float softplusf_(float x) { return fmaxf(x, 0.0f) + log1pf(__expf(-fabsf(x))); }

struct Params {
    const float* x_prompt; const float* x_sample; const float* state_conv; const float* state_delta;
    const float* cache_k; const float* cache_v; const float* state_hgrn; const float* p_prompt; const float* p_sample;
    const float* w_in_even; const float* conv_w; const float* a_log; const float* dt_bias; const float* norm_a; const float* sinks;
    const float* w_out_even; const float* w_in_odd; const float* lb_raw; const float* norm_c; const float* w_out_odd;
    const float* ln_g; const float* ln_b; const float* w_ple_proj; const float* w_ple_gate;
    float* y_prompt; float* y_sample; float* conv_p; float* conv_s; float* delta_p; float* delta_s;
    float* wk_p; float* wk_s; float* wv_p; float* wv_s; float* hg_p; float* hg_s;
    bf16_t* wt_in_even; bf16_t* wt_out_even; bf16_t* wt_in_odd; bf16_t* wt_out_odd; bf16_t* wt_gate; bf16_t* wt_proj;
    float* xf; bf16_t* xb; bf16_t* qb; bf16_t* pb; bf16_t* proj; float* aux; float* rope;
    bf16_t* dnqkv; float* dngb; float* dno; bf16_t* qr; float* kr; float* hgo;
};

__device__ __forceinline__ int even_col_map(int n) {
    if (n < 2048) return n;
    if (n < 3328) return n + 8;
    if (n < 3336) return n - 3328 + 2048;
    return -1;
}
__global__ void __launch_bounds__(256) k_transpose(const float* __restrict__ src, bf16_t* __restrict__ dst, int K, int Nsrc, int Ndst, int remap) {
    __shared__ float tile[64][65];
    const int ntn = Ndst / 64, ntk = K / 64;
    for (int tIdx = blockIdx.x; tIdx < ntn * ntk; tIdx += gridDim.x) {
        const int tn = tIdx % ntn, tk = tIdx / ntn;
        const int n0 = tn * 64, k0 = tk * 64;
        for (int e = threadIdx.x; e < 64 * 64; e += 256) {
            const int kk = e >> 6, nn = e & 63;
            int n = n0 + nn;
            int sn = remap ? even_col_map(n) : n;
            float v = 0.f;
            if (sn >= 0 && sn < Nsrc) v = src[(size_t)(k0 + kk) * Nsrc + sn];
            tile[kk][nn] = v;
        }
        __syncthreads();
        for (int e = threadIdx.x; e < 64 * 64; e += 256) {
            const int nn = e >> 6, kk = e & 63;
            dst[(size_t)(n0 + nn) * K + k0 + kk] = f2bf(tile[kk][nn]);
        }
        __syncthreads();
    }
}

__global__ void __launch_bounds__(256) k_prep_act(Params p) {
    const size_t gtid = (size_t)blockIdx.x * 256 + threadIdx.x, gsz = (size_t)gridDim.x * 256;
    for (size_t i = gtid; i < (size_t)T * D / 4; i += gsz) {
        const size_t e = i * 4; const int t = (int)(e / D);
        const float4 v = (t < TP) ? *(const float4*)(p.x_prompt + e) : *(const float4*)(p.x_sample + (e - (size_t)TP * D));
        *(float4*)(p.xf + e) = v;
        ushort4 o; o.x = f2bf(v.x); o.y = f2bf(v.y); o.z = f2bf(v.z); o.w = f2bf(v.w);
        *(ushort4*)(p.xb + e) = o;
    }
    for (size_t i = gtid; i < (size_t)4 * T * PLE / 4; i += gsz) {
        const size_t e = i * 4; const int l = (int)(e / ((size_t)T * PLE)); const size_t r = e - (size_t)l * T * PLE;
        const int t = (int)(r / PLE);
        const float4 v = (t < TP) ? *(const float4*)(p.p_prompt + (size_t)l * TP * PLE + r) : *(const float4*)(p.p_sample + (size_t)l * TS * PLE + (r - (size_t)TP * PLE));
        ushort4 o; o.x = f2bf(v.x); o.y = f2bf(v.y); o.z = f2bf(v.z); o.w = f2bf(v.w);
        *(ushort4*)(p.pb + e) = o;
    }
    for (size_t i = gtid; i < (size_t)(SEQ + LS) * 8; i += gsz) {
        const int pi = (int)(i / 8), fi = (int)(i % 8);
        const float pos = (pi < SEQ) ? (float)pi : (float)(8192 + pi - SEQ);
        const float inv = powf(500000.0f, -(float)(2 * fi) / 16.0f);
        const float ang = pos * inv;
        float s, c; sincosf(ang, &s, &c);
        p.rope[(size_t)pi * 16 + fi] = c; p.rope[(size_t)pi * 16 + 8 + fi] = s;
    }
}

__device__ __forceinline__ void gemm_mainloop(f32x4 (&acc)[4][4], const bf16_t* __restrict__ A, int lda, const bf16_t* __restrict__ Bt, int ldb,
                                              int K, int row0, int col0, char* smem) {
    const int tid = threadIdx.x, lane = tid & 63, wid = tid >> 6;
    const int wr = wid >> 1, wc = wid & 1;
    uint4 ra0, ra1, ra2, ra3, rb0, rb1, rb2, rb3;
    const int nk = K / 64;
    const int lr = tid >> 3, lch = tid & 7;
    const bf16_t* gA = A + (size_t)(row0 + lr) * lda + lch * 8;
    const bf16_t* gB = Bt + (size_t)(col0 + lr) * ldb + lch * 8;
    const int soff = lr * 128 + ((lch ^ (lr & 7)) << 4);
#define GLOAD(k0) { ra0 = *(const uint4*)(gA + (k0)); ra1 = *(const uint4*)(gA + (size_t)32 * lda + (k0)); ra2 = *(const uint4*)(gA + (size_t)64 * lda + (k0)); ra3 = *(const uint4*)(gA + (size_t)96 * lda + (k0)); \
                    rb0 = *(const uint4*)(gB + (k0)); rb1 = *(const uint4*)(gB + (size_t)32 * ldb + (k0)); rb2 = *(const uint4*)(gB + (size_t)64 * ldb + (k0)); rb3 = *(const uint4*)(gB + (size_t)96 * ldb + (k0)); }
#define SWRITE(stage) { char* sp_ = smem + (stage) * 32768 + soff; \
                    *(uint4*)(sp_) = ra0; *(uint4*)(sp_ + 4096) = ra1; *(uint4*)(sp_ + 8192) = ra2; *(uint4*)(sp_ + 12288) = ra3; \
                    *(uint4*)(sp_ + 16384) = rb0; *(uint4*)(sp_ + 16384 + 4096) = rb1; *(uint4*)(sp_ + 16384 + 8192) = rb2; *(uint4*)(sp_ + 16384 + 12288) = rb3; }
    __syncthreads();
    GLOAD(0); SWRITE(0);
    __syncthreads();
    for (int kt = 0; kt < nk; ++kt) {
        const int cur = kt & 1;
        if (kt + 1 < nk) GLOAD((kt + 1) * 64);
        const char* sA = smem + cur * 32768;
        const char* sB = sA + 16384;
#pragma unroll
        for (int kk = 0; kk < 2; ++kk) {
            bf16x8 af[4], bfr[4];
            const int ch = kk * 4 + (lane >> 4);
#pragma unroll
            for (int m = 0; m < 4; ++m) {
                const int r = wr * 64 + m * 16 + (lane & 15);
                af[m] = *(const bf16x8*)(sA + r * 128 + ((ch ^ (r & 7)) << 4));
            }
#pragma unroll
            for (int n = 0; n < 4; ++n) {
                const int r = wc * 64 + n * 16 + (lane & 15);
                bfr[n] = *(const bf16x8*)(sB + r * 128 + ((ch ^ (r & 7)) << 4));
            }
#pragma unroll
            for (int m = 0; m < 4; ++m)
#pragma unroll
                for (int n = 0; n < 4; ++n)
                    acc[m][n] = __builtin_amdgcn_mfma_f32_16x16x32_bf16(bfr[n], af[m], acc[m][n], 0, 0, 0);
        }
        if (kt + 1 < nk) SWRITE(cur ^ 1);
        __syncthreads();
    }
}

__device__ __forceinline__ void zero_acc(f32x4 (&acc)[4][4]) {
#pragma unroll
    for (int m = 0; m < 4; ++m)
#pragma unroll
        for (int n = 0; n < 4; ++n) acc[m][n] = (f32x4){0.f, 0.f, 0.f, 0.f};
}

template <int EPI>
__global__ void __launch_bounds__(256) k_gemm(Params p, const bf16_t* __restrict__ A, const bf16_t* __restrict__ Bt, int N, int K, int layer) {
    __shared__ __attribute__((aligned(16))) char smem[65536];
    const int ntn = N / 128, ntm = T / 128;
    const int lane = threadIdx.x & 63, wid = threadIdx.x >> 6, wr = wid >> 1, wc = wid & 1;
    for (int tIdx = blockIdx.x; tIdx < ntn * ntm; tIdx += gridDim.x) {
        const int pn = tIdx % ntn, pm = tIdx / ntn;
        const int row0 = pm * 128, col0 = pn * 128;
        f32x4 acc[4][4];
        zero_acc(acc);
        gemm_mainloop(acc, A, K, Bt, K, K, row0, col0, smem);
#pragma unroll
        for (int m = 0; m < 4; ++m) {
            const int row = row0 + wr * 64 + m * 16 + (lane & 15);
#pragma unroll
            for (int n = 0; n < 4; ++n) {
                const int col = col0 + wc * 64 + n * 16 + 4 * (lane >> 4);
                const f32x4 v = acc[m][n];
                if (EPI == 0) {
                    ushort4 o; o.x = f2bf(v[0]); o.y = f2bf(v[1]); o.z = f2bf(v[2]); o.w = f2bf(v[3]);
                    *(ushort4*)(p.proj + (size_t)row * EVEN_LD + col) = o;
                    if (col >= C_AB && col < C_AB + 8) *(float4*)(p.aux + (size_t)row * 8 + (col - C_AB)) = make_float4(v[0], v[1], v[2], v[3]);
                    if (col < CONV_CH) {
                        const int j = layer >> 1;
                        if (row < TP) {
                            const int b = row / SEQ, s = row % SEQ;
                            if (s >= SEQ - 3) *(float4*)(p.conv_p + (((size_t)j * NB + b) * 3 + (s - (SEQ - 3))) * CONV_CH + col) = make_float4(v[0], v[1], v[2], v[3]);
                        } else {
                            const int r2 = row - TP, nn = r2 / LS, s = r2 % LS;
                            if (s >= LS - 3) *(float4*)(p.conv_s + (((size_t)j * NS + nn) * 3 + (s - (LS - 3))) * CONV_CH + col) = make_float4(v[0], v[1], v[2], v[3]);
                        }
                    }
                } else if (EPI == 1) {
                    ushort4 o; o.x = f2bf(v[0]); o.y = f2bf(v[1]); o.z = f2bf(v[2]); o.w = f2bf(v[3]);
                    *(ushort4*)(p.proj + (size_t)row * ODD_LD + col) = o;
                } else {
                    float4 x = *(float4*)(p.xf + (size_t)row * D + col);
                    x.x = ALPHA * x.x + v[0]; x.y = ALPHA * x.y + v[1]; x.z = ALPHA * x.z + v[2]; x.w = ALPHA * x.w + v[3];
                    *(float4*)(p.xf + (size_t)row * D + col) = x;
                }
            }
        }
    }
}

__global__ void __launch_bounds__(256) k_gemm_ple(Params p, int layer) {
    __shared__ __attribute__((aligned(16))) char smem[65536];
    const int ntn = D / 128, ntm = T / 128;
    const int lane = threadIdx.x & 63, wid = threadIdx.x >> 6, wr = wid >> 1, wc = wid & 1;
    const bf16_t* Wg = p.wt_gate + (size_t)layer * D * D;
    const bf16_t* Wp = p.wt_proj + (size_t)layer * D * PLE;
    const bf16_t* Pb = p.pb + (size_t)layer * T * PLE;
    for (int tIdx = blockIdx.x; tIdx < ntn * ntm; tIdx += gridDim.x) {
        const int pn = tIdx % ntn, pm = tIdx / ntn;
        const int row0 = pm * 128, col0 = pn * 128;
        f32x4 acc1[4][4], acc2[4][4];
        zero_acc(acc1); zero_acc(acc2);
        gemm_mainloop(acc1, p.qb, D, Wg, D, D, row0, col0, smem);
        gemm_mainloop(acc2, Pb, PLE, Wp, PLE, PLE, row0, col0, smem);
#pragma unroll
        for (int m = 0; m < 4; ++m) {
            const int row = row0 + wr * 64 + m * 16 + (lane & 15);
#pragma unroll
            for (int n = 0; n < 4; ++n) {
                const int col = col0 + wc * 64 + n * 16 + 4 * (lane >> 4);
                const float4 h = *(const float4*)(p.xf + (size_t)row * D + col);
                float4 o;
                o.x = h.x + sigmoidf_(acc1[m][n][0]) * acc2[m][n][0];
                o.y = h.y + sigmoidf_(acc1[m][n][1]) * acc2[m][n][1];
                o.z = h.z + sigmoidf_(acc1[m][n][2]) * acc2[m][n][2];
                o.w = h.w + sigmoidf_(acc1[m][n][3]) * acc2[m][n][3];
                if (layer == 3) {
                    if (row < TP) *(float4*)(p.y_prompt + (size_t)row * D + col) = o;
                    else *(float4*)(p.y_sample + (size_t)(row - TP) * D + col) = o;
                } else {
                    *(float4*)(p.xf + (size_t)row * D + col) = o;
                    ushort4 ob; ob.x = f2bf(o.x); ob.y = f2bf(o.y); ob.z = f2bf(o.z); ob.w = f2bf(o.w);
                    *(ushort4*)(p.xb + (size_t)row * D + col) = ob;
                }
            }
        }
    }
}

__global__ void __launch_bounds__(256) k_layernorm(Params p, int layer) {
    __shared__ float red[8];
    const float* g = p.ln_g + (size_t)layer * D; const float* b = p.ln_b + (size_t)layer * D;
    const int tid = threadIdx.x, lane = tid & 63, wid = tid >> 6;
    for (int row = blockIdx.x; row < T; row += gridDim.x) {
        float4 v = *(const float4*)(p.xf + (size_t)row * D + tid * 4);
        float s = v.x + v.y + v.z + v.w;
        for (int o = 32; o > 0; o >>= 1) s += __shfl_xor(s, o);
        if (lane == 0) red[wid] = s;
        __syncthreads();
        const float mu = (red[0] + red[1] + red[2] + red[3]) * (1.0f / D);
        const float dx = v.x - mu, dy = v.y - mu, dz = v.z - mu, dw = v.w - mu;
        float q = dx * dx + dy * dy + dz * dz + dw * dw;
        for (int o = 32; o > 0; o >>= 1) q += __shfl_xor(q, o);
        if (lane == 0) red[4 + wid] = q;
        __syncthreads();
        const float var = (red[4] + red[5] + red[6] + red[7]) * (1.0f / D);
        const float rs = rsqrtf(var + EPS);
        const float4 gg = *(const float4*)(g + tid * 4), bb = *(const float4*)(b + tid * 4);
        float4 o; o.x = dx * rs * gg.x + bb.x; o.y = dy * rs * gg.y + bb.y; o.z = dz * rs * gg.z + bb.z; o.w = dw * rs * gg.w + bb.w;
        *(float4*)(p.xf + (size_t)row * D + tid * 4) = o;
        ushort4 ob; ob.x = f2bf(o.x); ob.y = f2bf(o.y); ob.z = f2bf(o.z); ob.w = f2bf(o.w);
        *(ushort4*)(p.qb + (size_t)row * D + tid * 4) = ob;
        __syncthreads();
    }
}

__device__ __forceinline__ void tok_info(int t, int& smp, int& seq, int& s) {
    if (t < TP) { smp = 0; seq = t / SEQ; s = t % SEQ; } else { smp = 1; seq = (t - TP) / LS; s = (t - TP) % LS; }
}

__global__ void __launch_bounds__(256) k_dn_pre(Params p, int j) {
    const int lane = threadIdx.x & 63;
    const int wave = blockIdx.x * 4 + (threadIdx.x >> 6), nw = gridDim.x * 4;
    const float* cw = p.conv_w + (size_t)j * 4 * CONV_CH;
    for (int item = wave; item < T * 4; item += nw) {
        const int t = item >> 2, h = item & 3;
        int smp, seq, s; tok_info(t, smp, seq, s);
        float out[3][2];
#pragma unroll
        for (int part = 0; part < 3; ++part) {
#pragma unroll
            for (int u = 0; u < 2; ++u) {
                const int c = part * 512 + h * 128 + lane + 64 * u;
                float y = 0.f;
#pragma unroll
                for (int jj = 0; jj < 4; ++jj) {
                    const int sp = s - 3 + jj;
                    float xv;
                    if (sp >= 0) xv = bf2f(p.proj[(size_t)(t - 3 + jj) * EVEN_LD + C_QKV + c]);
                    else if (smp) xv = p.state_conv[(((size_t)j * NS + seq) * 3 + (sp + 3)) * CONV_CH + c];
                    else xv = 0.f;
                    y += cw[jj * CONV_CH + c] * xv;
                }
                out[part][u] = siluf_(y);
            }
        }
#pragma unroll
        for (int part = 0; part < 2; ++part) {
            float ss = out[part][0] * out[part][0] + out[part][1] * out[part][1];
            for (int o = 32; o > 0; o >>= 1) ss += __shfl_xor(ss, o);
            const float r = rsqrtf(ss + EPS);
            out[part][0] *= r; out[part][1] *= r;
        }
#pragma unroll
        for (int part = 0; part < 3; ++part)
#pragma unroll
            for (int u = 0; u < 2; ++u)
                p.dnqkv[(size_t)t * CONV_CH + part * 512 + h * 128 + lane + 64 * u] = f2bf(out[part][u]);
        if (lane == 0) {
            const float a_in = p.aux[(size_t)t * 8 + h], b_in = p.aux[(size_t)t * 8 + 4 + h];
            const float g = -__expf(p.a_log[j * 4 + h]) * softplusf_(a_in + p.dt_bias[j * 4 + h]);
            p.dngb[(size_t)t * 8 + h] = g;
            p.dngb[(size_t)t * 8 + 4 + h] = sigmoidf_(b_in);
        }
    }
}

__global__ void __launch_bounds__(256) k_dn_rec(Params p, int j) {
    const int lane = threadIdx.x & 63;
    const int wave = blockIdx.x * 4 + (threadIdx.x >> 6), nw = gridDim.x * 4;
    const int e = lane & 3, dg = lane >> 2;
    const int nitems = (NB + NS) * 4 * 32;
    for (int item = wave; item < nitems; item += nw) {
        const int es = item & 31, h = (item >> 5) & 3, st = item >> 7;
        const int smp = st >= NB, seq = smp ? st - NB : st;
        const int t0 = smp ? TP + seq * LS : seq * SEQ, len = smp ? LS : SEQ;
        const int ec = es * 4 + e;
        float S[8];
        if (smp) {
            const float* s0 = p.state_delta + (((size_t)j * NS + seq) * 4 + h) * 128 * 128;
#pragma unroll
            for (int i = 0; i < 8; ++i) S[i] = s0[(size_t)(dg * 8 + i) * 128 + ec];
        } else {
#pragma unroll
            for (int i = 0; i < 8; ++i) S[i] = 0.f;
        }
        for (int s = 0; s < len; ++s) {
            const int t = t0 + s;
            const bf16x8 qv = *(const bf16x8*)(p.dnqkv + (size_t)t * CONV_CH + h * 128 + dg * 8);
            const bf16x8 kv = *(const bf16x8*)(p.dnqkv + (size_t)t * CONV_CH + 512 + h * 128 + dg * 8);
            const float v = bf2f(p.dnqkv[(size_t)t * CONV_CH + 1024 + h * 128 + ec]);
            const float g = p.dngb[(size_t)t * 8 + h], beta = p.dngb[(size_t)t * 8 + 4 + h];
            float q[8], k[8];
#pragma unroll
            for (int i = 0; i < 8; ++i) { q[i] = bf2f((bf16_t)qv[i]); k[i] = bf2f((bf16_t)kv[i]); }
            float kS = 0.f, qS = 0.f, qk = 0.f;
#pragma unroll
            for (int i = 0; i < 8; ++i) { kS += k[i] * S[i]; qS += q[i] * S[i]; qk += q[i] * k[i]; }
            for (int o = 4; o < 64; o <<= 1) { kS += __shfl_xor(kS, o); qS += __shfl_xor(qS, o); qk += __shfl_xor(qk, o); }
            const float a = __expf(g);
            const float vn = beta * (v - a * kS);
            const float o = 0.08838834764831845f * (a * qS + qk * vn);
#pragma unroll
            for (int i = 0; i < 8; ++i) S[i] = a * S[i] + k[i] * vn;
            if (dg == 0) p.dno[(size_t)t * 512 + h * 128 + ec] = o;
        }
        float* so = smp ? p.delta_s + (((size_t)j * NS + seq) * 4 + h) * 128 * 128 : p.delta_p + (((size_t)j * NB + seq) * 4 + h) * 128 * 128;
#pragma unroll
        for (int i = 0; i < 8; ++i) so[(size_t)(dg * 8 + i) * 128 + ec] = S[i];
    }
}

__global__ void __launch_bounds__(256) k_dn_post(Params p, int j) {
    const int lane = threadIdx.x & 63;
    const int wave = blockIdx.x * 4 + (threadIdx.x >> 6), nw = gridDim.x * 4;
    for (int item = wave; item < T * 4; item += nw) {
        const int t = item >> 2, h = item & 3;
        const float o0 = p.dno[(size_t)t * 512 + h * 128 + lane], o1 = p.dno[(size_t)t * 512 + h * 128 + lane + 64];
        float ss = o0 * o0 + o1 * o1;
        for (int o = 32; o > 0; o >>= 1) ss += __shfl_xor(ss, o);
        const float r = rsqrtf(ss * (1.0f / 128.0f) + EPS);
        const float g0 = bf2f(p.proj[(size_t)t * EVEN_LD + C_GA + h * 128 + lane]), g1 = bf2f(p.proj[(size_t)t * EVEN_LD + C_GA + h * 128 + lane + 64]);
        p.qb[(size_t)t * D + h * 128 + lane] = f2bf(o0 * r * p.norm_a[j * 128 + lane] * siluf_(g0));
        p.qb[(size_t)t * D + h * 128 + lane + 64] = f2bf(o1 * r * p.norm_a[j * 128 + lane + 64] * siluf_(g1));
    }
}

__global__ void __launch_bounds__(256) k_swa_pre(Params p, int j) {
    const int lane = threadIdx.x & 63;
    const int wave = blockIdx.x * 4 + (threadIdx.x >> 6), nw = gridDim.x * 4;
    for (int t = wave; t < T; t += nw) {
        int smp, seq, s; tok_info(t, smp, seq, s);
        const int pi = smp ? SEQ + s : s;
        const float* rp = p.rope + (size_t)pi * 16;
        const int dd = lane;
#pragma unroll
        for (int hh = 0; hh < 10; ++hh) {
            const int cbase = (hh < 8) ? C_QB + hh * 64 : C_KB + (hh - 8) * 64;
            float x = bf2f(p.proj[(size_t)t * EVEN_LD + cbase + dd]);
            float r = x;
            if (dd < 16) {
                const int fi = dd & 7;
                const float other = bf2f(p.proj[(size_t)t * EVEN_LD + cbase + (dd ^ 8)]);
                const float c = rp[fi], sn = rp[8 + fi];
                r = (dd < 8) ? (x * c - other * sn) : (x * c + other * sn);
            }
            if (hh < 8) p.qr[(size_t)t * 512 + hh * 64 + dd] = f2bf(r);
            else {
                const int kh = hh - 8;
                p.kr[(size_t)t * 128 + kh * 64 + dd] = r;
                if (!smp) {
                    if (s >= SEQ - 128) p.wk_p[((((size_t)j * NB + seq) * 128 + (s - (SEQ - 128))) * 2 + kh) * 64 + dd] = r;
                } else {
                    p.wk_s[((((size_t)j * NS + seq) * 128 + (120 + s)) * 2 + kh) * 64 + dd] = r;
                }
            }
        }
#pragma unroll
        for (int kh = 0; kh < 2; ++kh) {
            const float v = bf2f(p.proj[(size_t)t * EVEN_LD + C_VB + kh * 64 + dd]);
            if (!smp) {
                if (s >= SEQ - 128) p.wv_p[((((size_t)j * NB + seq) * 128 + (s - (SEQ - 128))) * 2 + kh) * 64 + dd] = v;
            } else {
                p.wv_s[((((size_t)j * NS + seq) * 128 + (120 + s)) * 2 + kh) * 64 + dd] = v;
            }
        }
    }
    const size_t gtid = (size_t)blockIdx.x * 256 + threadIdx.x, gsz = (size_t)gridDim.x * 256;
    for (size_t i = gtid; i < (size_t)NS * 120 * 128; i += gsz) {
        const int nn = (int)(i / (120 * 128)); const int rem = (int)(i % (120 * 128));
        const size_t src = ((size_t)j * NS + nn) * 128 * 128 + 8 * 128 + rem;
        const size_t dst = ((size_t)j * NS + nn) * 128 * 128 + rem;
        p.wk_s[dst] = p.cache_k[src];
        p.wv_s[dst] = p.cache_v[src];
    }
}

__global__ void __launch_bounds__(256) k_swa_attn(Params p, int j) {
    const int lane = threadIdx.x & 63;
    const int wave = blockIdx.x * 4 + (threadIdx.x >> 6), nw = gridDim.x * 4;
    for (int item = wave; item < T * 8; item += nw) {
        const int t = item >> 3, hq = item & 7, kh = hq >> 2;
        int smp, seq, s; tok_info(t, smp, seq, s);
        const int t0 = t - s;
        float q[64];
        {
            const bf16_t* qp = p.qr + (size_t)t * 512 + hq * 64;
#pragma unroll
            for (int c = 0; c < 8; ++c) {
                const bf16x8 v = *(const bf16x8*)(qp + c * 8);
#pragma unroll
                for (int i = 0; i < 8; ++i) q[c * 8 + i] = bf2f((bf16_t)v[i]);
            }
        }
        const float sink = p.sinks[j * 8 + hq];
        float sc[3]; bool valid[3];
        float mx = -1e30f;
#pragma unroll
        for (int rr = 0; rr < 3; ++rr) {
            const int r = lane + 64 * rr;
            const int kp = s - 128 + r;
            bool ok = (r <= 128);
            const float* kptr = nullptr;
            if (ok) {
                if (kp >= 0) kptr = p.kr + (size_t)(t0 + kp) * 128 + kh * 64;
                else if (smp) kptr = p.cache_k + ((((size_t)j * NS + seq) * 128 + (128 + kp)) * 2 + kh) * 64;
                else ok = false;
            }
            float d = 0.f;
            if (ok) {
#pragma unroll
                for (int c = 0; c < 16; ++c) {
                    const float4 kv = *(const float4*)(kptr + c * 4);
                    d += q[c * 4] * kv.x + q[c * 4 + 1] * kv.y + q[c * 4 + 2] * kv.z + q[c * 4 + 3] * kv.w;
                }
                d *= 0.125f;
                mx = fmaxf(mx, d);
            }
            sc[rr] = d; valid[rr] = ok;
        }
        for (int o = 32; o > 0; o >>= 1) mx = fmaxf(mx, __shfl_xor(mx, o));
        const float m = fmaxf(mx, sink);
        float pr[3]; float sum = 0.f;
#pragma unroll
        for (int rr = 0; rr < 3; ++rr) { pr[rr] = valid[rr] ? __expf(sc[rr] - m) : 0.f; sum += pr[rr]; }
        for (int o = 32; o > 0; o >>= 1) sum += __shfl_xor(sum, o);
        const float denom = sum + __expf(sink - m);
        float acc = 0.f;
        for (int r = 0; r <= 128; ++r) {
            const float pj = __shfl(r < 64 ? pr[0] : (r < 128 ? pr[1] : pr[2]), r & 63);
            const int kp = s - 128 + r;
            float vv = 0.f;
            if (kp >= 0) vv = bf2f(p.proj[(size_t)(t0 + kp) * EVEN_LD + C_VB + kh * 64 + lane]);
            else if (smp) vv = p.cache_v[((((size_t)j * NS + seq) * 128 + (128 + kp)) * 2 + kh) * 64 + lane];
            acc += pj * vv;
        }
        const float o = acc / denom;
        const float g = bf2f(p.proj[(size_t)t * EVEN_LD + C_GB + hq * 64 + lane]);
        p.qb[(size_t)t * D + 512 + hq * 64 + lane] = f2bf(o * siluf_(g));
    }
}

__global__ void __launch_bounds__(256) k_hg_rec(Params p, int j) {
    const int lane = threadIdx.x & 63;
    const int wave = blockIdx.x * 4 + (threadIdx.x >> 6), nw = gridDim.x * 4;
    const int e = lane & 3, dg = lane >> 2;
    const int nitems = (NB + NS) * 8 * 32;
    for (int item = wave; item < nitems; item += nw) {
        const int es = item & 31, h = (item >> 5) & 7, st = item >> 8;
        const int smp = st >= NB, seq = smp ? st - NB : st;
        const int t0 = smp ? TP + seq * LS : seq * SEQ, len = smp ? LS : SEQ;
        const int ec = es * 4 + e;
        float lb[8];
#pragma unroll
        for (int i = 0; i < 8; ++i) {
            const int c = h * 128 + dg * 8 + i;
            if (j == 0) lb[i] = 0.f;
            else {
                const float r0 = p.lb_raw[c], r1 = p.lb_raw[D + c];
                const float mm = fmaxf(r0, r1);
                const float e0 = __expf(r0 - mm), e1 = __expf(r1 - mm);
                lb[i] = e1 / (e0 + e1);
            }
        }
        float S[8];
        if (smp) {
            const float* s0 = p.state_hgrn + (((size_t)j * NS + seq) * 8 + h) * 128 * 128;
#pragma unroll
            for (int i = 0; i < 8; ++i) S[i] = s0[(size_t)(dg * 8 + i) * 128 + ec];
        } else {
#pragma unroll
            for (int i = 0; i < 8; ++i) S[i] = 0.f;
        }
        for (int s = 0; s < len; ++s) {
            const int t = t0 + s;
            const bf16_t* row = p.proj + (size_t)t * ODD_LD;
            const bf16x8 qv = *(const bf16x8*)(row + h * 128 + dg * 8);
            const bf16x8 fv = *(const bf16x8*)(row + 1024 + h * 128 + dg * 8);
            const float v = bf2f(row[2048 + h * 128 + ec]);
            float o = 0.f;
#pragma unroll
            for (int i = 0; i < 8; ++i) {
                const float qq = siluf_(bf2f((bf16_t)qv[i])) * 0.08838834764831845f;
                const float z = bf2f((bf16_t)fv[i]);
                const float f = fmaxf(lb[i] + (1.0f - lb[i]) * sigmoidf_(z), 1e-30f);
                const float k = (1.0f - lb[i]) * sigmoidf_(-z);
                S[i] = f * S[i] + k * v;
                o += qq * S[i];
            }
            for (int off = 4; off < 64; off <<= 1) o += __shfl_xor(o, off);
            if (dg == 0) p.hgo[(size_t)t * D + h * 128 + ec] = o;
        }
        float* so = smp ? p.hg_s + (((size_t)j * NS + seq) * 8 + h) * 128 * 128 : p.hg_p + (((size_t)j * NB + seq) * 8 + h) * 128 * 128;
#pragma unroll
        for (int i = 0; i < 8; ++i) so[(size_t)(dg * 8 + i) * 128 + ec] = S[i];
    }
}

__global__ void __launch_bounds__(256) k_hg_post(Params p, int j) {
    const int lane = threadIdx.x & 63;
    const int wave = blockIdx.x * 4 + (threadIdx.x >> 6), nw = gridDim.x * 4;
    for (int item = wave; item < T * 8; item += nw) {
        const int t = item >> 3, h = item & 7;
        const float o0 = p.hgo[(size_t)t * D + h * 128 + lane], o1 = p.hgo[(size_t)t * D + h * 128 + lane + 64];
        float ss = o0 * o0 + o1 * o1;
        for (int o = 32; o > 0; o >>= 1) ss += __shfl_xor(ss, o);
        const float r = rsqrtf(ss * (1.0f / 128.0f) + EPS);
        const float g0 = bf2f(p.proj[(size_t)t * ODD_LD + 3072 + h * 128 + lane]), g1 = bf2f(p.proj[(size_t)t * ODD_LD + 3072 + h * 128 + lane + 64]);
        p.qb[(size_t)t * D + h * 128 + lane] = f2bf(o0 * r * p.norm_c[j * 128 + lane] * siluf_(g0));
        p.qb[(size_t)t * D + h * 128 + lane + 64] = f2bf(o1 * r * p.norm_c[j * 128 + lane + 64] * siluf_(g1));
    }
}

static inline size_t align_up(size_t x) { return (x + 255) & ~(size_t)255; }

extern "C" void kernel_launch(void* const* d_in, const int* in_sizes, int n_in, void* d_out, int out_size, void* d_ws, size_t ws_size, hipStream_t stream) {
    Params p{};
    p.x_prompt = (const float*)d_in[0]; p.x_sample = (const float*)d_in[1]; p.state_conv = (const float*)d_in[2]; p.state_delta = (const float*)d_in[3];
    p.cache_k = (const float*)d_in[4]; p.cache_v = (const float*)d_in[5]; p.state_hgrn = (const float*)d_in[6]; p.p_prompt = (const float*)d_in[7]; p.p_sample = (const float*)d_in[8];
    p.w_in_even = (const float*)d_in[9]; p.conv_w = (const float*)d_in[10]; p.a_log = (const float*)d_in[11]; p.dt_bias = (const float*)d_in[12]; p.norm_a = (const float*)d_in[13];
    p.sinks = (const float*)d_in[14]; p.w_out_even = (const float*)d_in[15]; p.w_in_odd = (const float*)d_in[16]; p.lb_raw = (const float*)d_in[17]; p.norm_c = (const float*)d_in[18];
    p.w_out_odd = (const float*)d_in[19]; p.ln_g = (const float*)d_in[20]; p.ln_b = (const float*)d_in[21]; p.w_ple_proj = (const float*)d_in[22]; p.w_ple_gate = (const float*)d_in[23];
    float* o = (float*)d_out;
    p.y_prompt = o; o += (size_t)TP * D;
    p.y_sample = o; o += (size_t)TS * D;
    p.conv_p = o; o += (size_t)2 * NB * 3 * CONV_CH;
    p.conv_s = o; o += (size_t)2 * NS * 3 * CONV_CH;
    p.delta_p = o; o += (size_t)2 * NB * 4 * 128 * 128;
    p.delta_s = o; o += (size_t)2 * NS * 4 * 128 * 128;
    p.wk_p = o; o += (size_t)2 * NB * 128 * 128;
    p.wk_s = o; o += (size_t)2 * NS * 128 * 128;
    p.wv_p = o; o += (size_t)2 * NB * 128 * 128;
    p.wv_s = o; o += (size_t)2 * NS * 128 * 128;
    p.hg_p = o; o += (size_t)2 * NB * 8 * 128 * 128;
    p.hg_s = o; o += (size_t)2 * NS * 8 * 128 * 128;

    char* w = (char*)d_ws; size_t off = 0;
    auto carve = [&](size_t bytes) { char* r = w + off; off += align_up(bytes); return r; };
    p.wt_in_even = (bf16_t*)carve((size_t)2 * EVEN_LD * D * 2);
    p.wt_out_even = (bf16_t*)carve((size_t)2 * D * D * 2);
    p.wt_in_odd = (bf16_t*)carve((size_t)2 * ODD_LD * D * 2);
    p.wt_out_odd = (bf16_t*)carve((size_t)2 * D * D * 2);
    p.wt_gate = (bf16_t*)carve((size_t)4 * D * D * 2);
    p.wt_proj = (bf16_t*)carve((size_t)4 * D * PLE * 2);
    p.xf = (float*)carve((size_t)T * D * 4);
    p.xb = (bf16_t*)carve((size_t)T * D * 2);
    p.qb = (bf16_t*)carve((size_t)T * D * 2);
    p.pb = (bf16_t*)carve((size_t)4 * T * PLE * 2);
    p.proj = (bf16_t*)carve((size_t)T * ODD_LD * 2);
    p.aux = (float*)carve((size_t)T * 8 * 4);
    p.rope = (float*)carve((size_t)(SEQ + LS) * 16 * 4);
    char* scr = w + off;
    {
        size_t o2 = 0;
        auto c2 = [&](size_t bytes) { char* r = scr + o2; o2 += align_up(bytes); return r; };
        p.dnqkv = (bf16_t*)c2((size_t)T * CONV_CH * 2);
        p.dngb = (float*)c2((size_t)T * 8 * 4);
        p.dno = (float*)c2((size_t)T * 512 * 4);
        p.qr = (bf16_t*)c2((size_t)T * 512 * 2);
        p.kr = (float*)c2((size_t)T * 128 * 4);
    }
    p.hgo = (float*)scr;

    const int G = 1024;
    for (int j = 0; j < 2; ++j) {
        k_transpose<<<G, 256, 0, stream>>>(p.w_in_even + (size_t)j * D * EVEN_IN, p.wt_in_even + (size_t)j * EVEN_LD * D, D, EVEN_IN, EVEN_LD, 1);
        k_transpose<<<G, 256, 0, stream>>>(p.w_out_even + (size_t)j * D * D, p.wt_out_even + (size_t)j * D * D, D, D, D, 0);
        k_transpose<<<G, 256, 0, stream>>>(p.w_in_odd + (size_t)j * D * ODD_LD, p.wt_in_odd + (size_t)j * ODD_LD * D, D, ODD_LD, ODD_LD, 0);
        k_transpose<<<G, 256, 0, stream>>>(p.w_out_odd + (size_t)j * D * D, p.wt_out_odd + (size_t)j * D * D, D, D, D, 0);
    }
    for (int l = 0; l < 4; ++l) {
        k_transpose<<<G, 256, 0, stream>>>(p.w_ple_gate + (size_t)l * D * D, p.wt_gate + (size_t)l * D * D, D, D, D, 0);
        k_transpose<<<G, 256, 0, stream>>>(p.w_ple_proj + (size_t)l * PLE * D, p.wt_proj + (size_t)l * D * PLE, PLE, D, D, 0);
    }
    k_prep_act<<<2048, 256, 0, stream>>>(p);

    for (int layer = 0; layer < 4; ++layer) {
        const int j = layer >> 1;
        if ((layer & 1) == 0) {
            k_gemm<0><<<G, 256, 0, stream>>>(p, p.xb, p.wt_in_even + (size_t)j * EVEN_LD * D, EVEN_LD, D, layer);
            k_dn_pre<<<2048, 256, 0, stream>>>(p, j);
            k_swa_pre<<<2048, 256, 0, stream>>>(p, j);
            k_dn_rec<<<(NB + NS) * 4 * 32 / 4, 256, 0, stream>>>(p, j);
            k_dn_post<<<2048, 256, 0, stream>>>(p, j);
            k_swa_attn<<<4096, 256, 0, stream>>>(p, j);
            k_gemm<2><<<G, 256, 0, stream>>>(p, p.qb, p.wt_out_even + (size_t)j * D * D, D, D, layer);
        } else {
            k_gemm<1><<<G, 256, 0, stream>>>(p, p.xb, p.wt_in_odd + (size_t)j * ODD_LD * D, ODD_LD, D, layer);
            k_hg_rec<<<(NB + NS) * 8 * 32 / 4, 256, 0, stream>>>(p, j);
            k_hg_post<<<2048, 256, 0, stream>>>(p, j);
            k_gemm<2><<<G, 256, 0, stream>>>(p, p.qb, p.wt_out_odd + (size_t)j * D * D, D, D, layer);
        }
        k_layernorm<<<2048, 256, 0, stream>>>(p, layer);
        k_gemm_ple<<<G, 256, 0, stream>>>(p, layer);
    }
}
```

```cpp
#include <hip/hip_runtime.h>
#include <hip/hip_cooperative_groups.h>
#include <cstdio>
namespace cg = cooperative_groups;
#include <stdint.h>
#include <math.h>

typedef unsigned short bf16_t;
typedef __attribute__((ext_vector_type(8))) short bf16x8;
typedef __attribute__((ext_vector_type(4))) float f32x4;

constexpr int D = 1024;
constexpr int NB = 4, SEQ = 4096, NS = 128, LS = 8;
constexpr int TP = NB * SEQ;
constexpr int TS = NS * LS;
constexpr int T = TP + TS;
constexpr int PLE = 256;
constexpr int EVEN_IN = 3336, EVEN_LD = 3456, ODD_LD = 4096;
constexpr int CONV_CH = 1536;
constexpr int C_QKV = 0, C_GA = 1536, C_QB = 2048, C_KB = 2560, C_VB = 2688, C_GB = 2816, C_AB = 3328;
constexpr float ALPHA = 1.681792830507429f;
constexpr float EPS = 1e-6f;

typedef __bf16 hw_bf16x2 __attribute__((ext_vector_type(2)));
typedef float hw_f32x2 __attribute__((ext_vector_type(2)));
__device__ __forceinline__ bf16_t f2bf(float f) { return __builtin_bit_cast(unsigned short, (__bf16)f); }
__device__ __forceinline__ unsigned pack_bf16(float lo, float hi) { const hw_f32x2 v = {lo, hi}; return __builtin_bit_cast(unsigned, __builtin_convertvector(v, hw_bf16x2)); }
__device__ __forceinline__ float4 unpack4(uint2 v) {
    float4 r; r.x = __uint_as_float(v.x << 16); r.y = __uint_as_float(v.x & 0xffff0000u); r.z = __uint_as_float(v.y << 16); r.w = __uint_as_float(v.y & 0xffff0000u); return r;
}
__device__ __forceinline__ void unpack8(const uint4 v, float (&f)[8]) {
    f[0] = __uint_as_float(v.x << 16); f[1] = __uint_as_float(v.x & 0xffff0000u); f[2] = __uint_as_float(v.y << 16); f[3] = __uint_as_float(v.y & 0xffff0000u);
    f[4] = __uint_as_float(v.z << 16); f[5] = __uint_as_float(v.z & 0xffff0000u); f[6] = __uint_as_float(v.w << 16); f[7] = __uint_as_float(v.w & 0xffff0000u);
}
__device__ __forceinline__ float bf2f(bf16_t h) { return __uint_as_float(((unsigned)h) << 16); }
__device__ __forceinline__ float sigmoidf_(float x) { return 1.0f / (1.0f + __expf(-x)); }
__device__ __forceinline__ float siluf_(float x) { return x / (1.0f + __expf(-x)); }
__device__ __forceinline__ float softplusf_(float x) { return fmaxf(x, 0.0f) + log1pf(__expf(-fabsf(x))); }

__shared__ __attribute__((aligned(16))) char g_smem[73728];

__device__ __forceinline__ int tid_opaque() { int t = threadIdx.x; asm volatile("" : "+v"(t)); return t; }

#define MEMFENCE() asm volatile("" ::: "memory")
#define LAUNDER(ptr) asm volatile("" : "+v"(ptr))

#define LAS __attribute__((address_space(3)))
__device__ __forceinline__ unsigned lds_base_addr() { return (unsigned)(size_t)(LAS char*)g_smem; }
__device__ __forceinline__ void glds16_asm(const void* gsrc, unsigned lds_dst) {
    unsigned keep;
    asm volatile("s_mov_b32 %0, m0\n\ts_mov_b32 m0, %2\n\ts_nop 0\n\tglobal_load_lds_dwordx4 %1, off\n\ts_mov_b32 m0, %0" : "=&s"(keep) : "v"(gsrc), "s"(lds_dst) : "memory");
}

struct Params {
    const float* x_prompt; const float* x_sample; const float* state_conv; const float* state_delta;
    const float* cache_k; const float* cache_v; const float* state_hgrn; const float* p_prompt; const float* p_sample;
    const float* w_in_even; const float* conv_w; const float* a_log; const float* dt_bias; const float* norm_a; const float* sinks;
    const float* w_out_even; const float* w_in_odd; const float* lb_raw; const float* norm_c; const float* w_out_odd;
    const float* ln_g; const float* ln_b; const float* w_ple_proj; const float* w_ple_gate;
    float* y_prompt; float* y_sample; float* conv_p; float* conv_s; float* delta_p; float* delta_s;
    float* wk_p; float* wk_s; float* wv_p; float* wv_s; float* hg_p; float* hg_s;
    bf16_t* wt_in_even; bf16_t* wt_out_even; bf16_t* wt_in_odd; bf16_t* wt_out_odd; bf16_t* wt_gate; bf16_t* wt_proj;
    bf16_t* p2; bf16_t* xb; bf16_t* qb; bf16_t* pb; bf16_t* proj; float* aux; float* rope;
    bf16_t* dnqkv; float* dngb; float* dno; bf16_t* qr; float* kr; bf16_t* krb; bf16_t* vT; bf16_t* kcat; bf16_t* vTcat; float* hgo; char* hgrec; char* hgv; char* dnrec; char* dnsp; float* dngl; unsigned* bar;
};

__device__ __forceinline__ int even_col_map(int n) {
    if (n < 2048) return n;
    if (n < 3328) return n + 8;
    if (n < 3336) return n - 3328 + 2048;
    return -1;
}
__device__ __forceinline__ void ph_transpose(const float* __restrict__ src, bf16_t* __restrict__ dst, int K, int Nsrc, int Ndst, int remap, char* smem, int bid, int nblk) {
    const int tidx = tid_opaque();
    float (*tile)[65] = (float (*)[65])smem;
    const int ntn = Ndst / 64, ntk = K / 64;
    for (int tIdx = bid; tIdx < ntn * ntk; tIdx += nblk) {
        const int tn = tIdx % ntn, tk = tIdx / ntn;
        const int n0 = tn * 64, k0 = tk * 64;
#pragma unroll
        for (int u = 0; u < 4; ++u) {
            const int e = tidx + 256 * u, kk = e >> 4, n4 = (e & 15) * 4;
            const int n = n0 + n4;
            const int sn = remap ? even_col_map(n) : n;
            float4 v = make_float4(0.f, 0.f, 0.f, 0.f);
            if (sn >= 0 && sn + 3 < Nsrc) v = *(const float4*)(src + (size_t)(k0 + kk) * Nsrc + sn);
            tile[kk][n4] = v.x; tile[kk][n4 + 1] = v.y; tile[kk][n4 + 2] = v.z; tile[kk][n4 + 3] = v.w;
        }
        __syncthreads();
#pragma unroll
        for (int u = 0; u < 2; ++u) {
            const int e = tidx + 256 * u, nn = e >> 3, kc = (e & 7) * 8;
            uint4 o;
            o.x = pack_bf16(tile[kc][nn], tile[kc + 1][nn]); o.y = pack_bf16(tile[kc + 2][nn], tile[kc + 3][nn]);
            o.z = pack_bf16(tile[kc + 4][nn], tile[kc + 5][nn]); o.w = pack_bf16(tile[kc + 6][nn], tile[kc + 7][nn]);
            *(uint4*)(dst + (size_t)(n0 + nn) * K + k0 + kc) = o;
        }
        __syncthreads();
    }
}

__device__ __forceinline__ void ph_weights(const Params& p, int layer, char* smem, int bid, int nblk) {
    const int j = layer >> 1;
    __syncthreads();
    if ((layer & 1) == 0) {
        ph_transpose(p.w_in_even + (size_t)j * D * EVEN_IN, p.wt_in_even + (size_t)j * EVEN_LD * D, D, EVEN_IN, EVEN_LD, 1, smem, bid, nblk);
        ph_transpose(p.w_out_even + (size_t)j * D * D, p.wt_out_even + (size_t)j * D * D, D, D, D, 0, smem, bid, nblk);
    } else {
        ph_transpose(p.w_in_odd + (size_t)j * D * ODD_LD, p.wt_in_odd + (size_t)j * ODD_LD * D, D, ODD_LD, ODD_LD, 0, smem, bid, nblk);
        ph_transpose(p.w_out_odd + (size_t)j * D * D, p.wt_out_odd + (size_t)j * D * D, D, D, D, 0, smem, bid, nblk);
    }
    ph_transpose(p.w_ple_gate + (size_t)layer * D * D, p.wt_gate + (size_t)layer * D * D, D, D, D, 0, smem, bid, nblk);
    ph_transpose(p.w_ple_proj + (size_t)layer * PLE * D, p.wt_proj + (size_t)layer * D * PLE, PLE, D, D, 0, smem, bid, nblk);
}

__device__ __forceinline__ void ph_prep_act(const Params& p) {
    const int tidx = tid_opaque();
    const size_t gtid = (size_t)blockIdx.x * 256 + tidx, gsz = (size_t)gridDim.x * 256;
    for (size_t i = gtid; i < (size_t)T * D / 4; i += gsz) {
        const size_t e = i * 4; const int t = (int)(e / D);
        const float4 v = (t < TP) ? *(const float4*)(p.x_prompt + e) : *(const float4*)(p.x_sample + (e - (size_t)TP * D));
        ushort4 o; o.x = f2bf(v.x); o.y = f2bf(v.y); o.z = f2bf(v.z); o.w = f2bf(v.w);
        *(ushort4*)(p.xb + e) = o;
    }
    for (size_t i = gtid; i < (size_t)(SEQ + LS) * 8; i += gsz) {
        const int pi = (int)(i / 8), fi = (int)(i % 8);
        const float pos = (pi < SEQ) ? (float)pi : (float)(8192 + pi - SEQ);
        const float inv = powf(500000.0f, -(float)(2 * fi) / 16.0f);
        const float ang = pos * inv;
        float s, c; sincosf(ang, &s, &c);
        p.rope[(size_t)pi * 16 + fi] = c; p.rope[(size_t)pi * 16 + 8 + fi] = s;
    }
}

template <int TS>
__device__ __forceinline__ void gemm_mainloop(f32x4 (&acc)[TS / 32][TS / 32], const bf16_t* __restrict__ A, int lda, const bf16_t* __restrict__ Bt, int ldb,
                                              int K, int row0, int col0, char* smem) {
    constexpr int NI = TS / 64, F = TS / 32, WT = TS / 2, OPB = TS * 64, SS = 2 * OPB;
    const int tidx = tid_opaque();
    const int lane = tidx & 63, wid = tidx >> 6;
    const int wr = wid >> 1, wc = wid & 1;
    const int nk = K / 32;
    const int srow = wid * (16 * NI) + (lane >> 2), schk = (lane & 3) ^ (2 * (lane >> 5));
    const bf16_t* gA = A + (size_t)(row0 + srow) * lda + schk * 8;
    const bf16_t* gB = Bt + (size_t)(col0 + srow) * ldb + schk * 8;
    const unsigned lbase = __builtin_amdgcn_readfirstlane(lds_base_addr() + wid * (NI * 1024));
#define GSTAGE(stage, kt_) { const unsigned d_ = lbase + (stage) * SS; const int k0_ = (kt_) * 32; \
        glds16_asm(gA + k0_, d_); if (NI == 2) glds16_asm(gA + (size_t)16 * lda + k0_, d_ + 1024); \
        glds16_asm(gB + k0_, d_ + OPB); if (NI == 2) glds16_asm(gB + (size_t)16 * ldb + k0_, d_ + OPB + 1024); }
    const int fr = lane & 15, fq = lane >> 4;
    const int foff = fr * 64 + ((fq ^ (2 * (fr >> 3))) << 4);
    __syncthreads();
    GSTAGE(0, 0);
    if (nk > 1) GSTAGE(1, 1);
    if (nk > 2) GSTAGE(2, 2);
#pragma unroll 1
    for (int kt = 0; kt < nk; ++kt) {
        if (NI == 2) {
            if (kt + 2 < nk) asm volatile("s_waitcnt vmcnt(8)" ::: "memory");
            else if (kt + 1 < nk) asm volatile("s_waitcnt vmcnt(4)" ::: "memory");
            else asm volatile("s_waitcnt vmcnt(0)" ::: "memory");
        } else {
            if (kt + 2 < nk) asm volatile("s_waitcnt vmcnt(4)" ::: "memory");
            else if (kt + 1 < nk) asm volatile("s_waitcnt vmcnt(2)" ::: "memory");
            else asm volatile("s_waitcnt vmcnt(0)" ::: "memory");
        }
        __builtin_amdgcn_s_barrier();
        MEMFENCE();
        if (kt + 3 < nk) GSTAGE((kt + 3) & 3, kt + 3);
        const char* sA = smem + (kt & 3) * SS + foff;
        const char* sB = sA + OPB;
        bf16x8 af[F], bfr[F];
#pragma unroll
        for (int m = 0; m < F; ++m) af[m] = *(const bf16x8*)(sA + (wr * WT + m * 16) * 64);
#pragma unroll
        for (int n = 0; n < F; ++n) bfr[n] = *(const bf16x8*)(sB + (wc * WT + n * 16) * 64);
#pragma unroll
        for (int m = 0; m < F; ++m)
#pragma unroll
            for (int n = 0; n < F; ++n)
                acc[m][n] = __builtin_amdgcn_mfma_f32_16x16x32_bf16(bfr[n], af[m], acc[m][n], 0, 0, 0);
    }
    asm volatile("s_waitcnt lgkmcnt(0)" ::: "memory");
    __syncthreads();
#undef GSTAGE
}

struct TileCtx { int x, lb, nlb; };
__device__ __forceinline__ bool gemm_next(const TileCtx& tc, int it, int ntn, int& pm, int& pn, int& quarter) {
    const int total = (tc.x < 0 ? 136 : 17) * ntn;
    const int full_rounds = total / tc.nlb, nfull = full_rounds * tc.nlb;
    int i;
    if (it < full_rounds) { i = tc.lb + it * tc.nlb; quarter = -1; }
    else {
        const int qi = tc.lb + (it - full_rounds) * tc.nlb;
        if (qi >= 4 * (total - nfull)) return false;
        i = nfull + (qi >> 2); quarter = qi & 3;
    }
    if (tc.x < 0) { pm = i / ntn; pn = i % ntn; return true; }
    const int g = i / (17 * 8);
    const int w = (ntn - g * 8) < 8 ? (ntn - g * 8) : 8;
    const int r = i - g * 17 * 8;
    pm = tc.x * 17 + r / w; pn = g * 8 + r % w;
    return true;
}

template <int EPI, int TS>
__device__ __forceinline__ void gemm_tile_body(const Params& p, const bf16_t* __restrict__ A, const bf16_t* __restrict__ Bt, int K, int layer, int row0, int col0, char* smem) {
    constexpr int F = TS / 32, WT = TS / 2, ELD = TS * 2 + 16, CH = TS / 8, RPP = 256 / CH, NP = TS / RPP;
    const int tidx = tid_opaque();
    const int lane = tidx & 63, wid = tidx >> 6, wr = wid >> 1, wc = wid & 1;
    f32x4 acc[F][F];
#pragma unroll
    for (int m = 0; m < F; ++m)
#pragma unroll
        for (int n = 0; n < F; ++n) acc[m][n] = (f32x4){0.f, 0.f, 0.f, 0.f};
    gemm_mainloop<TS>(acc, A, K, Bt, K, K, row0, col0, smem);
    if (EPI == 0) {
        const int j = layer >> 1;
        if ((col0 & ~127) == C_AB || col0 < CONV_CH) {
#pragma unroll
            for (int m = 0; m < F; ++m) {
                const int row = row0 + wr * WT + m * 16 + (lane & 15);
#pragma unroll
                for (int n = 0; n < F; ++n) {
                    const int col = col0 + wc * WT + n * 16 + 4 * (lane >> 4);
                    const f32x4 v = acc[m][n];
                    if (col >= C_AB && col < C_AB + 8) *(float4*)(p.aux + (size_t)row * 8 + (col - C_AB)) = make_float4(v[0], v[1], v[2], v[3]);
                    if (col < CONV_CH) {
                        if (row < TP) {
                            const int b = row / SEQ, sq = row % SEQ;
                            if (sq >= SEQ - 3) *(float4*)(p.conv_p + (((size_t)j * NB + b) * 3 + (sq - (SEQ - 3))) * CONV_CH + col) = make_float4(v[0], v[1], v[2], v[3]);
                        } else {
                            const int r2 = row - TP, nn = r2 / LS, sq = r2 % LS;
                            if (sq >= LS - 3) *(float4*)(p.conv_s + (((size_t)j * NS + nn) * 3 + (sq - (LS - 3))) * CONV_CH + col) = make_float4(v[0], v[1], v[2], v[3]);
                        }
                    }
                }
            }
        }
    }
#pragma unroll
    for (int m = 0; m < F; ++m) {
        const int r = wr * WT + m * 16 + (lane & 15);
#pragma unroll
        for (int n = 0; n < F; ++n) {
            const int c = wc * WT + n * 16 + 4 * (lane >> 4);
            uint2 o; o.x = pack_bf16(acc[m][n][0], acc[m][n][1]); o.y = pack_bf16(acc[m][n][2], acc[m][n][3]);
            *(uint2*)(smem + r * ELD + c * 2) = o;
        }
    }
    __syncthreads();
    const int chunk = tidx & (CH - 1), rbase = tidx / CH;
#pragma unroll
    for (int i = 0; i < NP; ++i) {
        const int rl = rbase + RPP * i, row = row0 + rl, col = col0 + chunk * 8;
        const uint4 sv = *(const uint4*)(smem + rl * ELD + chunk * 16);
        if (EPI == 0) *(uint4*)(p.proj + (size_t)row * EVEN_LD + col) = sv;
        else if (EPI == 1) *(uint4*)(p.proj + (size_t)row * ODD_LD + col) = sv;
        else if (EPI == 3) *(uint4*)(p.p2 + (size_t)row * D + col) = sv;
        else {
            const float4 a0 = unpack4(make_uint2(sv.x, sv.y)), a1 = unpack4(make_uint2(sv.z, sv.w));
            if (EPI == 2) {
                uint4* xp = (uint4*)(p.xb + (size_t)row * D + col);
                const uint4 xv = *xp;
                const float4 x0 = unpack4(make_uint2(xv.x, xv.y)), x1 = unpack4(make_uint2(xv.z, xv.w));
                uint4 o;
                o.x = pack_bf16(ALPHA * x0.x + a0.x, ALPHA * x0.y + a0.y); o.y = pack_bf16(ALPHA * x0.z + a0.z, ALPHA * x0.w + a0.w);
                o.z = pack_bf16(ALPHA * x1.x + a1.x, ALPHA * x1.y + a1.y); o.w = pack_bf16(ALPHA * x1.z + a1.z, ALPHA * x1.w + a1.w);
                *xp = o;
            } else {
                const uint4 hv = *(const uint4*)(p.qb + (size_t)row * D + col);
                const uint4 pv = *(const uint4*)(p.p2 + (size_t)row * D + col);
                const float4 x0 = unpack4(make_uint2(hv.x, hv.y)), x1 = unpack4(make_uint2(hv.z, hv.w));
                const float4 p0 = unpack4(make_uint2(pv.x, pv.y)), p1 = unpack4(make_uint2(pv.z, pv.w));
                float4 o0, o1;
                o0.x = x0.x + sigmoidf_(a0.x) * p0.x; o0.y = x0.y + sigmoidf_(a0.y) * p0.y; o0.z = x0.z + sigmoidf_(a0.z) * p0.z; o0.w = x0.w + sigmoidf_(a0.w) * p0.w;
                o1.x = x1.x + sigmoidf_(a1.x) * p1.x; o1.y = x1.y + sigmoidf_(a1.y) * p1.y; o1.z = x1.z + sigmoidf_(a1.z) * p1.z; o1.w = x1.w + sigmoidf_(a1.w) * p1.w;
                if (layer == 3) {
                    float* yp = (row < TP) ? p.y_prompt + (size_t)row * D + col : p.y_sample + (size_t)(row - TP) * D + col;
                    *(float4*)yp = o0; *(float4*)(yp + 4) = o1;
                } else {
                    uint4 ob; ob.x = pack_bf16(o0.x, o0.y); ob.y = pack_bf16(o0.z, o0.w); ob.z = pack_bf16(o1.x, o1.y); ob.w = pack_bf16(o1.z, o1.w);
                    *(uint4*)(p.xb + (size_t)row * D + col) = ob;
                }
            }
        }
    }
}

__device__ __forceinline__ void gemm_mainloop_256(f32x4 (&acc)[8][4], const bf16_t* __restrict__ A, int lda, const bf16_t* __restrict__ Bt, int ldb,
                                                  int K, int row0, int col0, char* smem) {
    const int tidx = tid_opaque();
    const int lane = tidx & 63, wid = tidx >> 6;
    const int wr = wid >> 1, wc = wid & 1;
    const int nk = K / 32;
    const int schk = (lane & 3) ^ (2 * (lane >> 5));
    const bf16_t* gA = A + (size_t)(row0 + wid * 64 + (lane >> 2)) * lda + schk * 8;
    const bf16_t* gB = Bt + (size_t)(col0 + wid * 32 + (lane >> 2)) * ldb + schk * 8;
    const unsigned lA = __builtin_amdgcn_readfirstlane(lds_base_addr() + wid * 4096);
    const unsigned lB = __builtin_amdgcn_readfirstlane(lds_base_addr() + 16384 + wid * 2048);
#define GSTAGE2(stage, kt_) { const int k0_ = (kt_) * 32; const unsigned so_ = (stage) * 24576; \
        glds16_asm(gA + k0_, lA + so_); glds16_asm(gA + (size_t)16 * lda + k0_, lA + so_ + 1024); glds16_asm(gA + (size_t)32 * lda + k0_, lA + so_ + 2048); glds16_asm(gA + (size_t)48 * lda + k0_, lA + so_ + 3072); \
        glds16_asm(gB + k0_, lB + so_); glds16_asm(gB + (size_t)16 * ldb + k0_, lB + so_ + 1024); }
    const int fr = lane & 15, fq = lane >> 4;
    const int foff = fr * 64 + ((fq ^ (2 * (fr >> 3))) << 4);
    __syncthreads();
    GSTAGE2(0, 0);
    if (nk > 1) GSTAGE2(1, 1);
    int st = 0;
#pragma unroll 1
    for (int kt = 0; kt < nk; ++kt) {
        if (kt + 1 < nk) asm volatile("s_waitcnt vmcnt(6)" ::: "memory");
        else asm volatile("s_waitcnt vmcnt(0)" ::: "memory");
        __builtin_amdgcn_s_barrier();
        MEMFENCE();
        const int st2 = (st == 0) ? 2 : st - 1;
        if (kt + 2 < nk) GSTAGE2(st2, kt + 2);
        const char* sA = smem + st * 24576 + foff;
        const char* sB = sA + 16384;
        bf16x8 bfr[4];
#pragma unroll
        for (int n = 0; n < 4; ++n) bfr[n] = *(const bf16x8*)(sB + (wc * 64 + n * 16) * 64);
#pragma unroll
        for (int m = 0; m < 8; ++m) {
            const bf16x8 af = *(const bf16x8*)(sA + (wr * 128 + m * 16) * 64);
#pragma unroll
            for (int n = 0; n < 4; ++n)
                acc[m][n] = __builtin_amdgcn_mfma_f32_16x16x32_bf16(bfr[n], af, acc[m][n], 0, 0, 0);
        }
        st = (st == 2) ? 0 : st + 1;
    }
    asm volatile("s_waitcnt lgkmcnt(0)" ::: "memory");
    __syncthreads();
#undef GSTAGE2
}

template <int EPI>
__device__ __forceinline__ void gemm_tile_256(const Params& p, const bf16_t* __restrict__ A, const bf16_t* __restrict__ Bt, int K, int layer, int row0, int col0, char* smem) {
    constexpr int ELD = 272;
    const int tidx = tid_opaque();
    const int lane = tidx & 63, wid = tidx >> 6, wr = wid >> 1, wc = wid & 1;
    f32x4 acc[8][4];
#pragma unroll
    for (int m = 0; m < 8; ++m)
#pragma unroll
        for (int n = 0; n < 4; ++n) acc[m][n] = (f32x4){0.f, 0.f, 0.f, 0.f};
    gemm_mainloop_256(acc, A, K, Bt, K, K, row0, col0, smem);
    if (EPI == 0) {
        const int j = layer >> 1;
        if (col0 == C_AB || col0 < CONV_CH) {
#pragma unroll
            for (int m = 0; m < 8; ++m) {
                const int row = row0 + wr * 128 + m * 16 + (lane & 15);
#pragma unroll
                for (int n = 0; n < 4; ++n) {
                    const int col = col0 + wc * 64 + n * 16 + 4 * (lane >> 4);
                    const f32x4 v = acc[m][n];
                    if (col >= C_AB && col < C_AB + 8) *(float4*)(p.aux + (size_t)row * 8 + (col - C_AB)) = make_float4(v[0], v[1], v[2], v[3]);
                    if (col < CONV_CH) {
                        if (row < TP) {
                            const int b = row / SEQ, sq = row % SEQ;
                            if (sq >= SEQ - 3) *(float4*)(p.conv_p + (((size_t)j * NB + b) * 3 + (sq - (SEQ - 3))) * CONV_CH + col) = make_float4(v[0], v[1], v[2], v[3]);
                        } else {
                            const int r2 = row - TP, nn = r2 / LS, sq = r2 % LS;
                            if (sq >= LS - 3) *(float4*)(p.conv_s + (((size_t)j * NS + nn) * 3 + (sq - (LS - 3))) * CONV_CH + col) = make_float4(v[0], v[1], v[2], v[3]);
                        }
                    }
                }
            }
        }
    }
#pragma unroll
    for (int hf = 0; hf < 2; ++hf) {
        if (wr == hf) {
#pragma unroll
            for (int m = 0; m < 8; ++m) {
                const int r = m * 16 + (lane & 15);
#pragma unroll
                for (int n = 0; n < 4; ++n) {
                    const int c = wc * 64 + n * 16 + 4 * (lane >> 4);
                    uint2 o; o.x = pack_bf16(acc[m][n][0], acc[m][n][1]); o.y = pack_bf16(acc[m][n][2], acc[m][n][3]);
                    *(uint2*)(smem + r * ELD + c * 2) = o;
                }
            }
        }
        __syncthreads();
        const int chunk = tidx & 15, rbase = tidx >> 4;
#pragma unroll
        for (int i = 0; i < 8; ++i) {
            const int rl = rbase + 16 * i, row = row0 + hf * 128 + rl, col = col0 + chunk * 8;
            const uint4 sv = *(const uint4*)(smem + rl * ELD + chunk * 16);
            if (EPI == 0) *(uint4*)(p.proj + (size_t)row * EVEN_LD + col) = sv;
            else *(uint4*)(p.proj + (size_t)row * ODD_LD + col) = sv;
        }
        __syncthreads();
    }
}

template <int EPI>
__device__ __forceinline__ void ph_gemm_in(const Params& p, const bf16_t* __restrict__ A, const bf16_t* __restrict__ Bt, int N, int K, int layer, char* smem) {
    const int ntn = N / 128, nt = 68 * ntn, G = gridDim.x;
    const int full = nt / G;
    for (int it = 0; it < full; ++it) {
        const int i = blockIdx.x + it * G;
        gemm_tile_256<EPI>(p, A, Bt, K, layer, (i / ntn) * 256, (i % ntn) * 128, smem);
    }
    const int rem = nt - full * G;
    for (int q = blockIdx.x; q < 2 * rem; q += G) {
        const int i = full * G + (q >> 1);
        gemm_tile_body<EPI, 128>(p, A, Bt, K, layer, (i / ntn) * 256 + (q & 1) * 128, (i % ntn) * 128, smem);
    }
}

template <int EPI>
__device__ __forceinline__ void ph_gemm(const Params& p, const TileCtx& tc, const bf16_t* __restrict__ A, const bf16_t* __restrict__ Bt, int N, int K, int layer, char* smem) {
    const int ntn = N / 128;
    for (int it = 0;; ++it) {
        int pm, pn, quarter;
        if (!gemm_next(tc, it, ntn, pm, pn, quarter)) break;
        if (quarter < 0) gemm_tile_body<EPI, 128>(p, A, Bt, K, layer, pm * 128, pn * 128, smem);
        else gemm_tile_body<EPI, 64>(p, A, Bt, K, layer, pm * 128 + (quarter >> 1) * 64, pn * 128 + (quarter & 1) * 64, smem);
    }
}

__device__ __forceinline__ void ph_layernorm(const Params& p, int layer, char* smem) {
    const int tidx = tid_opaque();
    const float* g = p.ln_g + (size_t)layer * D; const float* b = p.ln_b + (size_t)layer * D;
    const int lane = tidx & 63;
    const int wave = blockIdx.x * 4 + (tidx >> 6), nw = gridDim.x * 4;
    for (int row = wave; row < T; row += nw) {
        const bf16_t* xr = p.xb + (size_t)row * D + lane * 8;
        float v[2][8];
#pragma unroll
        for (int u = 0; u < 2; ++u) unpack8(*(const uint4*)(xr + u * 512), v[u]);
        float s = 0.f;
#pragma unroll
        for (int u = 0; u < 2; ++u)
#pragma unroll
            for (int i = 0; i < 8; ++i) s += v[u][i];
        for (int o = 32; o > 0; o >>= 1) s += __shfl_xor(s, o);
        const float mu = s * (1.0f / D);
        float q = 0.f;
#pragma unroll
        for (int u = 0; u < 2; ++u)
#pragma unroll
            for (int i = 0; i < 8; ++i) { v[u][i] -= mu; q += v[u][i] * v[u][i]; }
        for (int o = 32; o > 0; o >>= 1) q += __shfl_xor(q, o);
        const float rs = rsqrtf(q * (1.0f / D) + EPS);
#pragma unroll
        for (int u = 0; u < 2; ++u) {
            const float* gp = g + lane * 8 + u * 512; const float* bp = b + lane * 8 + u * 512;
            const float4 g0 = *(const float4*)gp, g1 = *(const float4*)(gp + 4), b0 = *(const float4*)bp, b1 = *(const float4*)(bp + 4);
            uint4 ob;
            ob.x = pack_bf16(v[u][0] * rs * g0.x + b0.x, v[u][1] * rs * g0.y + b0.y); ob.y = pack_bf16(v[u][2] * rs * g0.z + b0.z, v[u][3] * rs * g0.w + b0.w);
            ob.z = pack_bf16(v[u][4] * rs * g1.x + b1.x, v[u][5] * rs * g1.y + b1.y); ob.w = pack_bf16(v[u][6] * rs * g1.z + b1.z, v[u][7] * rs * g1.w + b1.w);
            *(uint4*)(p.qb + (size_t)row * D + lane * 8 + u * 512) = ob;
        }
    }
}

__device__ __forceinline__ void ph_conv_p(const Params& p, int layer) {
    const int tidx = tid_opaque();
    const size_t gtid = (size_t)blockIdx.x * 256 + tidx, gsz = (size_t)gridDim.x * 256;
    for (size_t i = gtid; i < (size_t)T * PLE / 4; i += gsz) {
        const size_t e = i * 4;
        const int t = (int)(e / PLE);
        const float4 v = (t < TP) ? *(const float4*)(p.p_prompt + (size_t)layer * TP * PLE + e) : *(const float4*)(p.p_sample + (size_t)layer * TS * PLE + (e - (size_t)TP * PLE));
        ushort4 o; o.x = f2bf(v.x); o.y = f2bf(v.y); o.z = f2bf(v.z); o.w = f2bf(v.w);
        *(ushort4*)(p.pb + e) = o;
    }
}

__device__ __forceinline__ void tok_info(int t, int& smp, int& seq, int& s) {
    if (t < TP) { smp = 0; seq = t / SEQ; s = t % SEQ; } else { smp = 1; seq = (t - TP) / LS; s = (t - TP) % LS; }
}

__device__ __forceinline__ void ph_dn_pre(const Params& p, int j) {
    const int tidx = tid_opaque();
    const int lane = tidx & 63;
    const int wave = blockIdx.x * 4 + (tidx >> 6), nw = gridDim.x * 4;
    const float* cw = p.conv_w + (size_t)j * 4 * CONV_CH;
    for (int item = TP * 4 + wave; item < T * 4; item += nw) {
        const int t = item >> 2, h = item & 3;
        int smp, seq, s; tok_info(t, smp, seq, s);
        float out[3][2];
#pragma unroll
        for (int part = 0; part < 3; ++part) {
#pragma unroll
            for (int u = 0; u < 2; ++u) {
                const int c = part * 512 + h * 128 + lane + 64 * u;
                float y = 0.f;
#pragma unroll
                for (int jj = 0; jj < 4; ++jj) {
                    const int sp = s - 3 + jj;
                    float xv;
                    if (sp >= 0) xv = bf2f(p.proj[(size_t)(t - 3 + jj) * EVEN_LD + C_QKV + c]);
                    else if (smp) xv = p.state_conv[(((size_t)j * NS + seq) * 3 + (sp + 3)) * CONV_CH + c];
                    else xv = 0.f;
                    y += cw[jj * CONV_CH + c] * xv;
                }
                out[part][u] = siluf_(y);
            }
        }
#pragma unroll
        for (int part = 0; part < 2; ++part) {
            float ss = out[part][0] * out[part][0] + out[part][1] * out[part][1];
            for (int o = 32; o > 0; o >>= 1) ss += __shfl_xor(ss, o);
            const float r = rsqrtf(ss + EPS);
            out[part][0] *= r; out[part][1] *= r;
        }
#pragma unroll
        for (int part = 0; part < 3; ++part)
#pragma unroll
            for (int u = 0; u < 2; ++u)
                p.dnqkv[(size_t)(t - TP) * CONV_CH + part * 512 + h * 128 + lane + 64 * u] = f2bf(out[part][u]);
        if (lane == 0) {
            const float a_in = p.aux[(size_t)t * 8 + h], b_in = p.aux[(size_t)t * 8 + 4 + h];
            const float g = -__expf(p.a_log[j * 4 + h]) * softplusf_(a_in + p.dt_bias[j * 4 + h]);
            p.dngb[(size_t)(t - TP) * 8 + h] = g;
            p.dngb[(size_t)(t - TP) * 8 + 4 + h] = sigmoidf_(b_in);
        }
    }
}

__device__ __forceinline__ void ph_dn_rec(const Params& p, int j, int bid, int nblk) {
    const int tidx = tid_opaque();
    const int lane = tidx & 63;
    const int wave = (tidx >> 6) * nblk + bid, nw = nblk * 4;
    const int e = lane & 3, dg = lane >> 2;
    const int nitems = (NB + NS) * 4 * 32;
    for (int item = NB * 4 * 32 + wave; item < nitems; item += nw) {
        const int es = item & 31, h = (item >> 5) & 3, st = item >> 7;
        const int smp = st >= NB, seq = smp ? st - NB : st;
        const int t0 = smp ? TP + seq * LS : seq * SEQ, len = smp ? LS : SEQ;
        const int ec = es * 4 + e;
        float S[8];
        if (smp) {
            const float* s0 = p.state_delta + (((size_t)j * NS + seq) * 4 + h) * 128 * 128;
#pragma unroll
            for (int i = 0; i < 8; ++i) S[i] = s0[(size_t)(dg * 8 + i) * 128 + ec];
        } else {
#pragma unroll
            for (int i = 0; i < 8; ++i) S[i] = 0.f;
        }
        for (int s = 0; s < len; ++s) {
            const int t = t0 + s;
            const bf16x8 qv = *(const bf16x8*)(p.dnqkv + (size_t)(t - TP) * CONV_CH + h * 128 + dg * 8);
            const bf16x8 kv = *(const bf16x8*)(p.dnqkv + (size_t)(t - TP) * CONV_CH + 512 + h * 128 + dg * 8);
            const float v = bf2f(p.dnqkv[(size_t)(t - TP) * CONV_CH + 1024 + h * 128 + ec]);
            const float g = p.dngb[(size_t)(t - TP) * 8 + h], beta = p.dngb[(size_t)(t - TP) * 8 + 4 + h];
            float q[8], k[8];
#pragma unroll
            for (int i = 0; i < 8; ++i) { q[i] = bf2f((bf16_t)qv[i]); k[i] = bf2f((bf16_t)kv[i]); }
            float kS = 0.f, qS = 0.f, qk = 0.f;
#pragma unroll
            for (int i = 0; i < 8; ++i) { kS += k[i] * S[i]; qS += q[i] * S[i]; qk += q[i] * k[i]; }
            for (int o = 4; o < 64; o <<= 1) { kS += __shfl_xor(kS, o); qS += __shfl_xor(qS, o); qk += __shfl_xor(qk, o); }
            const float a = __expf(g);
            const float vn = beta * (v - a * kS);
            const float o = 0.08838834764831845f * (a * qS + qk * vn);
#pragma unroll
            for (int i = 0; i < 8; ++i) S[i] = a * S[i] + k[i] * vn;
            if (dg == 0) p.dno[(size_t)(t - TP) * 512 + h * 128 + ec] = o;
        }
        float* so = smp ? p.delta_s + (((size_t)j * NS + seq) * 4 + h) * 128 * 128 : p.delta_p + (((size_t)j * NB + seq) * 4 + h) * 128 * 128;
#pragma unroll
        for (int i = 0; i < 8; ++i) so[(size_t)(dg * 8 + i) * 128 + ec] = S[i];
    }
}

__device__ __forceinline__ void ph_dn_post(const Params& p, int j) {
    const int tidx = tid_opaque();
    const int lane = tidx & 63;
    const int wave = blockIdx.x * 4 + (tidx >> 6), nw = gridDim.x * 4;
    for (int item = TP * 4 + wave; item < T * 4; item += nw) {
        const int t = item >> 2, h = item & 3;
        const float o0 = p.dno[(size_t)(t - TP) * 512 + h * 128 + lane], o1 = p.dno[(size_t)(t - TP) * 512 + h * 128 + lane + 64];
        float ss = o0 * o0 + o1 * o1;
        for (int o = 32; o > 0; o >>= 1) ss += __shfl_xor(ss, o);
        const float r = rsqrtf(ss * (1.0f / 128.0f) + EPS);
        const float g0 = bf2f(p.proj[(size_t)t * EVEN_LD + C_GA + h * 128 + lane]), g1 = bf2f(p.proj[(size_t)t * EVEN_LD + C_GA + h * 128 + lane + 64]);
        p.qb[(size_t)t * D + h * 128 + lane] = f2bf(o0 * r * p.norm_a[j * 128 + lane] * siluf_(g0));
        p.qb[(size_t)t * D + h * 128 + lane + 64] = f2bf(o1 * r * p.norm_a[j * 128 + lane + 64] * siluf_(g1));
    }
}


constexpr int DR_N = 0, DR_B = 32768, DR_Q = 65536, DR_O = 81920, DR_SIZE = 98304;
constexpr int DN_R1 = 0, DN_R2 = 16384, DN_R3 = 32768, DN_R4 = 49152, DN_R5 = 58368;


__device__ __forceinline__ void ph_dn_prep(const Params& p, int j, char* smem) {
    char* const smem0 = smem;
    const float* cw = p.conv_w + (size_t)j * 4 * CONV_CH;
    for (int item = blockIdx.x; item < 16 * 64; item += gridDim.x) {
        const int st = item >> 6, c = item & 63, b = st >> 2, h = st & 3;
        const int t0 = b * SEQ + c * 64;
        char* rec = p.dnrec + (size_t)item * DR_SIZE;
        const int tidx = tid_opaque();
        char* smem = smem0; LAUNDER(smem);
        float* sG = (float*)(smem + DN_R5);
        float* sBeta = sG + 64;
        float* sRq = sBeta + 64;
        float* sRk = sRq + 64;
        float* sFw = sRk + 64;
        float* sFk = sFw + 64;
        float* sg0 = sFk + 64;
        float* sA = (float*)(smem + DN_R1);
        const int lane = tidx & 63, wid = tidx >> 6, n = lane & 15, q = lane >> 4;
        __syncthreads();
        if (tidx < 64) {
            const int t = t0 + tidx;
            const float a_in = p.aux[(size_t)t * 8 + h], b_in = p.aux[(size_t)t * 8 + 4 + h];
            sg0[tidx] = -__expf(p.a_log[j * 4 + h]) * softplusf_(a_in + p.dt_bias[j * 4 + h]);
            sBeta[tidx] = sigmoidf_(b_in);
        }
        __syncthreads();
        if (tidx < 64) {
            float G = 0.f;
            for (int k = 0; k <= tidx; ++k) G += sg0[k];
            sG[tidx] = G;
        }
        float X[64];
        {
            const int cch = tidx & 127;
            if (tidx < 128) {
                const int colq = h * 128 + cch, colk = 512 + h * 128 + cch;
                const float wq0 = cw[colq], wq1 = cw[CONV_CH + colq], wq2 = cw[2 * CONV_CH + colq], wq3 = cw[3 * CONV_CH + colq];
                const float wk0 = cw[colk], wk1 = cw[CONV_CH + colk], wk2 = cw[2 * CONV_CH + colk], wk3 = cw[3 * CONV_CH + colk];
                float q0 = 0.f, q1 = 0.f, q2 = 0.f, k0 = 0.f, k1 = 0.f, k2 = 0.f;
                if (c > 0) {
                    const bf16_t* r0 = p.proj + (size_t)(t0 - 3) * EVEN_LD + C_QKV;
                    q0 = bf2f(r0[colq]); q1 = bf2f(r0[EVEN_LD + colq]); q2 = bf2f(r0[2 * EVEN_LD + colq]);
                    k0 = bf2f(r0[colk]); k1 = bf2f(r0[EVEN_LD + colk]); k2 = bf2f(r0[2 * EVEN_LD + colk]);
                }
                const bf16_t* r = p.proj + (size_t)t0 * EVEN_LD + C_QKV + colq;
                bf16_t lq[8], lk[8], nq[8], nk[8];
#pragma unroll
                for (int u = 0; u < 8; ++u) { lq[u] = r[(size_t)u * EVEN_LD]; lk[u] = r[(size_t)u * EVEN_LD + 512]; }
#pragma unroll
                for (int bb = 0; bb < 8; ++bb) {
                    if (bb < 7) {
#pragma unroll
                        for (int u = 0; u < 8; ++u) { nq[u] = r[(size_t)(bb * 8 + 8 + u) * EVEN_LD]; nk[u] = r[(size_t)(bb * 8 + 8 + u) * EVEN_LD + 512]; }
                    }
#pragma unroll
                    for (int u = 0; u < 8; ++u) {
                        const int i = bb * 8 + u;
                        const float q3 = bf2f(lq[u]), k3 = bf2f(lk[u]);
                        const float yq = siluf_(wq0 * q0 + wq1 * q1 + wq2 * q2 + wq3 * q3);
                        const float yk = siluf_(wk0 * k0 + wk1 * k1 + wk2 * k2 + wk3 * k3);
                        q0 = q1; q1 = q2; q2 = q3; k0 = k1; k1 = k2; k2 = k3;
                        X[i] = yk;
                        *(bf16_t*)(smem + DN_R1 + i * 256 + ((((cch >> 3) ^ (i & 15)) << 4) | ((cch & 7) << 1))) = f2bf(yq);
                        *(bf16_t*)(smem + DN_R2 + i * 256 + ((((cch >> 3) ^ (i & 15)) << 4) | ((cch & 7) << 1))) = f2bf(yk);
                        *(bf16_t*)(smem + DN_R3 + cch * 128 + ((((i >> 3) ^ (cch & 7)) << 4) | ((i & 7) << 1))) = f2bf(yk);
                    }
#pragma unroll
                    for (int u = 0; u < 8; ++u) { lq[u] = nq[u]; lk[u] = nk[u]; asm volatile("" : "+v"(X[bb * 8 + u])); }
                    MEMFENCE();
                }
            } else {
                const int colv = 1024 + h * 128 + cch;
                const float w0 = cw[colv], w1 = cw[CONV_CH + colv], w2 = cw[2 * CONV_CH + colv], w3 = cw[3 * CONV_CH + colv];
                float v0 = 0.f, v1 = 0.f, v2 = 0.f;
                if (c > 0) {
                    const bf16_t* r0 = p.proj + (size_t)(t0 - 3) * EVEN_LD + C_QKV;
                    v0 = bf2f(r0[colv]); v1 = bf2f(r0[EVEN_LD + colv]); v2 = bf2f(r0[2 * EVEN_LD + colv]);
                }
                const bf16_t* r = p.proj + (size_t)t0 * EVEN_LD + C_QKV + colv;
                bf16_t lv[8], nv[8];
#pragma unroll
                for (int u = 0; u < 8; ++u) lv[u] = r[(size_t)u * EVEN_LD];
#pragma unroll
                for (int bb = 0; bb < 8; ++bb) {
                    if (bb < 7) {
#pragma unroll
                        for (int u = 0; u < 8; ++u) nv[u] = r[(size_t)(bb * 8 + 8 + u) * EVEN_LD];
                    }
#pragma unroll
                    for (int u = 0; u < 8; ++u) {
                        const float v3 = bf2f(lv[u]);
                        X[bb * 8 + u] = siluf_(w0 * v0 + w1 * v1 + w2 * v2 + w3 * v3);
                        v0 = v1; v1 = v2; v2 = v3;
                    }
#pragma unroll
                    for (int u = 0; u < 8; ++u) { lv[u] = nv[u]; asm volatile("" : "+v"(X[bb * 8 + u])); }
                    MEMFENCE();
                }
            }
        }
        __syncthreads();
        {
            const int i = tidx >> 2, qt = tidx & 3;
            float sq = 0.f, sk = 0.f;
#pragma unroll
            for (int u = 0; u < 4; ++u) {
                const int chn = (qt * 4 + u) ^ (i & 15);
                const bf16x8 a = *(const bf16x8*)(smem + DN_R1 + i * 256 + (chn << 4));
                const bf16x8 bb = *(const bf16x8*)(smem + DN_R2 + i * 256 + (chn << 4));
#pragma unroll
                for (int e = 0; e < 8; ++e) { const float x = bf2f((bf16_t)a[e]), y = bf2f((bf16_t)bb[e]); sq += x * x; sk += y * y; }
            }
            sq += __shfl_xor(sq, 1); sq += __shfl_xor(sq, 2);
            sk += __shfl_xor(sk, 1); sk += __shfl_xor(sk, 2);
            if (qt == 0) {
                const float rq = rsqrtf(sq + EPS) * 0.08838834764831845f, rk = rsqrtf(sk + EPS);
                const float G = sG[i], Gl = sG[63];
                sRq[i] = rq; sRk[i] = rk;
                sFw[i] = rk * sBeta[i] * __expf(G);
                sFk[i] = rk * __expf(Gl - G);
            }
        }
        __syncthreads();
        {
            const int dd = tidx & 127, cg = tidx >> 7;
#pragma unroll
            for (int u = 0; u < 4; ++u) {
                const int chn = cg * 4 + u;
                char* ptr = smem + DN_R3 + dd * 128 + ((chn ^ (dd & 7)) << 4);
                const uint4 v = *(const uint4*)ptr;
                const float* f = sFk + chn * 8;
                uint4 o;
                o.x = pack_bf16(__uint_as_float(v.x << 16) * f[0], __uint_as_float(v.x & 0xffff0000u) * f[1]);
                o.y = pack_bf16(__uint_as_float(v.y << 16) * f[2], __uint_as_float(v.y & 0xffff0000u) * f[3]);
                o.z = pack_bf16(__uint_as_float(v.z << 16) * f[4], __uint_as_float(v.z & 0xffff0000u) * f[5]);
                o.w = pack_bf16(__uint_as_float(v.w << 16) * f[6], __uint_as_float(v.w & 0xffff0000u) * f[7]);
                *(uint4*)ptr = o;
            }
        }
        const int irow = wid * 16 + n;
        {
            const float fq = sRq[irow] * __expf(sG[irow]);
#pragma unroll
            for (int kk = 0; kk < 4; ++kk) {
                uint4 o;
                {
                    const int chn = ((2 * kk) * 2 + (q >> 1)) ^ (irow & 15);
                    const float4 f = unpack4(*(const uint2*)(smem + DN_R1 + irow * 256 + (chn << 4) + ((q & 1) << 3)));
                    o.x = pack_bf16(f.x * fq, f.y * fq); o.y = pack_bf16(f.z * fq, f.w * fq);
                }
                {
                    const int chn = ((2 * kk + 1) * 2 + (q >> 1)) ^ (irow & 15);
                    const float4 f = unpack4(*(const uint2*)(smem + DN_R1 + irow * 256 + (chn << 4) + ((q & 1) << 3)));
                    o.z = pack_bf16(f.x * fq, f.y * fq); o.w = pack_bf16(f.z * fq, f.w * fq);
                }
                *(uint4*)(rec + DR_Q + (((wid * 4 + kk) * 64) + lane) * 16) = o;
            }
        }
        {
            bf16x8 kfi[4], qfi[4];
#pragma unroll
            for (int kk = 0; kk < 4; ++kk) {
                const int chn = (kk * 4 + q) ^ (irow & 15);
                kfi[kk] = *(const bf16x8*)(smem + DN_R2 + irow * 256 + (chn << 4));
                qfi[kk] = *(const bf16x8*)(smem + DN_R1 + irow * 256 + (chn << 4));
            }
            const float Gi = sG[irow], bi = sBeta[irow], rki = sRk[irow], rqi = sRq[irow];
            __syncthreads();
#pragma unroll
            for (int jt = 0; jt < 4; ++jt) {
                f32x4 aA = {0.f, 0.f, 0.f, 0.f}, aQ = {0.f, 0.f, 0.f, 0.f};
                if (jt <= wid) {
                    const int jrow = jt * 16 + n;
#pragma unroll
                    for (int kk = 0; kk < 4; ++kk) {
                        const int chn = (kk * 4 + q) ^ (jrow & 15);
                        const bf16x8 kfj = *(const bf16x8*)(smem + DN_R2 + jrow * 256 + (chn << 4));
                        aA = __builtin_amdgcn_mfma_f32_16x16x32_bf16(kfj, kfi[kk], aA, 0, 0, 0);
                        aQ = __builtin_amdgcn_mfma_f32_16x16x32_bf16(kfj, qfi[kk], aQ, 0, 0, 0);
                    }
                }
                float qkv[4], av[4];
#pragma unroll
                for (int rr = 0; rr < 4; ++rr) {
                    const int jj = jt * 16 + 4 * q + rr;
                    const float dec = (jj <= irow) ? __expf(Gi - sG[jj]) : 0.f;
                    const float rkj = sRk[jj];
                    qkv[rr] = rqi * rkj * aQ[rr] * dec;
                    av[rr] = (jj < irow) ? bi * rki * rkj * aA[rr] * dec : 0.f;
                }
                uint2 o; o.x = pack_bf16(qkv[0], qkv[1]); o.y = pack_bf16(qkv[2], qkv[3]);
                *(uint2*)(smem + DN_R4 + irow * 144 + (jt * 16 + 4 * q) * 2) = o;
                *(float4*)(sA + irow * 64 + jt * 16 + 4 * q) = make_float4(av[0], av[1], av[2], av[3]);
            }
        }
        __syncthreads();
        {
            const float* fac = (tidx < 128) ? sFw : sBeta;
            const float* sAl = sA;
            asm volatile("" : "+v"(sAl));
#pragma unroll
            for (int i4 = 0; i4 < 16; ++i4) {
                const float4 f = *(const float4*)(fac + i4 * 4);
                X[i4 * 4] *= f.x; X[i4 * 4 + 1] *= f.y; X[i4 * 4 + 2] *= f.z; X[i4 * 4 + 3] *= f.w;
            }
#pragma unroll
            for (int ib = 0; ib < 8; ++ib) {
                float a[8];
#pragma unroll
                for (int r = 0; r < 8; ++r) a[r] = X[8 * ib + r];
#pragma unroll
                for (int jb = 0; jb < 2 * ib; ++jb) {
#pragma unroll
                    for (int r = 0; r < 8; ++r) {
                        const float4 av = *(const float4*)(sAl + (8 * ib + r) * 64 + 4 * jb);
                        a[r] -= av.x * X[4 * jb]; a[r] -= av.y * X[4 * jb + 1]; a[r] -= av.z * X[4 * jb + 2]; a[r] -= av.w * X[4 * jb + 3];
                    }
                }
#pragma unroll
                for (int r = 1; r < 8; ++r) {
                    const float4 d0 = *(const float4*)(sAl + (8 * ib + r) * 64 + 8 * ib), d1 = *(const float4*)(sAl + (8 * ib + r) * 64 + 8 * ib + 4);
                    const float dv[8] = {d0.x, d0.y, d0.z, d0.w, d1.x, d1.y, d1.z, d1.w};
#pragma unroll
                    for (int c = 0; c < 8; ++c) if (c < r) a[r] -= dv[c] * a[c];
                }
#pragma unroll
                for (int r = 0; r < 8; ++r) X[8 * ib + r] = a[r];
                asm volatile("" : "+v"(X[8 * ib]), "+v"(X[8 * ib + 1]), "+v"(X[8 * ib + 2]), "+v"(X[8 * ib + 3]), "+v"(X[8 * ib + 4]), "+v"(X[8 * ib + 5]), "+v"(X[8 * ib + 6]), "+v"(X[8 * ib + 7]) :: "memory");
            }
        }
        __syncthreads();
        {
            const int cch = tidx & 127;
            char* base = smem + ((tidx < 128) ? DN_R2 : DN_R1) + cch * 128;
#pragma unroll
            for (int chn = 0; chn < 8; ++chn) {
                uint4 o;
                o.x = pack_bf16(X[chn * 8 + 0], X[chn * 8 + 1]); o.y = pack_bf16(X[chn * 8 + 2], X[chn * 8 + 3]);
                o.z = pack_bf16(X[chn * 8 + 4], X[chn * 8 + 5]); o.w = pack_bf16(X[chn * 8 + 6], X[chn * 8 + 7]);
                *(uint4*)(base + ((chn ^ (cch & 7)) << 4)) = o;
            }
        }
        if (tidx == 0) p.dngl[item] = __expf(sG[63]);
        __syncthreads();
#define TFRAG(REG, r0, kj) (*(const bf16x8*)(smem + (REG) + ((r0) + n) * 128 + (((((kj) * 4 + q)) ^ (((r0) + n) & 7)) << 4)))
        {
            f32x4 acc[2][8];
#pragma unroll
            for (int a = 0; a < 2; ++a)
#pragma unroll
                for (int nt = 0; nt < 8; ++nt) acc[a][nt] = (f32x4){0.f, 0.f, 0.f, 0.f};
#pragma unroll
            for (int kj = 0; kj < 2; ++kj) {
                const bf16x8 kd0 = TFRAG(DN_R3, (2 * wid) * 16, kj), kd1 = TFRAG(DN_R3, (2 * wid + 1) * 16, kj);
#pragma unroll
                for (int nt = 0; nt < 8; ++nt) {
                    const bf16x8 wf = TFRAG(DN_R2, nt * 16, kj);
                    acc[0][nt] = __builtin_amdgcn_mfma_f32_16x16x32_bf16(wf, kd0, acc[0][nt], 0, 0, 0);
                    acc[1][nt] = __builtin_amdgcn_mfma_f32_16x16x32_bf16(wf, kd1, acc[1][nt], 0, 0, 0);
                }
            }
#pragma unroll
            for (int a = 0; a < 2; ++a)
#pragma unroll
                for (int kk = 0; kk < 4; ++kk) {
                    const f32x4 lo = acc[a][2 * kk], hi = acc[a][2 * kk + 1];
                    uint4 o;
                    o.x = pack_bf16(-lo[0], -lo[1]); o.y = pack_bf16(-lo[2], -lo[3]); o.z = pack_bf16(-hi[0], -hi[1]); o.w = pack_bf16(-hi[2], -hi[3]);
                    *(uint4*)(rec + DR_N + ((((2 * wid + a) * 4 + kk) * 64) + lane) * 16) = o;
                }
        }
        {
            f32x4 acc[8][2];
#pragma unroll
            for (int mt = 0; mt < 8; ++mt) { acc[mt][0] = (f32x4){0.f, 0.f, 0.f, 0.f}; acc[mt][1] = (f32x4){0.f, 0.f, 0.f, 0.f}; }
#pragma unroll
            for (int kj = 0; kj < 2; ++kj) {
                const bf16x8 u0 = TFRAG(DN_R1, (2 * wid) * 16, kj), u1 = TFRAG(DN_R1, (2 * wid + 1) * 16, kj);
#pragma unroll
                for (int mt = 0; mt < 8; ++mt) {
                    const bf16x8 kd = TFRAG(DN_R3, mt * 16, kj);
                    acc[mt][0] = __builtin_amdgcn_mfma_f32_16x16x32_bf16(kd, u0, acc[mt][0], 0, 0, 0);
                    acc[mt][1] = __builtin_amdgcn_mfma_f32_16x16x32_bf16(kd, u1, acc[mt][1], 0, 0, 0);
                }
            }
#pragma unroll
            for (int mt = 0; mt < 8; ++mt)
#pragma unroll
                for (int a = 0; a < 2; ++a) {
                    uint2 o; o.x = pack_bf16(acc[mt][a][0], acc[mt][a][1]); o.y = pack_bf16(acc[mt][a][2], acc[mt][a][3]);
                    *(uint2*)(rec + DR_B + ((((2 * wid + a) * 8 + mt) * 64) + lane) * 8) = o;
                }
        }
        {
            bf16x8 qkf[2];
#pragma unroll
            for (int kj = 0; kj < 2; ++kj) qkf[kj] = *(const bf16x8*)(smem + DN_R4 + irow * 144 + (kj * 32 + 8 * q) * 2);
            f32x4 pq[8];
#pragma unroll
            for (int dt = 0; dt < 8; ++dt) {
                pq[dt] = (f32x4){0.f, 0.f, 0.f, 0.f};
#pragma unroll
                for (int kj = 0; kj < 2; ++kj) pq[dt] = __builtin_amdgcn_mfma_f32_16x16x32_bf16(TFRAG(DN_R2, dt * 16, kj), qkf[kj], pq[dt], 0, 0, 0);
            }
#pragma unroll
            for (int kk = 0; kk < 4; ++kk) {
                uint4* qp = (uint4*)(rec + DR_Q + (((wid * 4 + kk) * 64) + lane) * 16);
                const uint4 qv = *qp;
                const float4 lo = unpack4(make_uint2(qv.x, qv.y)), hi = unpack4(make_uint2(qv.z, qv.w));
                uint4 o;
                o.x = pack_bf16(lo.x - pq[2 * kk][0], lo.y - pq[2 * kk][1]);
                o.y = pack_bf16(lo.z - pq[2 * kk][2], lo.w - pq[2 * kk][3]);
                o.z = pack_bf16(hi.x - pq[2 * kk + 1][0], hi.y - pq[2 * kk + 1][1]);
                o.w = pack_bf16(hi.z - pq[2 * kk + 1][2], hi.w - pq[2 * kk + 1][3]);
                *qp = o;
            }
#pragma unroll
            for (int et = 0; et < 8; ++et) {
                f32x4 po = {0.f, 0.f, 0.f, 0.f};
#pragma unroll
                for (int kj = 0; kj < 2; ++kj) po = __builtin_amdgcn_mfma_f32_16x16x32_bf16(TFRAG(DN_R1, et * 16, kj), qkf[kj], po, 0, 0, 0);
                uint2 o; o.x = pack_bf16(po[0], po[1]); o.y = pack_bf16(po[2], po[3]);
                *(uint2*)(rec + DR_O + (((wid * 8 + et) * 64) + lane) * 8) = o;
            }
        }
#undef TFRAG
    }
}

__device__ __forceinline__ void ph_dn_scan(const Params& p, int j, char* smem) {
    const int tidx = tid_opaque();
    const int lane = tidx & 63, wid = tidx >> 6, n = lane & 15, q = lane >> 4;
    const unsigned lbase = __builtin_amdgcn_readfirstlane(lds_base_addr() + wid * 1024);
    for (int item = blockIdx.x; item < 32; item += gridDim.x) {
        const int st = item >> 1, et = (item & 1) * 4 + wid;
        const int b = st >> 2, h = st & 3;
        f32x4 acc[8];
#pragma unroll
        for (int mt = 0; mt < 8; ++mt) acc[mt] = (f32x4){0.f, 0.f, 0.f, 0.f};
        const char* rec = p.dnrec + (size_t)st * 64 * DR_SIZE;
        const char* nsrc = rec + DR_N + tidx * 16;
        char* sp = p.dnsp + (size_t)st * 64 * 32768 + (et >> 1) * 8192 + (et & 1) * 1024 + lane * 16;
        const char* brec = rec + DR_B + (size_t)et * 8 * 512 + lane * 8;
        __syncthreads();
#pragma unroll
        for (int k = 0; k < 8; ++k) glds16_asm(nsrc + k * 4096, lbase + k * 4096);
        uint2 bcur[8];
#pragma unroll
        for (int mt = 0; mt < 8; ++mt) bcur[mt] = *(const uint2*)(brec + mt * 512);
        float gl = p.dngl[st * 64];
        asm volatile("s_waitcnt vmcnt(0)" ::: "memory");
        __syncthreads();
#pragma unroll 1
        for (int c = 0; c < 64; ++c) {
            const char* slot = smem + (c & 1) * 32768;
            bf16x8 sB[4];
#pragma unroll
            for (int kk = 0; kk < 4; ++kk) {
                const f32x4 lo = acc[2 * kk], hi = acc[2 * kk + 1];
                uint4 cu;
                cu.x = pack_bf16(lo[0], lo[1]); cu.y = pack_bf16(lo[2], lo[3]); cu.z = pack_bf16(hi[0], hi[1]); cu.w = pack_bf16(hi[2], hi[3]);
                sB[kk] = __builtin_bit_cast(bf16x8, cu);
                *(uint4*)(sp + (size_t)c * 32768 + kk * 2048) = cu;
            }
#pragma unroll
            for (int mt = 0; mt < 8; ++mt) {
                const float4 b0 = unpack4(bcur[mt]);
                acc[mt][0] = gl * acc[mt][0] + b0.x; acc[mt][1] = gl * acc[mt][1] + b0.y; acc[mt][2] = gl * acc[mt][2] + b0.z; acc[mt][3] = gl * acc[mt][3] + b0.w;
            }
            {
                const int cn = (c + 1 < 64) ? c + 1 : c;
                const char* nb = brec + (size_t)cn * DR_SIZE;
#pragma unroll
                for (int mt = 0; mt < 8; ++mt) bcur[mt] = *(const uint2*)(nb + mt * 512);
                gl = p.dngl[st * 64 + cn];
                if (c + 1 < 64) {
                    const unsigned dst = lbase + ((c + 1) & 1) * 32768;
#pragma unroll
                    for (int k = 0; k < 8; ++k) glds16_asm(nsrc + (size_t)(c + 1) * DR_SIZE + k * 4096, dst + k * 4096);
                }
            }
#pragma unroll
            for (int mt = 0; mt < 8; ++mt) {
                f32x4 c0 = acc[mt];
#pragma unroll
                for (int kk = 0; kk < 4; ++kk) {
                    const bf16x8 nf = *(const bf16x8*)(slot + ((mt * 4 + kk) * 64 + lane) * 16);
                    c0 = __builtin_amdgcn_mfma_f32_16x16x32_bf16(nf, sB[kk], c0, 0, 0, 0);
                }
                acc[mt] = c0;
            }
            asm volatile("s_waitcnt vmcnt(0) lgkmcnt(0)" ::: "memory");
            __builtin_amdgcn_s_barrier();
            MEMFENCE();
        }
        float* so = p.delta_p + (((size_t)j * NB + b) * 4 + h) * 128 * 128;
#pragma unroll
        for (int mt = 0; mt < 8; ++mt)
#pragma unroll
            for (int rr = 0; rr < 4; ++rr) so[(size_t)(mt * 16 + 4 * q + rr) * 128 + et * 16 + n] = acc[mt][rr];
    }
}

__device__ __forceinline__ void ph_dn_out(const Params& p, int j) {
    const int tidx = tid_opaque();
    const int lane = tidx & 63, wid = tidx >> 6, n = lane & 15, q = lane >> 4;
    for (int item = blockIdx.x; item < 16 * 64; item += gridDim.x) {
        const int st = item >> 6, c = item & 63, b = st >> 2, h = st & 3;
        const char* rec = p.dnrec + (size_t)item * DR_SIZE;
        const char* sp = p.dnsp + (size_t)item * 32768 + lane * 16;
        bf16x8 qf[4];
#pragma unroll
        for (int kk = 0; kk < 4; ++kk) qf[kk] = *(const bf16x8*)(rec + DR_Q + (((wid * 4 + kk) * 64) + lane) * 16);
        f32x4 o[8];
        float ss = 0.f;
#pragma unroll
        for (int et = 0; et < 8; ++et) {
            const float4 oi = unpack4(*(const uint2*)(rec + DR_O + (((wid * 8 + et) * 64) + lane) * 8));
            f32x4 a = {oi.x, oi.y, oi.z, oi.w};
#pragma unroll
            for (int kk = 0; kk < 4; ++kk) {
                const bf16x8 sf = *(const bf16x8*)(sp + (et >> 1) * 8192 + (kk * 2 + (et & 1)) * 1024);
                a = __builtin_amdgcn_mfma_f32_16x16x32_bf16(sf, qf[kk], a, 0, 0, 0);
            }
            o[et] = a;
            ss += a[0] * a[0] + a[1] * a[1] + a[2] * a[2] + a[3] * a[3];
        }
        ss += __shfl_xor(ss, 16); ss += __shfl_xor(ss, 32);
        const float r = rsqrtf(ss * (1.0f / 128.0f) + EPS);
        const int t = b * SEQ + c * 64 + wid * 16 + n;
#pragma unroll
        for (int et = 0; et < 8; ++et) {
            const int e0 = et * 16 + 4 * q;
            const float4 g = unpack4(*(const uint2*)(p.proj + (size_t)t * EVEN_LD + C_GA + h * 128 + e0));
            const float4 na = *(const float4*)(p.norm_a + j * 128 + e0);
            uint2 w;
            w.x = pack_bf16(o[et][0] * r * na.x * siluf_(g.x), o[et][1] * r * na.y * siluf_(g.y));
            w.y = pack_bf16(o[et][2] * r * na.z * siluf_(g.z), o[et][3] * r * na.w * siluf_(g.w));
            *(uint2*)(p.qb + (size_t)t * D + h * 128 + e0) = w;
        }
    }
}

__device__ __forceinline__ void rope_chunk(float (&x)[8], int chunk_in_head, const float* rp, int lane) {
    float o[8];
#pragma unroll
    for (int i = 0; i < 8; ++i) o[i] = __shfl_xor(x[i], 1);
    if (chunk_in_head < 2) {
        const float4 c0 = *(const float4*)rp, c1 = *(const float4*)(rp + 4), s0 = *(const float4*)(rp + 8), s1 = *(const float4*)(rp + 12);
        const float c[8] = {c0.x, c0.y, c0.z, c0.w, c1.x, c1.y, c1.z, c1.w}, sn[8] = {s0.x, s0.y, s0.z, s0.w, s1.x, s1.y, s1.z, s1.w};
        const float sg = chunk_in_head == 0 ? -1.f : 1.f;
#pragma unroll
        for (int i = 0; i < 8; ++i) x[i] = x[i] * c[i] + sg * o[i] * sn[i];
    }
}

__device__ __forceinline__ void ph_swa_pre(const Params& p, int j) {
    const int tidx = tid_opaque();
    const int lane = tidx & 63;
    const int wave = blockIdx.x * 4 + (tidx >> 6), nw = gridDim.x * 4;
    for (int t = wave; t < T; t += nw) {
        int smp, seq, s; tok_info(t, smp, seq, s);
        const int pi = smp ? SEQ + s : s;
        const float* rp = p.rope + (size_t)pi * 16;
        const bf16_t* row = p.proj + (size_t)t * EVEN_LD;
        {
            float x[8]; unpack8(*(const uint4*)(row + C_QB + lane * 8), x);
            rope_chunk(x, lane & 7, rp, lane);
            uint4 o; o.x = pack_bf16(x[0], x[1]); o.y = pack_bf16(x[2], x[3]); o.z = pack_bf16(x[4], x[5]); o.w = pack_bf16(x[6], x[7]);
            *(uint4*)(p.qr + (size_t)t * 512 + lane * 8) = o;
        }
        {
            const int l32 = lane & 31, isv = (lane >> 4) & 1, l16 = lane & 15;
            float x[8]; unpack8(*(const uint4*)(row + (isv ? C_VB : C_KB) + l16 * 8), x);
            float xr[8];
#pragma unroll
            for (int i = 0; i < 8; ++i) xr[i] = x[i];
            rope_chunk(xr, l16 & 7, rp, lane);
            if (lane < 32) {
                const int kh = l16 >> 3, d0 = (l16 & 7) * 8;
                if (!isv) {
                    uint4 o; o.x = pack_bf16(xr[0], xr[1]); o.y = pack_bf16(xr[2], xr[3]); o.z = pack_bf16(xr[4], xr[5]); o.w = pack_bf16(xr[6], xr[7]);
                    if (!smp) *(uint4*)(p.krb + (size_t)t * 128 + l16 * 8) = o;
                    else *(uint4*)(p.kcat + (((size_t)seq * 2 + kh) * 144 + 128 + s) * 64 + d0) = o;
                }
                float src[8];
#pragma unroll
                for (int i = 0; i < 8; ++i) src[i] = isv ? x[i] : xr[i];
                float* dst = nullptr;
                if (!smp) { if (s >= SEQ - 128) dst = (isv ? p.wv_p : p.wk_p) + ((((size_t)j * NB + seq) * 128 + (s - (SEQ - 128))) * 2 + kh) * 64 + d0; }
                else dst = (isv ? p.wv_s : p.wk_s) + ((((size_t)j * NS + seq) * 128 + (120 + s)) * 2 + kh) * 64 + d0;
                if (dst) { *(float4*)dst = make_float4(src[0], src[1], src[2], src[3]); *(float4*)(dst + 4) = make_float4(src[4], src[5], src[6], src[7]); }
                (void)l32;
            }
        }
    }
    const size_t gtid = (size_t)blockIdx.x * 256 + tidx, gsz = (size_t)gridDim.x * 256;
    for (size_t i = gtid; i < (size_t)NS * 120 * 128; i += gsz) {
        const int nn = (int)(i / (120 * 128)); const int rem = (int)(i % (120 * 128));
        const size_t src = ((size_t)j * NS + nn) * 128 * 128 + 8 * 128 + rem;
        const size_t dst = ((size_t)j * NS + nn) * 128 * 128 + rem;
        p.wk_s[dst] = p.cache_k[src];
        p.wv_s[dst] = p.cache_v[src];
    }
}

__device__ __forceinline__ void ph_swa_attn(const Params& p, int j) {
    const int tidx = tid_opaque();
    const int lane = tidx & 63;
    const int wave = blockIdx.x * 4 + (tidx >> 6), nw = gridDim.x * 4;
    for (int item = wave; item < T * 8; item += nw) {
        const int t = item >> 3, hq = item & 7, kh = hq >> 2;
        int smp, seq, s; tok_info(t, smp, seq, s);
        const int t0 = t - s;
        float q[64];
        {
            const bf16_t* qp = p.qr + (size_t)t * 512 + hq * 64;
#pragma unroll
            for (int c = 0; c < 8; ++c) {
                const bf16x8 v = *(const bf16x8*)(qp + c * 8);
#pragma unroll
                for (int i = 0; i < 8; ++i) q[c * 8 + i] = bf2f((bf16_t)v[i]);
            }
        }
        const float sink = p.sinks[j * 8 + hq];
        float sc[3]; bool valid[3];
        float mx = -1e30f;
#pragma unroll
        for (int rr = 0; rr < 3; ++rr) {
            const int r = lane + 64 * rr;
            const int kp = s - 128 + r;
            bool ok = (r <= 128);
            const float* kptr = nullptr;
            if (ok) {
                if (kp >= 0) kptr = p.kr + (size_t)(t0 + kp) * 128 + kh * 64;
                else if (smp) kptr = p.cache_k + ((((size_t)j * NS + seq) * 128 + (128 + kp)) * 2 + kh) * 64;
                else ok = false;
            }
            float d = 0.f;
            if (ok) {
#pragma unroll
                for (int c = 0; c < 16; ++c) {
                    const float4 kv = *(const float4*)(kptr + c * 4);
                    d += q[c * 4] * kv.x + q[c * 4 + 1] * kv.y + q[c * 4 + 2] * kv.z + q[c * 4 + 3] * kv.w;
                }
                d *= 0.125f;
                mx = fmaxf(mx, d);
            }
            sc[rr] = d; valid[rr] = ok;
        }
        for (int o = 32; o > 0; o >>= 1) mx = fmaxf(mx, __shfl_xor(mx, o));
        const float m = fmaxf(mx, sink);
        float pr[3]; float sum = 0.f;
#pragma unroll
        for (int rr = 0; rr < 3; ++rr) { pr[rr] = valid[rr] ? __expf(sc[rr] - m) : 0.f; sum += pr[rr]; }
        for (int o = 32; o > 0; o >>= 1) sum += __shfl_xor(sum, o);
        const float denom = sum + __expf(sink - m);
        float acc = 0.f;
        for (int r = 0; r <= 128; ++r) {
            const float pj = __shfl(r < 64 ? pr[0] : (r < 128 ? pr[1] : pr[2]), r & 63);
            const int kp = s - 128 + r;
            float vv = 0.f;
            if (kp >= 0) vv = bf2f(p.proj[(size_t)(t0 + kp) * EVEN_LD + C_VB + kh * 64 + lane]);
            else if (smp) vv = p.cache_v[((((size_t)j * NS + seq) * 128 + (128 + kp)) * 2 + kh) * 64 + lane];
            acc += pj * vv;
        }
        const float o = acc / denom;
        const float g = bf2f(p.proj[(size_t)t * EVEN_LD + C_GB + hq * 64 + lane]);
        p.qb[(size_t)t * D + 512 + hq * 64 + lane] = f2bf(o * siluf_(g));
    }
}


__device__ __forceinline__ void ph_swa_prep2(const Params& p, int j, char* smem) {
    const int tidx = tid_opaque();
    bf16_t* tile = (bf16_t*)smem;
    for (int item = blockIdx.x; item < NB * (SEQ / 64); item += gridDim.x) {
        const int b = item / (SEQ / 64), pt = item % (SEQ / 64);
        const int t0 = b * SEQ + pt * 64;
        __syncthreads();
#pragma unroll
        for (int u = 0; u < 4; ++u) {
            const int cidx = tidx + 256 * u, tok = cidx >> 4, ch = cidx & 15;
            *(uint4*)(tile + tok * 128 + ch * 8) = *(const uint4*)(p.proj + (size_t)(t0 + tok) * EVEN_LD + C_VB + ch * 8);
        }
        __syncthreads();
#pragma unroll
        for (int u = 0; u < 8; ++u) {
            const int pidx = tidx + 256 * u;
            const int ln = pidx & 63, dt = (pidx >> 6) & 3, kvh = (pidx >> 8) & 1, Tl = pidx >> 9;
            const int n = ln & 15, q = ln >> 4;
            const int col = kvh * 64 + dt * 16 + n, tk = Tl * 16 + 4 * q;
            uint2 w;
            w.x = (unsigned)tile[tk * 128 + col] | ((unsigned)tile[(tk + 1) * 128 + col] << 16);
            w.y = (unsigned)tile[(tk + 2) * 128 + col] | ((unsigned)tile[(tk + 3) * 128 + col] << 16);
            *(uint2*)(p.vT + ((((size_t)(b * 2 + kvh) * 256 + pt * 4 + Tl) * 4 + dt) * 64 + ln) * 4) = w;
        }
    }
    for (int item = blockIdx.x; item < NS; item += gridDim.x) {
        const int nn = item;
        __syncthreads();
        for (int e = tidx; e < 128 * 32; e += 256) {
            const int c = e >> 5, k4 = e & 31;
            const size_t src = (((size_t)j * NS + nn) * 128 + c) * 128 + k4 * 4;
            const float4 kv = *(const float4*)(p.cache_k + src), vv = *(const float4*)(p.cache_v + src);
            const int kvh = k4 >> 4, d0 = (k4 & 15) * 4;
            ushort4 ko; ko.x = f2bf(kv.x); ko.y = f2bf(kv.y); ko.z = f2bf(kv.z); ko.w = f2bf(kv.w);
            *(ushort4*)(p.kcat + (((size_t)nn * 2 + kvh) * 144 + c) * 64 + d0) = ko;
            bf16_t* tp_ = tile + c * 130 + k4 * 4;
            tp_[0] = f2bf(vv.x); tp_[1] = f2bf(vv.y); tp_[2] = f2bf(vv.z); tp_[3] = f2bf(vv.w);
        }
        for (int e = tidx; e < 8 * 128; e += 256) {
            const int c = e >> 7, kd = e & 127;
            tile[(128 + c) * 130 + kd] = p.proj[(size_t)(TP + nn * LS + c) * EVEN_LD + C_VB + kd];
            p.kcat[(((size_t)nn * 2 + (kd >> 6)) * 144 + 136 + c) * 64 + (kd & 63)] = 0;
        }
        __syncthreads();
        for (int pidx = tidx; pidx < 10 * 2 * 4 * 64; pidx += 256) {
            const int ln = pidx & 63, dt = (pidx >> 6) & 3, kvh = (pidx >> 8) & 1, Tl = pidx >> 9;
            const int n = ln & 15, q = ln >> 4;
            const int col = kvh * 64 + dt * 16 + n, tk = Tl * 16 + 4 * q;
            unsigned v4[4];
#pragma unroll
            for (int e = 0; e < 4; ++e) v4[e] = (tk + e < 136) ? (unsigned)tile[(tk + e) * 130 + col] : 0u;
            uint2 w; w.x = v4[0] | (v4[1] << 16); w.y = v4[2] | (v4[3] << 16);
            *(uint2*)(p.vTcat + ((((size_t)(nn * 2 + kvh) * 10 + Tl) * 4 + dt) * 64 + ln) * 4) = w;
        }
    }
}

__device__ __forceinline__ void ph_swa_attn2(const Params& p, int j, int bid, int nblk) {
    const int tidx = tid_opaque();
    const int lane = tidx & 63, n = lane & 15, q = lane >> 4;
    const int wave = bid * 4 + (tidx >> 6), nw = nblk * 4;
    const int nprompt = NB * (SEQ / 16) * 8;
    for (int item = wave; item < nprompt + NS * 8; item += nw) {
        int hq, qc0, tq0, kstride, kmax, vstride, vmax, nvalid;
        const bf16_t* Kb; const bf16_t* VTb;
        if (item < nprompt) {
            const int b = item / ((SEQ / 16) * 8), rem = item % ((SEQ / 16) * 8);
            hq = rem & 7; qc0 = (rem >> 3) * 16; tq0 = b * SEQ + qc0;
            Kb = p.krb + (size_t)b * SEQ * 128 + (hq >> 2) * 64; kstride = 128; kmax = SEQ - 1;
            VTb = p.vT + (size_t)(b * 2 + (hq >> 2)) * 256 * 4 * 64 * 4; vstride = 0; vmax = 255;
            nvalid = 16;
        } else {
            const int it2 = item - nprompt, nn = it2 >> 3;
            hq = it2 & 7; qc0 = 128; tq0 = TP + nn * LS;
            Kb = p.kcat + ((size_t)nn * 2 + (hq >> 2)) * 144 * 64; kstride = 64; kmax = 143;
            VTb = p.vTcat + (size_t)(nn * 2 + (hq >> 2)) * 10 * 4 * 64 * 4; vstride = 0; vmax = 9;
            nvalid = 8;
        }
        const int key0 = qc0 - 128;
        const int tq = tq0 + (n < nvalid ? n : nvalid - 1);
        bf16x8 qf[2];
        qf[0] = *(const bf16x8*)(p.qr + (size_t)tq * 512 + hq * 64 + 8 * q);
        qf[1] = *(const bf16x8*)(p.qr + (size_t)tq * 512 + hq * 64 + 32 + 8 * q);
        bf16x8 kf[20];
#pragma unroll
        for (int kt = 0; kt < 10; ++kt) {
            int kc = key0 + 16 * kt + n; kc = kc < 0 ? 0 : (kc > kmax ? kmax : kc);
            const bf16_t* kp = Kb + (size_t)kc * kstride + 8 * q;
            kf[2 * kt] = *(const bf16x8*)(kp); kf[2 * kt + 1] = *(const bf16x8*)(kp + 32);
        }
        uint2 vv[40];
#pragma unroll
        for (int k2 = 0; k2 < 5; ++k2) {
            int tA = (key0 >> 4) + 2 * k2, tB = tA + 1;
            tA = tA < 0 ? 0 : (tA > vmax ? vmax : tA); tB = tB < 0 ? 0 : (tB > vmax ? vmax : tB);
#pragma unroll
            for (int dt = 0; dt < 4; ++dt) {
                vv[(dt * 5 + k2) * 2] = *(const uint2*)(VTb + (((size_t)tA * 4 + dt) * 64 + lane) * 4);
                vv[(dt * 5 + k2) * 2 + 1] = *(const uint2*)(VTb + (((size_t)tB * 4 + dt) * 64 + lane) * 4);
            }
        }
        uint2 gg[4];
#pragma unroll
        for (int dt = 0; dt < 4; ++dt) gg[dt] = *(const uint2*)(p.proj + (size_t)tq * EVEN_LD + C_GB + hq * 64 + dt * 16 + 4 * q);
        const float sink = p.sinks[j * 8 + hq];
        __builtin_amdgcn_sched_barrier(0);
        f32x4 sc[10];
#pragma unroll
        for (int kt = 0; kt < 10; ++kt) {
            f32x4 a = {0.f, 0.f, 0.f, 0.f};
            a = __builtin_amdgcn_mfma_f32_16x16x32_bf16(kf[2 * kt], qf[0], a, 0, 0, 0);
            a = __builtin_amdgcn_mfma_f32_16x16x32_bf16(kf[2 * kt + 1], qf[1], a, 0, 0, 0);
            sc[kt] = a;
        }
        const int qc = qc0 + n;
        float mx = -1e30f;
#pragma unroll
        for (int kt = 0; kt < 10; ++kt)
#pragma unroll
            for (int rr = 0; rr < 4; ++rr) {
                const int kc = key0 + 16 * kt + 4 * q + rr, rel = qc - kc;
                const bool ok = (kc >= 0) && (rel >= 0) && (rel <= 128);
                const float sv = ok ? sc[kt][rr] * 0.125f : -1e30f;
                sc[kt][rr] = sv;
                mx = fmaxf(mx, sv);
            }
        mx = fmaxf(mx, __shfl_xor(mx, 16)); mx = fmaxf(mx, __shfl_xor(mx, 32));
        const float m = fmaxf(mx, sink);
        float sum = 0.f;
#pragma unroll
        for (int kt = 0; kt < 10; ++kt)
#pragma unroll
            for (int rr = 0; rr < 4; ++rr) {
                const float pv = (sc[kt][rr] > -1e29f) ? __expf(sc[kt][rr] - m) : 0.f;
                sc[kt][rr] = pv; sum += pv;
            }
        sum += __shfl_xor(sum, 16); sum += __shfl_xor(sum, 32);
        const float inv = 1.0f / (sum + __expf(sink - m));
        bf16x8 pf[5];
#pragma unroll
        for (int k2 = 0; k2 < 5; ++k2) {
            uint4 cu;
            cu.x = pack_bf16(sc[2 * k2][0], sc[2 * k2][1]); cu.y = pack_bf16(sc[2 * k2][2], sc[2 * k2][3]);
            cu.z = pack_bf16(sc[2 * k2 + 1][0], sc[2 * k2 + 1][1]); cu.w = pack_bf16(sc[2 * k2 + 1][2], sc[2 * k2 + 1][3]);
            pf[k2] = __builtin_bit_cast(bf16x8, cu);
        }
#pragma unroll
        for (int dt = 0; dt < 4; ++dt) {
            f32x4 o = {0.f, 0.f, 0.f, 0.f};
#pragma unroll
            for (int k2 = 0; k2 < 5; ++k2) {
                const uint2 va = vv[(dt * 5 + k2) * 2], vb = vv[(dt * 5 + k2) * 2 + 1];
                const bf16x8 vf = __builtin_bit_cast(bf16x8, make_uint4(va.x, va.y, vb.x, vb.y));
                o = __builtin_amdgcn_mfma_f32_16x16x32_bf16(vf, pf[k2], o, 0, 0, 0);
            }
            if (n < nvalid) {
                const int d0 = dt * 16 + 4 * q;
                const float4 g = unpack4(gg[dt]);
                uint2 w;
                w.x = pack_bf16(o[0] * inv * siluf_(g.x), o[1] * inv * siluf_(g.y));
                w.y = pack_bf16(o[2] * inv * siluf_(g.z), o[3] * inv * siluf_(g.w));
                *(uint2*)(p.qb + (size_t)tq * D + 512 + hq * 64 + d0) = w;
            }
        }
    }
}

__device__ __forceinline__ void ph_hg_rec(const Params& p, int j, int first_stream) {
    const int tidx = tid_opaque();
    const int lane = tidx & 63;
    const int wave = (tidx >> 6) * gridDim.x + blockIdx.x, nw = gridDim.x * 4;
    const int e = lane & 3, dg = lane >> 2;
    const int nitems = (NB + NS) * 8 * 32;
    for (int item = wave + first_stream * 8 * 32; item < nitems; item += nw) {
        const int es = item & 31, h = (item >> 5) & 7, st = item >> 8;
        const int smp = st >= NB, seq = smp ? st - NB : st;
        const int t0 = smp ? TP + seq * LS : seq * SEQ, len = smp ? LS : SEQ;
        const int ec = es * 4 + e;
        float lb[8];
#pragma unroll
        for (int i = 0; i < 8; ++i) {
            const int c = h * 128 + dg * 8 + i;
            if (j == 0) lb[i] = 0.f;
            else {
                const float r0 = p.lb_raw[c], r1 = p.lb_raw[D + c];
                const float mm = fmaxf(r0, r1);
                const float e0 = __expf(r0 - mm), e1 = __expf(r1 - mm);
                lb[i] = e1 / (e0 + e1);
            }
        }
        float S[8];
        if (smp) {
            const float* s0 = p.state_hgrn + (((size_t)j * NS + seq) * 8 + h) * 128 * 128;
#pragma unroll
            for (int i = 0; i < 8; ++i) S[i] = s0[(size_t)(dg * 8 + i) * 128 + ec];
        } else {
#pragma unroll
            for (int i = 0; i < 8; ++i) S[i] = 0.f;
        }
        for (int s = 0; s < len; ++s) {
            const int t = t0 + s;
            const bf16_t* row = p.proj + (size_t)t * ODD_LD;
            const bf16x8 qv = *(const bf16x8*)(row + h * 128 + dg * 8);
            const bf16x8 fv = *(const bf16x8*)(row + 1024 + h * 128 + dg * 8);
            const float v = bf2f(row[2048 + h * 128 + ec]);
            float o = 0.f;
#pragma unroll
            for (int i = 0; i < 8; ++i) {
                const float qq = siluf_(bf2f((bf16_t)qv[i])) * 0.08838834764831845f;
                const float z = bf2f((bf16_t)fv[i]);
                const float f = fmaxf(lb[i] + (1.0f - lb[i]) * sigmoidf_(z), 1e-30f);
                const float k = (1.0f - lb[i]) * sigmoidf_(-z);
                S[i] = f * S[i] + k * v;
                o += qq * S[i];
            }
            for (int off = 4; off < 64; off <<= 1) o += __shfl_xor(o, off);
            if (dg == 0) p.hgo[(size_t)t * D + h * 128 + ec] = o;
        }
        float* so = smp ? p.hg_s + (((size_t)j * NS + seq) * 8 + h) * 128 * 128 : p.hg_p + (((size_t)j * NB + seq) * 8 + h) * 128 * 128;
#pragma unroll
        for (int i = 0; i < 8; ++i) so[(size_t)(dg * 8 + i) * 128 + ec] = S[i];
    }
}


constexpr int REC_Q = 0, REC_KT = 8192, REC_A = 16384, REC_D = 18432, REC_BYTES = 18944, REC_SIZE = 19456, REC_V = 20480, HG_SLOT = 28672;

__device__ __forceinline__ void ph_hg_prep(const Params& p, int j, char* smem) {
    const int tidx = tid_opaque();
    const int lane = tidx & 63, wid = tidx >> 6;
    char* const smem0 = smem;
    const int d = tidx & 127, half = tidx >> 7;
    bf16_t rq[16], rz[16], rv[16];
#define HG_LOAD_RAW(it_) { const int st_ = (it_) >> 7, c_ = (it_) & 127; \
        const bf16_t* row_ = p.proj + (size_t)((st_ >> 3) * SEQ + c_ * 32 + half * 16) * ODD_LD + (st_ & 7) * 128 + d; \
        _Pragma("unroll") for (int ii = 0; ii < 16; ++ii) { rq[ii] = row_[(size_t)ii * ODD_LD]; rz[ii] = row_[(size_t)ii * ODD_LD + 1024]; rv[ii] = row_[(size_t)ii * ODD_LD + 2048]; } }
    if ((int)blockIdx.x < 32 * 128) HG_LOAD_RAW(blockIdx.x);
    for (int item = blockIdx.x; item < 32 * 128; item += gridDim.x) {
        const int st = item >> 7, c = item & 127, b = st >> 3, h = st & 7;
        const int ch = h * 128 + d;
        float lb = 0.f;
        if (j != 0) {
            const float r0 = p.lb_raw[ch], r1 = p.lb_raw[D + ch];
            const float mm = fmaxf(r0, r1);
            const float e0 = __expf(r0 - mm), e1 = __expf(r1 - mm);
            lb = e1 / (e0 + e1);
        }
        char* rec = p.hgrec + (size_t)item * REC_SIZE;
        char* vrec = p.hgv + (size_t)item * 8192;
        char* smem = smem0;
        float* sQ = (float*)smem;
        float* sK = sQ + 32 * 132;
        float* sG = sK + 32 * 132;
        bf16_t* sQh = (bf16_t*)(sG + 32 * 132);
        bf16_t* sKh = sQh + 16 * 128;
        float* sA = (float*)(sKh + 16 * 128);
        float* sTot = sA + 32 * 33;
        __syncthreads();
        float qv[16], kv[16], gl_[16];
        unsigned vb[8];
        float gacc = 0.f;
#pragma unroll
        for (int ii = 0; ii < 16; ++ii) {
            const int i = half * 16 + ii;
            const float qraw = bf2f(rq[ii]), z = bf2f(rz[ii]);
            const unsigned vraw = rv[ii];
            if (ii & 1) vb[ii >> 1] |= vraw << 16; else vb[ii >> 1] = vraw;
            const float sg = sigmoidf_(z);
            const float f = fmaxf(lb + (1.0f - lb) * sg, 1e-30f);
            gacc += __logf(f);
            qv[ii] = siluf_(qraw) * 0.08838834764831845f;
            kv[ii] = (1.0f - lb) * (1.0f - sg);
            gl_[ii] = gacc;
            sQ[i * 132 + d] = qv[ii];
            sK[i * 132 + d] = kv[ii];
        }
        if (item + (int)gridDim.x < 32 * 128) HG_LOAD_RAW(item + gridDim.x);
        sTot[half * 128 + d] = gacc;
#pragma unroll
        for (int ii = 0; ii < 16; ++ii) {
            const int off = ii * 128 + ((((d >> 3) ^ (ii & 7)) << 3) | (d & 7));
            if (half) sQh[off] = f2bf(qv[ii] * __expf(gl_[ii]));
            else sKh[off] = f2bf(kv[ii] * __expf(gacc - gl_[ii]));
        }
        for (int e = tidx; e < 32 * 33; e += 256) sA[e] = 0.f;
        __syncthreads();
        const float tot0 = sTot[d], tot1 = sTot[128 + d];
        const float glv = tot0 + tot1, goff = half ? tot0 : 0.f;
#pragma unroll
        for (int ii = 0; ii < 16; ++ii) { gl_[ii] += goff; sG[(half * 16 + ii) * 132 + d] = gl_[ii] * 1.4426950408889634f; }
#pragma unroll
        for (int g = 0; g < 2; ++g) {
            const int kg = 2 * half + g;
            uint4 w;
            w.x = pack_bf16(kv[g * 8 + 0] * __expf(glv - gl_[g * 8 + 0]), kv[g * 8 + 1] * __expf(glv - gl_[g * 8 + 1]));
            w.y = pack_bf16(kv[g * 8 + 2] * __expf(glv - gl_[g * 8 + 2]), kv[g * 8 + 3] * __expf(glv - gl_[g * 8 + 3]));
            w.z = pack_bf16(kv[g * 8 + 4] * __expf(glv - gl_[g * 8 + 4]), kv[g * 8 + 5] * __expf(glv - gl_[g * 8 + 5]));
            w.w = pack_bf16(kv[g * 8 + 6] * __expf(glv - gl_[g * 8 + 6]), kv[g * 8 + 7] * __expf(glv - gl_[g * 8 + 7]));
            *(uint4*)(rec + REC_KT + (((d >> 4) * 64) + kg * 16 + (d & 15)) * 16) = w;
            uint4 vv; vv.x = vb[g * 4 + 0]; vv.y = vb[g * 4 + 1]; vv.z = vb[g * 4 + 2]; vv.w = vb[g * 4 + 3];
            *(uint4*)(vrec + ((((d >> 5) * 2 + ((d >> 4) & 1)) * 64) + kg * 16 + (d & 15)) * 16) = vv;
        }
        if (half == 0) *(float*)(rec + REC_D + d * 4) = __expf(glv);
        __syncthreads();
#pragma unroll
        for (int u = 0; u < 2; ++u) {
            const int sidx = tidx + 256 * u;
            const int mt = sidx >> 8, kk = (sidx >> 6) & 3, ln = sidx & 63, r = ln & 15, q = ln >> 4;
            const int i = mt * 16 + r, dA = kk * 32 + 4 * q, dB = dA + 16;
            const float4 qa = *(const float4*)(sQ + i * 132 + dA), ga = *(const float4*)(sG + i * 132 + dA);
            const float4 qb_ = *(const float4*)(sQ + i * 132 + dB), gb_ = *(const float4*)(sG + i * 132 + dB);
            uint4 w;
            w.x = pack_bf16(qa.x * __builtin_amdgcn_exp2f(ga.x), qa.y * __builtin_amdgcn_exp2f(ga.y));
            w.y = pack_bf16(qa.z * __builtin_amdgcn_exp2f(ga.z), qa.w * __builtin_amdgcn_exp2f(ga.w));
            w.z = pack_bf16(qb_.x * __builtin_amdgcn_exp2f(gb_.x), qb_.y * __builtin_amdgcn_exp2f(gb_.y));
            w.w = pack_bf16(qb_.z * __builtin_amdgcn_exp2f(gb_.z), qb_.w * __builtin_amdgcn_exp2f(gb_.w));
            *(uint4*)(rec + REC_Q + sidx * 16) = w;
        }
        if (wid == 0) {
            f32x4 acc = {0.f, 0.f, 0.f, 0.f};
            const int r = lane & 15, kg = lane >> 4;
#pragma unroll
            for (int kk = 0; kk < 4; ++kk) {
                const int chn = kk * 4 + kg;
                const bf16x8 a = *(const bf16x8*)(sQh + r * 128 + ((chn ^ (r & 7)) << 3));
                const bf16x8 bb = *(const bf16x8*)(sKh + r * 128 + ((chn ^ (r & 7)) << 3));
                acc = __builtin_amdgcn_mfma_f32_16x16x32_bf16(a, bb, acc, 0, 0, 0);
            }
#pragma unroll
            for (int rr = 0; rr < 4; ++rr) sA[(16 + 4 * kg + rr) * 33 + r] = acc[rr];
        }
        {
            const int sl = tidx & 7;
#pragma unroll 1
            for (int pidx = tidx >> 3; pidx < 272; pidx += 32) {
                const int blk2 = pidx >= 136, tt = pidx - (blk2 ? 136 : 0);
                int r = (int)((__builtin_sqrtf(8.0f * tt + 1.0f) - 1.0f) * 0.5f);
                if ((r + 1) * (r + 2) / 2 <= tt) ++r;
                if (r * (r + 1) / 2 > tt) --r;
                const int cidx = tt - r * (r + 1) / 2;
                const int i = blk2 * 16 + r, jr = blk2 * 16 + cidx;
                float sum = 0.f;
#pragma unroll
                for (int u = 0; u < 4; ++u) {
                    const float4 qa = *(const float4*)(sQ + i * 132 + sl * 16 + u * 4), gi = *(const float4*)(sG + i * 132 + sl * 16 + u * 4);
                    const float4 kq = *(const float4*)(sK + jr * 132 + sl * 16 + u * 4), g = *(const float4*)(sG + jr * 132 + sl * 16 + u * 4);
                    sum += qa.x * kq.x * __builtin_amdgcn_exp2f(gi.x - g.x);
                    sum += qa.y * kq.y * __builtin_amdgcn_exp2f(gi.y - g.y);
                    sum += qa.z * kq.z * __builtin_amdgcn_exp2f(gi.z - g.z);
                    sum += qa.w * kq.w * __builtin_amdgcn_exp2f(gi.w - g.w);
                }
                sum += __shfl_xor(sum, 1); sum += __shfl_xor(sum, 2); sum += __shfl_xor(sum, 4);
                if (sl == 0) sA[i * 33 + jr] = sum;
            }
        }
        __syncthreads();
        if (tidx < 128) {
            const int mt = tidx >> 6, ln = tidx & 63, r = ln & 15, kg = ln >> 4;
            const float* ap = sA + (mt * 16 + r) * 33 + kg * 8;
            uint4 w;
            w.x = pack_bf16(ap[0], ap[1]); w.y = pack_bf16(ap[2], ap[3]); w.z = pack_bf16(ap[4], ap[5]); w.w = pack_bf16(ap[6], ap[7]);
            *(uint4*)(rec + REC_A + tidx * 16) = w;
        }
    }
}

__device__ __forceinline__ void ph_hg_scan(const Params& p, int j, char* smem) {
    const int tidx = tid_opaque();
    const int lane = tidx & 63, wid = tidx >> 6, n = lane & 15, q = lane >> 4;
    const unsigned lbase = __builtin_amdgcn_readfirstlane(lds_base_addr() + wid * 1024);
    for (int item = blockIdx.x; item < 64; item += gridDim.x) {
        const int st = item >> 1, et = (item & 1) * 4 + wid;
        const int b = st >> 3, h = st & 7;
        f32x4 acc[8];
#pragma unroll
        for (int mt = 0; mt < 8; ++mt) acc[mt] = (f32x4){0.f, 0.f, 0.f, 0.f};
        const char* rec = p.hgrec + (size_t)st * 128 * REC_SIZE + tidx * 16;
        const char* vrec = p.hgv + (size_t)st * 128 * 8192 + tidx * 16;
        __syncthreads();
#pragma unroll
        for (int k = 0; k < 5; ++k) glds16_asm(rec + k * 4096, lbase + k * 4096);
#pragma unroll
        for (int k = 0; k < 2; ++k) glds16_asm(vrec + k * 4096, lbase + REC_V + k * 4096);
        asm volatile("s_waitcnt vmcnt(0)" ::: "memory");
        __syncthreads();
        f32x4 po[2];
        po[0] = (f32x4){0.f, 0.f, 0.f, 0.f}; po[1] = (f32x4){0.f, 0.f, 0.f, 0.f};
#pragma unroll 1
        for (int c = 0; c <= 128; ++c) {
            if (c > 0) {
                const int tc = b * SEQ + (c - 1) * 32;
#pragma unroll
                for (int mt = 0; mt < 2; ++mt)
#pragma unroll
                    for (int rr = 0; rr < 4; ++rr) p.hgo[(size_t)(tc + mt * 16 + 4 * q + rr) * D + h * 128 + et * 16 + n] = po[mt][rr];
            }
            if (c == 128) break;
            MEMFENCE();
            if (c + 1 < 128) {
                const unsigned dst = lbase + ((c + 1) & 1) * HG_SLOT;
#pragma unroll
                for (int k = 0; k < 5; ++k) glds16_asm(rec + (size_t)(c + 1) * REC_SIZE + k * 4096, dst + k * 4096);
#pragma unroll
                for (int k = 0; k < 2; ++k) glds16_asm(vrec + (size_t)(c + 1) * 8192 + k * 4096, dst + REC_V + k * 4096);
            }
            const char* slot = smem + (c & 1) * HG_SLOT;
            const bf16x8 vf = *(const bf16x8*)(slot + REC_V + et * 1024 + lane * 16);
            bf16x8 sB[4];
#pragma unroll
            for (int kk = 0; kk < 4; ++kk) {
                const f32x4 lo = acc[2 * kk], hi = acc[2 * kk + 1];
                uint4 cu;
                cu.x = pack_bf16(lo[0], lo[1]); cu.y = pack_bf16(lo[2], lo[3]); cu.z = pack_bf16(hi[0], hi[1]); cu.w = pack_bf16(hi[2], hi[3]);
                sB[kk] = __builtin_bit_cast(bf16x8, cu);
            }
#pragma unroll
            for (int mt = 0; mt < 2; ++mt) {
                const bf16x8 af = *(const bf16x8*)(slot + REC_A + (mt * 64 + lane) * 16);
                f32x4 o0 = {0.f, 0.f, 0.f, 0.f};
#pragma unroll
                for (int kk = 0; kk < 4; ++kk) {
                    const bf16x8 qf = *(const bf16x8*)(slot + REC_Q + ((mt * 4 + kk) * 64 + lane) * 16);
                    o0 = __builtin_amdgcn_mfma_f32_16x16x32_bf16(qf, sB[kk], o0, 0, 0, 0);
                }
                po[mt] = __builtin_amdgcn_mfma_f32_16x16x32_bf16(af, vf, o0, 0, 0, 0);
            }
#pragma unroll
            for (int mt = 0; mt < 8; ++mt) {
                const float4 dv = *(const float4*)(slot + REC_D + (mt * 16 + 4 * q) * 4);
                const bf16x8 kt = *(const bf16x8*)(slot + REC_KT + (mt * 64 + lane) * 16);
                f32x4 c0 = acc[mt];
                c0[0] *= dv.x; c0[1] *= dv.y; c0[2] *= dv.z; c0[3] *= dv.w;
                acc[mt] = __builtin_amdgcn_mfma_f32_16x16x32_bf16(kt, vf, c0, 0, 0, 0);
            }
            asm volatile("s_waitcnt vmcnt(0) lgkmcnt(0)" ::: "memory");
            __builtin_amdgcn_s_barrier();
            MEMFENCE();
        }
        float* so = p.hg_p + (((size_t)j * NB + b) * 8 + h) * 128 * 128;
#pragma unroll
        for (int mt = 0; mt < 8; ++mt)
#pragma unroll
            for (int rr = 0; rr < 4; ++rr) so[(size_t)(mt * 16 + 4 * q + rr) * 128 + et * 16 + n] = acc[mt][rr];
    }
}


__device__ __forceinline__ void ph_hg_rec2(const Params& p, int j, char* smem, int bid, int nblk) {
    const int tidx = tid_opaque();
    const int lane = tidx & 63, wid = tidx >> 6;
    float* sb = (float*)(smem + wid * 2048);
    const int wave = wid * nblk + bid, nw = nblk * 4;
    __syncthreads();
    for (int item = wave; item < NS * 8 * 2; item += nw) {
        const int hf = item & 1, h = (item >> 1) & 7, nn = item >> 4;
        const int e = hf * 64 + lane;
        float lb0 = 0.f, lb1 = 0.f;
        if (j != 0) {
            const int c0 = h * 128 + lane, c1 = c0 + 64;
            { const float r0 = p.lb_raw[c0], r1 = p.lb_raw[D + c0], mm = fmaxf(r0, r1), e0 = __expf(r0 - mm), e1 = __expf(r1 - mm); lb0 = e1 / (e0 + e1); }
            { const float r0 = p.lb_raw[c1], r1 = p.lb_raw[D + c1], mm = fmaxf(r0, r1), e0 = __expf(r0 - mm), e1 = __expf(r1 - mm); lb1 = e1 / (e0 + e1); }
        }
        const float* s0 = p.state_hgrn + (((size_t)j * NS + nn) * 8 + h) * 128 * 128 + e;
        float S[128];
#pragma unroll
        for (int d = 0; d < 128; ++d) S[d] = s0[(size_t)d * 128];
        for (int st = 0; st < LS; ++st) {
            const int t = TP + nn * LS + st;
            const bf16_t* row = p.proj + (size_t)t * ODD_LD + h * 128;
            {
                const float q0 = bf2f(row[lane]), q1 = bf2f(row[lane + 64]);
                const float z0 = bf2f(row[1024 + lane]), z1 = bf2f(row[1024 + lane + 64]);
                const float g0 = sigmoidf_(z0), g1 = sigmoidf_(z1);
                sb[lane] = siluf_(q0) * 0.08838834764831845f; sb[lane + 64] = siluf_(q1) * 0.08838834764831845f;
                sb[128 + lane] = fmaxf(lb0 + (1.0f - lb0) * g0, 1e-30f); sb[128 + lane + 64] = fmaxf(lb1 + (1.0f - lb1) * g1, 1e-30f);
                sb[256 + lane] = (1.0f - lb0) * (1.0f - g0); sb[256 + lane + 64] = (1.0f - lb1) * (1.0f - g1);
            }
            const float v = bf2f(row[2048 + e]);
            float o = 0.f;
#pragma unroll
            for (int d4 = 0; d4 < 32; ++d4) {
                const float4 qv = *(const float4*)(sb + d4 * 4), fv = *(const float4*)(sb + 128 + d4 * 4), kv = *(const float4*)(sb + 256 + d4 * 4);
                S[d4 * 4] = fv.x * S[d4 * 4] + kv.x * v; o += qv.x * S[d4 * 4];
                S[d4 * 4 + 1] = fv.y * S[d4 * 4 + 1] + kv.y * v; o += qv.y * S[d4 * 4 + 1];
                S[d4 * 4 + 2] = fv.z * S[d4 * 4 + 2] + kv.z * v; o += qv.z * S[d4 * 4 + 2];
                S[d4 * 4 + 3] = fv.w * S[d4 * 4 + 3] + kv.w * v; o += qv.w * S[d4 * 4 + 3];
                if ((d4 & 3) == 3) asm volatile("" : "+v"(o) :: "memory");
            }
            p.hgo[(size_t)t * D + h * 128 + e] = o;
        }
        float* so = p.hg_s + (((size_t)j * NS + nn) * 8 + h) * 128 * 128 + e;
#pragma unroll
        for (int d = 0; d < 128; ++d) so[(size_t)d * 128] = S[d];
    }
}

__device__ __forceinline__ void ph_dn_rec2(const Params& p, int j, char* smem, int bid, int nblk) {
    const int tidx = tid_opaque();
    const int lane = tidx & 63, wid = tidx >> 6;
    float* sb = (float*)(smem + wid * 2048);
    const int wave = wid * nblk + bid, nw = nblk * 4;
    for (int item = wave; item < NS * 4 * 2; item += nw) {
        const int hf = item & 1, h = (item >> 1) & 3, nn = item >> 3;
        const int e = hf * 64 + lane;
        const float* s0 = p.state_delta + (((size_t)j * NS + nn) * 4 + h) * 128 * 128 + e;
        float S[128];
#pragma unroll
        for (int d = 0; d < 128; ++d) S[d] = s0[(size_t)d * 128];
        for (int st = 0; st < LS; ++st) {
            const int ts = nn * LS + st;
            const bf16_t* row = p.dnqkv + (size_t)ts * CONV_CH + h * 128;
            const float q0 = bf2f(row[lane]), q1 = bf2f(row[lane + 64]), k0 = bf2f(row[512 + lane]), k1 = bf2f(row[512 + lane + 64]);
            sb[lane] = q0; sb[lane + 64] = q1; sb[128 + lane] = k0; sb[128 + lane + 64] = k1;
            float qk = q0 * k0 + q1 * k1;
            for (int off = 32; off > 0; off >>= 1) qk += __shfl_xor(qk, off);
            const float v = bf2f(row[1024 + e]);
            const float g = p.dngb[(size_t)ts * 8 + h], beta = p.dngb[(size_t)ts * 8 + 4 + h];
            float kS = 0.f, qS = 0.f;
#pragma unroll
            for (int d4 = 0; d4 < 32; ++d4) {
                const float4 qv = *(const float4*)(sb + d4 * 4), kv = *(const float4*)(sb + 128 + d4 * 4);
                kS += kv.x * S[d4 * 4] + kv.y * S[d4 * 4 + 1] + kv.z * S[d4 * 4 + 2] + kv.w * S[d4 * 4 + 3];
                qS += qv.x * S[d4 * 4] + qv.y * S[d4 * 4 + 1] + qv.z * S[d4 * 4 + 2] + qv.w * S[d4 * 4 + 3];
                if ((d4 & 3) == 3) asm volatile("" : "+v"(kS), "+v"(qS) :: "memory");
            }
            const float a = __expf(g);
            const float vn = beta * (v - a * kS);
            p.dno[(size_t)ts * 512 + h * 128 + e] = 0.08838834764831845f * (a * qS + qk * vn);
#pragma unroll
            for (int d4 = 0; d4 < 32; ++d4) {
                const float4 kv = *(const float4*)(sb + 128 + d4 * 4);
                S[d4 * 4] = a * S[d4 * 4] + kv.x * vn; S[d4 * 4 + 1] = a * S[d4 * 4 + 1] + kv.y * vn;
                S[d4 * 4 + 2] = a * S[d4 * 4 + 2] + kv.z * vn; S[d4 * 4 + 3] = a * S[d4 * 4 + 3] + kv.w * vn;
                if ((d4 & 3) == 3) asm volatile("" : "+v"(S[d4 * 4 + 3]) :: "memory");
            }
        }
        float* so = p.delta_s + (((size_t)j * NS + nn) * 4 + h) * 128 * 128 + e;
#pragma unroll
        for (int d = 0; d < 128; ++d) so[(size_t)d * 128] = S[d];
    }
}

__device__ __forceinline__ void ph_hg_post(const Params& p, int j) {
    const int tidx = tid_opaque();
    const int lane = tidx & 63, grp = lane >> 4, l16 = lane & 15;
    const int wave = blockIdx.x * 4 + (tidx >> 6), nw = gridDim.x * 4;
    const float4 nc0 = *(const float4*)(p.norm_c + j * 128 + l16 * 8), nc1 = *(const float4*)(p.norm_c + j * 128 + l16 * 8 + 4);
    for (int it = wave; it < T * 2; it += nw) {
        const int item = it * 4 + grp, t = item >> 3, h = item & 7;
        const float* op = p.hgo + (size_t)t * D + h * 128 + l16 * 8;
        const float4 a0 = *(const float4*)op, a1 = *(const float4*)(op + 4);
        const uint4 gv = *(const uint4*)(p.proj + (size_t)t * ODD_LD + 3072 + h * 128 + l16 * 8);
        float ss = a0.x * a0.x + a0.y * a0.y + a0.z * a0.z + a0.w * a0.w + a1.x * a1.x + a1.y * a1.y + a1.z * a1.z + a1.w * a1.w;
        ss += __shfl_xor(ss, 1); ss += __shfl_xor(ss, 2); ss += __shfl_xor(ss, 4); ss += __shfl_xor(ss, 8);
        const float r = rsqrtf(ss * (1.0f / 128.0f) + EPS);
        const float4 g0 = unpack4(make_uint2(gv.x, gv.y)), g1 = unpack4(make_uint2(gv.z, gv.w));
        uint4 o;
        o.x = pack_bf16(a0.x * r * nc0.x * siluf_(g0.x), a0.y * r * nc0.y * siluf_(g0.y));
        o.y = pack_bf16(a0.z * r * nc0.z * siluf_(g0.z), a0.w * r * nc0.w * siluf_(g0.w));
        o.z = pack_bf16(a1.x * r * nc1.x * siluf_(g1.x), a1.y * r * nc1.y * siluf_(g1.y));
        o.w = pack_bf16(a1.z * r * nc1.z * siluf_(g1.z), a1.w * r * nc1.w * siluf_(g1.w));
        *(uint4*)(p.qb + (size_t)t * D + h * 128 + l16 * 8) = o;
    }
}

#define XB_TMO      128
#define XB_XCNT(j)  (256  + 64 * (j))
#define XB_XSUB(j)  (1280 + 64 * (j))
#define XB_XGEN(j)  (2304 + 64 * (j))
#define XB_TOP      3328
#define XB_TOPGEN   3392
#define XCD_BAR_WORDS 3456
#define XB_SPIN_CAP (1u << 20)
__device__ __forceinline__ unsigned xb_ld(unsigned* p)              { return __hip_atomic_load(p, __ATOMIC_RELAXED, __HIP_MEMORY_SCOPE_AGENT); }
__device__ __forceinline__ unsigned xb_add(unsigned* p, unsigned v) { return __hip_atomic_fetch_add(p, v, __ATOMIC_RELAXED, __HIP_MEMORY_SCOPE_AGENT); }
__device__ __forceinline__ unsigned xb_xcc_id() { return (unsigned)__builtin_amdgcn_s_getreg((3 << 11) | 20) & 0xFu; }
#define XB_SPIN(cond, bar) do { unsigned _sp = 0; while (cond) { __builtin_amdgcn_s_sleep(1); \
    if ((++_sp & 255u) == 0u) { if (xb_ld(&(bar)[XB_TMO])) break; if (_sp > XB_SPIN_CAP) { atomicAdd(&(bar)[XB_TMO], 1u); break; } } } } while (0)
struct XcdBarrier { unsigned* bar; unsigned x, nloc, nx, rank, even; };

__device__ __forceinline__ XcdBarrier xcd_setup(unsigned* bar, char* smem) {
    XcdBarrier b; b.bar = bar; b.x = xb_xcc_id();
    volatile unsigned* st = (volatile unsigned*)smem;
    if (threadIdx.x == 0) {
        st[2] = xb_add(&bar[XB_XCNT(b.x)], 1u);
        const unsigned G = gridDim.x;
        unsigned sum, cnt, mine, sp = 0u;
        for (;;) {
            sum = 0u; cnt = 0u; mine = 0u;
#pragma unroll
            for (unsigned jx = 0; jx < 16; ++jx) { const unsigned c = xb_ld(&bar[XB_XCNT(jx)]); sum += c; cnt += (c > 0u) ? 1u : 0u; mine = (jx == b.x) ? c : mine; }
            if (sum == G) break;
            __builtin_amdgcn_s_sleep(1);
            if ((++sp & 255u) == 0u) { if (xb_ld(&bar[XB_TMO])) break; if (sp > XB_SPIN_CAP) { atomicAdd(&bar[XB_TMO], 1u); break; } }
        }
        st[0] = mine > 0u ? mine : 1u; st[1] = cnt > 0u ? cnt : 1u;
        unsigned ev = (sum == G && cnt == 8u) ? 1u : 0u;
#pragma unroll
        for (unsigned jx = 0; jx < 16; ++jx) { const unsigned c = xb_ld(&bar[XB_XCNT(jx)]); if (c != 0u && c * 8u != G) ev = 0u; }
        st[3] = ev;
    }
    __syncthreads();
    b.nloc = __builtin_amdgcn_readfirstlane(st[0]); b.nx = __builtin_amdgcn_readfirstlane(st[1]); b.rank = __builtin_amdgcn_readfirstlane(st[2]); b.even = __builtin_amdgcn_readfirstlane(st[3]);
    __syncthreads();
    return b;
}

__device__ __forceinline__ void xcd_barrier(const XcdBarrier& b) {
    asm volatile("s_waitcnt vmcnt(0)" ::: "memory");
    __syncthreads();
    if (threadIdx.x == 0) {
        unsigned* bar = b.bar;
        __builtin_amdgcn_s_waitcnt(0);
        const unsigned nloc = b.nloc, nx = b.nx;
        const unsigned old = xb_add(&bar[XB_XSUB(b.x)], 1u);
        const unsigned gen = old / nloc;
        if (old + 1u == (gen + 1u) * nloc) {
            __builtin_amdgcn_fence(__ATOMIC_RELEASE, "agent");
            asm volatile("s_waitcnt vmcnt(0)" ::: "memory");
            const unsigned og = xb_add(&bar[XB_TOP], 1u);
            const unsigned tg = og / nx;
            if (og + 1u == (tg + 1u) * nx) xb_add(&bar[XB_TOPGEN], 1u);
            else XB_SPIN(xb_ld(&bar[XB_TOPGEN]) == tg, bar);
            __builtin_amdgcn_fence(__ATOMIC_ACQUIRE, "agent");
            xb_add(&bar[XB_XGEN(b.x)], 1u);
            asm volatile("s_waitcnt vmcnt(0)" ::: "memory");
        } else {
            XB_SPIN(xb_ld(&bar[XB_XGEN(b.x)]) == gen, bar);
            __builtin_amdgcn_fence(__ATOMIC_ACQUIRE, "agent");
            asm volatile("s_waitcnt vmcnt(0)" ::: "memory");
        }
    }
    __syncthreads();
}

template <int LAYER>
__device__ __forceinline__ void run_layer(const Params& p, const XcdBarrier& xb, const TileCtx& tc, char* smem) {
    constexpr int layer = LAYER;
    constexpr int j = LAYER >> 1;
        if constexpr ((LAYER & 1) == 0) {
            ph_gemm_in<0>(p, p.xb, p.wt_in_even + (size_t)j * EVEN_LD * D, EVEN_LD, D, layer, smem);
            ph_conv_p(p, layer);
            xcd_barrier(xb);
            ph_dn_prep(p, j, smem);
            ph_dn_pre(p, j);
            ph_swa_pre(p, j);
            ph_swa_prep2(p, j, smem);
            xcd_barrier(xb);
            if (blockIdx.x < 32) ph_dn_scan(p, j, smem);
            else { const int bid = __builtin_amdgcn_readfirstlane((int)blockIdx.x - 32), nbk = __builtin_amdgcn_readfirstlane((int)gridDim.x - 32); ph_dn_rec2(p, j, smem, bid, nbk); ph_swa_attn2(p, j, bid, nbk);
                   TileCtx ts; ts.x = -1; ts.lb = bid; ts.nlb = nbk;
                   ph_gemm<3>(p, ts, p.pb, p.wt_proj + (size_t)layer * D * PLE, D, PLE, layer, smem);
                   if (LAYER == 0) ph_weights(p, 1, smem, bid, nbk); }
            xcd_barrier(xb);
            ph_dn_out(p, j);
            ph_dn_post(p, j);
            xcd_barrier(xb);
            ph_gemm<2>(p, tc, p.qb, p.wt_out_even + (size_t)j * D * D, D, D, layer, smem);
        } else {
            ph_gemm_in<1>(p, p.xb, p.wt_in_odd + (size_t)j * ODD_LD * D, ODD_LD, D, layer, smem);
            ph_conv_p(p, layer);
            xcd_barrier(xb);
            ph_hg_prep(p, j, smem);
            xcd_barrier(xb);
            if (blockIdx.x < 64) ph_hg_scan(p, j, smem);
            else {
                const int bid = __builtin_amdgcn_readfirstlane((int)blockIdx.x - 64), nbk = __builtin_amdgcn_readfirstlane((int)gridDim.x - 64);
                TileCtx ts; ts.x = -1; ts.lb = bid; ts.nlb = nbk;
                ph_hg_rec2(p, j, smem, bid, nbk);
                ph_gemm<3>(p, ts, p.pb, p.wt_proj + (size_t)layer * D * PLE, D, PLE, layer, smem);
                if (LAYER == 1) { ph_weights(p, 2, smem, bid, nbk); ph_weights(p, 3, smem, bid, nbk); }
            }
            xcd_barrier(xb);
            ph_hg_post(p, j);
            xcd_barrier(xb);
            ph_gemm<2>(p, tc, p.qb, p.wt_out_odd + (size_t)j * D * D, D, D, layer, smem);
        }
        xcd_barrier(xb);
        ph_layernorm(p, layer, smem);
        xcd_barrier(xb);
        ph_gemm<4>(p, tc, p.qb, p.wt_gate + (size_t)layer * D * D, D, D, layer, smem);
        if (layer < 3) xcd_barrier(xb);
}

__global__ void __launch_bounds__(256, 2) mega(Params p) {
    char* smem = g_smem;
    const XcdBarrier xb = xcd_setup(p.bar, smem);
    ph_weights(p, 0, smem, blockIdx.x, gridDim.x);
    ph_prep_act(p);
    xcd_barrier(xb);
    TileCtx tc;
    if (xb.even) { tc.x = (int)xb.x; tc.lb = (int)xb.rank; tc.nlb = (int)xb.nloc; }
    else { tc.x = blockIdx.x & 7; tc.lb = blockIdx.x >> 3; tc.nlb = gridDim.x >> 3; }
    run_layer<0>(p, xb, tc, smem);
    run_layer<1>(p, xb, tc, smem);
    run_layer<2>(p, xb, tc, smem);
    run_layer<3>(p, xb, tc, smem);
}

static inline size_t align_up(size_t x) { return (x + 255) & ~(size_t)255; }

extern "C" void kernel_launch(void* const* d_in, const int* in_sizes, int n_in, void* d_out, int out_size, void* d_ws, size_t ws_size, hipStream_t stream) {
    Params p{};
    p.x_prompt = (const float*)d_in[0]; p.x_sample = (const float*)d_in[1]; p.state_conv = (const float*)d_in[2]; p.state_delta = (const float*)d_in[3];
    p.cache_k = (const float*)d_in[4]; p.cache_v = (const float*)d_in[5]; p.state_hgrn = (const float*)d_in[6]; p.p_prompt = (const float*)d_in[7]; p.p_sample = (const float*)d_in[8];
    p.w_in_even = (const float*)d_in[9]; p.conv_w = (const float*)d_in[10]; p.a_log = (const float*)d_in[11]; p.dt_bias = (const float*)d_in[12]; p.norm_a = (const float*)d_in[13];
    p.sinks = (const float*)d_in[14]; p.w_out_even = (const float*)d_in[15]; p.w_in_odd = (const float*)d_in[16]; p.lb_raw = (const float*)d_in[17]; p.norm_c = (const float*)d_in[18];
    p.w_out_odd = (const float*)d_in[19]; p.ln_g = (const float*)d_in[20]; p.ln_b = (const float*)d_in[21]; p.w_ple_proj = (const float*)d_in[22]; p.w_ple_gate = (const float*)d_in[23];
    float* o = (float*)d_out;
    p.y_prompt = o; o += (size_t)TP * D;
    p.y_sample = o; o += (size_t)TS * D;
    p.conv_p = o; o += (size_t)2 * NB * 3 * CONV_CH;
    p.conv_s = o; o += (size_t)2 * NS * 3 * CONV_CH;
    p.delta_p = o; o += (size_t)2 * NB * 4 * 128 * 128;
    p.delta_s = o; o += (size_t)2 * NS * 4 * 128 * 128;
    p.wk_p = o; o += (size_t)2 * NB * 128 * 128;
    p.wk_s = o; o += (size_t)2 * NS * 128 * 128;
    p.wv_p = o; o += (size_t)2 * NB * 128 * 128;
    p.wv_s = o; o += (size_t)2 * NS * 128 * 128;
    p.hg_p = o; o += (size_t)2 * NB * 8 * 128 * 128;
    p.hg_s = o; o += (size_t)2 * NS * 8 * 128 * 128;

    char* w = (char*)d_ws; size_t off = 0;
    auto carve = [&](size_t bytes) { char* r = w + off; off += align_up(bytes); return r; };
    p.wt_in_even = (bf16_t*)carve((size_t)2 * EVEN_LD * D * 2);
    p.wt_out_even = (bf16_t*)carve((size_t)2 * D * D * 2);
    p.wt_in_odd = (bf16_t*)carve((size_t)2 * ODD_LD * D * 2);
    p.wt_out_odd = (bf16_t*)carve((size_t)2 * D * D * 2);
    p.wt_gate = (bf16_t*)carve((size_t)4 * D * D * 2);
    p.wt_proj = (bf16_t*)carve((size_t)4 * D * PLE * 2);
    p.p2 = (bf16_t*)carve((size_t)T * D * 2);
    p.xb = (bf16_t*)carve((size_t)T * D * 2);
    p.qb = (bf16_t*)carve((size_t)T * D * 2);
    p.pb = (bf16_t*)carve((size_t)T * PLE * 2);
    p.proj = (bf16_t*)carve((size_t)T * ODD_LD * 2);
    p.aux = (float*)carve((size_t)T * 8 * 4);
    p.rope = (float*)carve((size_t)(SEQ + LS) * 16 * 4);
    p.bar = (unsigned*)carve((size_t)XCD_BAR_WORDS * 4);
    char* scr = w + off;
    {
        size_t o2 = 0;
        auto c2 = [&](size_t bytes) { char* r = scr + o2; o2 += align_up(bytes); return r; };
        p.dnqkv = (bf16_t*)c2((size_t)TS * CONV_CH * 2);
        p.dngb = (float*)c2((size_t)TS * 8 * 4);
        p.dno = (float*)c2((size_t)TS * 512 * 4);
        p.qr = (bf16_t*)c2((size_t)T * 512 * 2);
        p.dnrec = c2((size_t)16 * 64 * DR_SIZE);
        p.dnsp = c2((size_t)16 * 64 * 32768);
        p.dngl = (float*)c2((size_t)16 * 64 * 4);
        p.krb = (bf16_t*)c2((size_t)TP * 128 * 2);
        p.vT = (bf16_t*)c2((size_t)NB * 128 * SEQ * 2);
        p.kcat = (bf16_t*)c2((size_t)NS * 2 * 144 * 64 * 2);
        p.vTcat = (bf16_t*)c2((size_t)NS * 128 * 160 * 2);
    }
    p.hgo = (float*)scr;
    p.hgrec = scr + align_up((size_t)T * D * 4);
    p.hgv = p.hgrec + (size_t)32 * 128 * REC_SIZE;

    static int grid_blocks = 0;
    if (!grid_blocks) {
        int dev = 0, cus = 0, per_cu = 0;
        hipGetDevice(&dev);
        hipDeviceGetAttribute(&cus, hipDeviceAttributeMultiprocessorCount, dev);
        hipOccupancyMaxActiveBlocksPerMultiprocessor(&per_cu, mega, 256, 0);
        if (per_cu > 2) per_cu = 2;
        grid_blocks = cus * per_cu;
    }
    hipMemsetAsync(p.bar, 0, (size_t)XCD_BAR_WORDS * 4, stream);
    void* args[] = {&p};
    hipError_t e = hipLaunchCooperativeKernel((void*)mega, dim3(grid_blocks), dim3(256), args, 0, stream);
    if (e != hipSuccess) fprintf(stderr, "cooperative launch failed: %s (grid %d)\n", hipGetErrorString(e), grid_blocks);
}
```

```cpp
#include <hip/hip_runtime.h>
#include <hip/hip_cooperative_groups.h>
#include <cstdio>
namespace cg = cooperative_groups;
#include <stdint.h>
#include <math.h>

typedef unsigned short bf16_t;
typedef __attribute__((ext_vector_type(8))) short bf16x8;
typedef __attribute__((ext_vector_type(4))) float f32x4;

constexpr int D = 1024;
constexpr int NB = 4, SEQ = 4096, NS = 128, LS = 8;
constexpr int TP = NB * SEQ;
constexpr int TS = NS * LS;
constexpr int T = TP + TS;
constexpr int PLE = 256;
constexpr int EVEN_IN = 3336, EVEN_LD = 3456, ODD_LD = 4096;
constexpr int CONV_CH = 1536;
constexpr int C_QKV = 0, C_GA = 1536, C_QB = 2048, C_KB = 2560, C_VB = 2688, C_GB = 2816, C_AB = 3328;
constexpr float ALPHA = 1.681792830507429f;
constexpr float EPS = 1e-6f;

typedef __bf16 hw_bf16x2 __attribute__((ext_vector_type(2)));
typedef float hw_f32x2 __attribute__((ext_vector_type(2)));
__device__ __forceinline__ bf16_t f2bf(float f) { return __builtin_bit_cast(unsigned short, (__bf16)f); }
__device__ __forceinline__ unsigned pack_bf16(float lo, float hi) { const hw_f32x2 v = {lo, hi}; return __builtin_bit_cast(unsigned, __builtin_convertvector(v, hw_bf16x2)); }
__device__ __forceinline__ float4 unpack4(uint2 v) {
    float4 r; r.x = __uint_as_float(v.x << 16); r.y = __uint_as_float(v.x & 0xffff0000u); r.z = __uint_as_float(v.y << 16); r.w = __uint_as_float(v.y & 0xffff0000u); return r;
}
__device__ __forceinline__ void unpack8(const uint4 v, float (&f)[8]) {
    f[0] = __uint_as_float(v.x << 16); f[1] = __uint_as_float(v.x & 0xffff0000u); f[2] = __uint_as_float(v.y << 16); f[3] = __uint_as_float(v.y & 0xffff0000u);
    f[4] = __uint_as_float(v.z << 16); f[5] = __uint_as_float(v.z & 0xffff0000u); f[6] = __uint_as_float(v.w << 16); f[7] = __uint_as_float(v.w & 0xffff0000u);
}
__device__ __forceinline__ float bf2f(bf16_t h) { return __uint_as_float(((unsigned)h) << 16); }
__device__ __forceinline__ float sigmoidf_(float x) { return 1.0f / (1.0f + __expf(-x)); }
__device__ __forceinline__ float siluf_(float x) { return x / (1.0f + __expf(-x)); }
__device__ __forceinline__ float softplusf_(float x) { return fmaxf(x, 0.0f) + log1pf(__expf(-fabsf(x))); }

__shared__ __attribute__((aligned(16))) char g_smem[65536];

__device__ __forceinline__ int tid_opaque() { int t = threadIdx.x; asm volatile("" : "+v"(t)); return t; }

#define MEMFENCE() asm volatile("" ::: "memory")
#define LAUNDER(ptr) asm volatile("" : "+v"(ptr))

#define LAS __attribute__((address_space(3)))
__device__ __forceinline__ unsigned lds_base_addr() { return (unsigned)(size_t)(LAS char*)g_smem; }
__device__ __forceinline__ void glds16_asm(const void* gsrc, unsigned lds_dst) {
    unsigned keep;
    asm volatile("s_mov_b32 %0, m0\n\ts_mov_b32 m0, %2\n\ts_nop 0\n\tglobal_load_lds_dwordx4 %1, off\n\ts_mov_b32 m0, %0" : "=&s"(keep) : "v"(gsrc), "s"(lds_dst) : "memory");
}

struct Params {
    const float* x_prompt; const float* x_sample; const float* state_conv; const float* state_delta;
    const float* cache_k; const float* cache_v; const float* state_hgrn; const float* p_prompt; const float* p_sample;
    const float* w_in_even; const float* conv_w; const float* a_log; const float* dt_bias; const float* norm_a; const float* sinks;
    const float* w_out_even; const float* w_in_odd; const float* lb_raw; const float* norm_c; const float* w_out_odd;
    const float* ln_g; const float* ln_b; const float* w_ple_proj; const float* w_ple_gate;
    float* y_prompt; float* y_sample; float* conv_p; float* conv_s; float* delta_p; float* delta_s;
    float* wk_p; float* wk_s; float* wv_p; float* wv_s; float* hg_p; float* hg_s;
    bf16_t* wt_in_even; bf16_t* wt_out_even; bf16_t* wt_in_odd; bf16_t* wt_out_odd; bf16_t* wt_gate; bf16_t* wt_proj;
    bf16_t* p2; bf16_t* xb; bf16_t* qb; bf16_t* pb; bf16_t* proj; float* aux; float* rope;
    bf16_t* dnqkv; float* dngb; float* dno; bf16_t* qr; float* kr; bf16_t* krb; bf16_t* vT; bf16_t* kcat; bf16_t* vTcat; float* hgo; char* hgrec; char* hgv; char* dnrec; char* dnsp; float* dngl; unsigned* bar;
};

__device__ __forceinline__ int even_col_map(int n) {
    if (n < 2048) return n;
    if (n < 3328) return n + 8;
    if (n < 3336) return n - 3328 + 2048;
    return -1;
}
__device__ __forceinline__ void ph_transpose(const float* __restrict__ src, bf16_t* __restrict__ dst, int K, int Nsrc, int Ndst, int remap, char* smem, int bid, int nblk) {
    const int tidx = tid_opaque();
    float (*tile)[65] = (float (*)[65])smem;
    const int ntn = Ndst / 64, ntk = K / 64;
    for (int tIdx = bid; tIdx < ntn * ntk; tIdx += nblk) {
        const int tn = tIdx % ntn, tk = tIdx / ntn;
        const int n0 = tn * 64, k0 = tk * 64;
#pragma unroll
        for (int u = 0; u < 4; ++u) {
            const int e = tidx + 256 * u, kk = e >> 4, n4 = (e & 15) * 4;
            const int n = n0 + n4;
            const int sn = remap ? even_col_map(n) : n;
            float4 v = make_float4(0.f, 0.f, 0.f, 0.f);
            if (sn >= 0 && sn + 3 < Nsrc) v = *(const float4*)(src + (size_t)(k0 + kk) * Nsrc + sn);
            tile[kk][n4] = v.x; tile[kk][n4 + 1] = v.y; tile[kk][n4 + 2] = v.z; tile[kk][n4 + 3] = v.w;
        }
        __syncthreads();
#pragma unroll
        for (int u = 0; u < 2; ++u) {
            const int e = tidx + 256 * u, nn = e >> 3, kc = (e & 7) * 8;
            uint4 o;
            o.x = pack_bf16(tile[kc][nn], tile[kc + 1][nn]); o.y = pack_bf16(tile[kc + 2][nn], tile[kc + 3][nn]);
            o.z = pack_bf16(tile[kc + 4][nn], tile[kc + 5][nn]); o.w = pack_bf16(tile[kc + 6][nn], tile[kc + 7][nn]);
            *(uint4*)(dst + (size_t)(n0 + nn) * K + k0 + kc) = o;
        }
        __syncthreads();
    }
}

__device__ __forceinline__ void ph_weights(const Params& p, int layer, char* smem, int bid, int nblk) {
    const int j = layer >> 1;
    __syncthreads();
    if ((layer & 1) == 0) {
        ph_transpose(p.w_in_even + (size_t)j * D * EVEN_IN, p.wt_in_even + (size_t)j * EVEN_LD * D, D, EVEN_IN, EVEN_LD, 1, smem, bid, nblk);
        ph_transpose(p.w_out_even + (size_t)j * D * D, p.wt_out_even + (size_t)j * D * D, D, D, D, 0, smem, bid, nblk);
    } else {
        ph_transpose(p.w_in_odd + (size_t)j * D * ODD_LD, p.wt_in_odd + (size_t)j * ODD_LD * D, D, ODD_LD, ODD_LD, 0, smem, bid, nblk);
        ph_transpose(p.w_out_odd + (size_t)j * D * D, p.wt_out_odd + (size_t)j * D * D, D, D, D, 0, smem, bid, nblk);
    }
    ph_transpose(p.w_ple_gate + (size_t)layer * D * D, p.wt_gate + (size_t)layer * D * D, D, D, D, 0, smem, bid, nblk);
    ph_transpose(p.w_ple_proj + (size_t)layer * PLE * D, p.wt_proj + (size_t)layer * D * PLE, PLE, D, D, 0, smem, bid, nblk);
}

__device__ __forceinline__ void ph_prep_act(const Params& p) {
    const int tidx = tid_opaque();
    const size_t gtid = (size_t)blockIdx.x * 256 + tidx, gsz = (size_t)gridDim.x * 256;
    for (size_t i = gtid; i < (size_t)T * D / 4; i += gsz) {
        const size_t e = i * 4; const int t = (int)(e / D);
        const float4 v = (t < TP) ? *(const float4*)(p.x_prompt + e) : *(const float4*)(p.x_sample + (e - (size_t)TP * D));
        ushort4 o; o.x = f2bf(v.x); o.y = f2bf(v.y); o.z = f2bf(v.z); o.w = f2bf(v.w);
        *(ushort4*)(p.xb + e) = o;
    }
    for (size_t i = gtid; i < (size_t)(SEQ + LS) * 8; i += gsz) {
        const int pi = (int)(i / 8), fi = (int)(i % 8);
        const float pos = (pi < SEQ) ? (float)pi : (float)(8192 + pi - SEQ);
        const float inv = powf(500000.0f, -(float)(2 * fi) / 16.0f);
        const float ang = pos * inv;
        float s, c; sincosf(ang, &s, &c);
        p.rope[(size_t)pi * 16 + fi] = c; p.rope[(size_t)pi * 16 + 8 + fi] = s;
    }
}

template <int TS>
__device__ __forceinline__ void gemm_mainloop(f32x4 (&acc)[TS / 32][TS / 32], const bf16_t* __restrict__ A, int lda, const bf16_t* __restrict__ Bt, int ldb,
                                              int K, int row0, int col0, char* smem) {
    constexpr int NI = TS / 64, F = TS / 32, WT = TS / 2, OPB = TS * 64, SS = 2 * OPB;
    const int tidx = tid_opaque();
    const int lane = tidx & 63, wid = tidx >> 6;
    const int wr = wid >> 1, wc = wid & 1;
    const int nk = K / 32;
    const int srow = wid * (16 * NI) + (lane >> 2), schk = (lane & 3) ^ (2 * (lane >> 5));
    const bf16_t* gA = A + (size_t)(row0 + srow) * lda + schk * 8;
    const bf16_t* gB = Bt + (size_t)(col0 + srow) * ldb + schk * 8;
    const unsigned lbase = __builtin_amdgcn_readfirstlane(lds_base_addr() + wid * (NI * 1024));
#define GSTAGE(stage, kt_) { const unsigned d_ = lbase + (stage) * SS; const int k0_ = (kt_) * 32; \
        glds16_asm(gA + k0_, d_); if (NI == 2) glds16_asm(gA + (size_t)16 * lda + k0_, d_ + 1024); \
        glds16_asm(gB + k0_, d_ + OPB); if (NI == 2) glds16_asm(gB + (size_t)16 * ldb + k0_, d_ + OPB + 1024); }
    const int fr = lane & 15, fq = lane >> 4;
    const int foff = fr * 64 + ((fq ^ (2 * (fr >> 3))) << 4);
    __syncthreads();
    GSTAGE(0, 0);
    if (nk > 1) GSTAGE(1, 1);
    if (nk > 2) GSTAGE(2, 2);
#pragma unroll 1
    for (int kt = 0; kt < nk; ++kt) {
        if (NI == 2) {
            if (kt + 2 < nk) asm volatile("s_waitcnt vmcnt(8)" ::: "memory");
            else if (kt + 1 < nk) asm volatile("s_waitcnt vmcnt(4)" ::: "memory");
            else asm volatile("s_waitcnt vmcnt(0)" ::: "memory");
        } else {
            if (kt + 2 < nk) asm volatile("s_waitcnt vmcnt(4)" ::: "memory");
            else if (kt + 1 < nk) asm volatile("s_waitcnt vmcnt(2)" ::: "memory");
            else asm volatile("s_waitcnt vmcnt(0)" ::: "memory");
        }
        __builtin_amdgcn_s_barrier();
        MEMFENCE();
        if (kt + 3 < nk) GSTAGE((kt + 3) & 3, kt + 3);
        const char* sA = smem + (kt & 3) * SS + foff;
        const char* sB = sA + OPB;
        bf16x8 af[F], bfr[F];
#pragma unroll
        for (int m = 0; m < F; ++m) af[m] = *(const bf16x8*)(sA + (wr * WT + m * 16) * 64);
#pragma unroll
        for (int n = 0; n < F; ++n) bfr[n] = *(const bf16x8*)(sB + (wc * WT + n * 16) * 64);
#pragma unroll
        for (int m = 0; m < F; ++m)
#pragma unroll
            for (int n = 0; n < F; ++n)
                acc[m][n] = __builtin_amdgcn_mfma_f32_16x16x32_bf16(bfr[n], af[m], acc[m][n], 0, 0, 0);
    }
    asm volatile("s_waitcnt lgkmcnt(0)" ::: "memory");
    __syncthreads();
#undef GSTAGE
}

struct TileCtx { int x, lb, nlb; };
__device__ __forceinline__ bool gemm_next(const TileCtx& tc, int it, int ntn, int& pm, int& pn, int& quarter) {
    const int total = (tc.x < 0 ? 136 : 17) * ntn;
    const int full_rounds = total / tc.nlb, nfull = full_rounds * tc.nlb;
    int i;
    if (it < full_rounds) { i = tc.lb + it * tc.nlb; quarter = -1; }
    else {
        const int qi = tc.lb + (it - full_rounds) * tc.nlb;
        if (qi >= 4 * (total - nfull)) return false;
        i = nfull + (qi >> 2); quarter = qi & 3;
    }
    if (tc.x < 0) { pm = i / ntn; pn = i % ntn; return true; }
    const int g = i / (17 * 8);
    const int w = (ntn - g * 8) < 8 ? (ntn - g * 8) : 8;
    const int r = i - g * 17 * 8;
    pm = tc.x * 17 + r / w; pn = g * 8 + r % w;
    return true;
}

template <int EPI, int TS>
__device__ __forceinline__ void gemm_tile_body(const Params& p, const bf16_t* __restrict__ A, const bf16_t* __restrict__ Bt, int K, int layer, int row0, int col0, char* smem) {
    constexpr int F = TS / 32, WT = TS / 2, ELD = TS * 2 + 16, CH = TS / 8, RPP = 256 / CH, NP = TS / RPP;
    const int tidx = tid_opaque();
    const int lane = tidx & 63, wid = tidx >> 6, wr = wid >> 1, wc = wid & 1;
    f32x4 acc[F][F];
#pragma unroll
    for (int m = 0; m < F; ++m)
#pragma unroll
        for (int n = 0; n < F; ++n) acc[m][n] = (f32x4){0.f, 0.f, 0.f, 0.f};
    gemm_mainloop<TS>(acc, A, K, Bt, K, K, row0, col0, smem);
    if (EPI == 0) {
        const int j = layer >> 1;
        if ((col0 & ~127) == C_AB || col0 < CONV_CH) {
#pragma unroll
            for (int m = 0; m < F; ++m) {
                const int row = row0 + wr * WT + m * 16 + (lane & 15);
#pragma unroll
                for (int n = 0; n < F; ++n) {
                    const int col = col0 + wc * WT + n * 16 + 4 * (lane >> 4);
                    const f32x4 v = acc[m][n];
                    if (col >= C_AB && col < C_AB + 8) *(float4*)(p.aux + (size_t)row * 8 + (col - C_AB)) = make_float4(v[0], v[1], v[2], v[3]);
                    if (col < CONV_CH) {
                        if (row < TP) {
                            const int b = row / SEQ, sq = row % SEQ;
                            if (sq >= SEQ - 3) *(float4*)(p.conv_p + (((size_t)j * NB + b) * 3 + (sq - (SEQ - 3))) * CONV_CH + col) = make_float4(v[0], v[1], v[2], v[3]);
                        } else {
                            const int r2 = row - TP, nn = r2 / LS, sq = r2 % LS;
                            if (sq >= LS - 3) *(float4*)(p.conv_s + (((size_t)j * NS + nn) * 3 + (sq - (LS - 3))) * CONV_CH + col) = make_float4(v[0], v[1], v[2], v[3]);
                        }
                    }
                }
            }
        }
    }
#pragma unroll
    for (int m = 0; m < F; ++m) {
        const int r = wr * WT + m * 16 + (lane & 15);
#pragma unroll
        for (int n = 0; n < F; ++n) {
            const int c = wc * WT + n * 16 + 4 * (lane >> 4);
            uint2 o; o.x = pack_bf16(acc[m][n][0], acc[m][n][1]); o.y = pack_bf16(acc[m][n][2], acc[m][n][3]);
            *(uint2*)(smem + r * ELD + c * 2) = o;
        }
    }
    __syncthreads();
    const int chunk = tidx & (CH - 1), rbase = tidx / CH;
#pragma unroll
    for (int i = 0; i < NP; ++i) {
        const int rl = rbase + RPP * i, row = row0 + rl, col = col0 + chunk * 8;
        const uint4 sv = *(const uint4*)(smem + rl * ELD + chunk * 16);
        if (EPI == 0) *(uint4*)(p.proj + (size_t)row * EVEN_LD + col) = sv;
        else if (EPI == 1) *(uint4*)(p.proj + (size_t)row * ODD_LD + col) = sv;
        else if (EPI == 3) *(uint4*)(p.p2 + (size_t)row * D + col) = sv;
        else {
            const float4 a0 = unpack4(make_uint2(sv.x, sv.y)), a1 = unpack4(make_uint2(sv.z, sv.w));
            if (EPI == 2) {
                uint4* xp = (uint4*)(p.xb + (size_t)row * D + col);
                const uint4 xv = *xp;
                const float4 x0 = unpack4(make_uint2(xv.x, xv.y)), x1 = unpack4(make_uint2(xv.z, xv.w));
                uint4 o;
                o.x = pack_bf16(ALPHA * x0.x + a0.x, ALPHA * x0.y + a0.y); o.y = pack_bf16(ALPHA * x0.z + a0.z, ALPHA * x0.w + a0.w);
                o.z = pack_bf16(ALPHA * x1.x + a1.x, ALPHA * x1.y + a1.y); o.w = pack_bf16(ALPHA * x1.z + a1.z, ALPHA * x1.w + a1.w);
                *xp = o;
            } else {
                const uint4 hv = *(const uint4*)(p.qb + (size_t)row * D + col);
                const uint4 pv = *(const uint4*)(p.p2 + (size_t)row * D + col);
                const float4 x0 = unpack4(make_uint2(hv.x, hv.y)), x1 = unpack4(make_uint2(hv.z, hv.w));
                const float4 p0 = unpack4(make_uint2(pv.x, pv.y)), p1 = unpack4(make_uint2(pv.z, pv.w));
                float4 o0, o1;
                o0.x = x0.x + sigmoidf_(a0.x) * p0.x; o0.y = x0.y + sigmoidf_(a0.y) * p0.y; o0.z = x0.z + sigmoidf_(a0.z) * p0.z; o0.w = x0.w + sigmoidf_(a0.w) * p0.w;
                o1.x = x1.x + sigmoidf_(a1.x) * p1.x; o1.y = x1.y + sigmoidf_(a1.y) * p1.y; o1.z = x1.z + sigmoidf_(a1.z) * p1.z; o1.w = x1.w + sigmoidf_(a1.w) * p1.w;
                if (layer == 3) {
                    float* yp = (row < TP) ? p.y_prompt + (size_t)row * D + col : p.y_sample + (size_t)(row - TP) * D + col;
                    *(float4*)yp = o0; *(float4*)(yp + 4) = o1;
                } else {
                    uint4 ob; ob.x = pack_bf16(o0.x, o0.y); ob.y = pack_bf16(o0.z, o0.w); ob.z = pack_bf16(o1.x, o1.y); ob.w = pack_bf16(o1.z, o1.w);
                    *(uint4*)(p.xb + (size_t)row * D + col) = ob;
                }
            }
        }
    }
}

__device__ __forceinline__ void gemm_mainloop_256(f32x4 (&acc)[8][4], const bf16_t* __restrict__ A, int lda, const bf16_t* __restrict__ Bt, int ldb,
                                                  int K, int row0, int col0, char* smem) {
    const int tidx = tid_opaque();
    const int lane = tidx & 63, wid = tidx >> 6;
    const int wr = wid >> 1, wc = wid & 1;
    const int nk = K / 32;
    const int schk = (lane & 3) ^ (2 * (lane >> 5));
    const bf16_t* gA = A + (size_t)(row0 + wid * 64 + (lane >> 2)) * lda + schk * 8;
    const bf16_t* gB = Bt + (size_t)(col0 + wid * 32 + (lane >> 2)) * ldb + schk * 8;
    const unsigned lA = __builtin_amdgcn_readfirstlane(lds_base_addr() + wid * 4096);
    const unsigned lB = __builtin_amdgcn_readfirstlane(lds_base_addr() + 16384 + wid * 2048);
#define GSTAGE2(stage, kt_) { const int k0_ = (kt_) * 32; const unsigned so_ = (stage) * 24576; \
        glds16_asm(gA + k0_, lA + so_); glds16_asm(gA + (size_t)16 * lda + k0_, lA + so_ + 1024); glds16_asm(gA + (size_t)32 * lda + k0_, lA + so_ + 2048); glds16_asm(gA + (size_t)48 * lda + k0_, lA + so_ + 3072); \
        glds16_asm(gB + k0_, lB + so_); glds16_asm(gB + (size_t)16 * ldb + k0_, lB + so_ + 1024); }
    const int fr = lane & 15, fq = lane >> 4;
    const int foff = fr * 64 + ((fq ^ (2 * (fr >> 3))) << 4);
    __syncthreads();
    GSTAGE2(0, 0);
#pragma unroll 1
    for (int kt = 0; kt < nk; ++kt) {
        asm volatile("s_waitcnt vmcnt(0)" ::: "memory");
        __builtin_amdgcn_s_barrier();
        MEMFENCE();
        if (kt + 1 < nk) GSTAGE2((kt + 1) & 1, kt + 1);
        const char* sA = smem + (kt & 1) * 24576 + foff;
        const char* sB = sA + 16384;
        bf16x8 bfr[4];
#pragma unroll
        for (int n = 0; n < 4; ++n) bfr[n] = *(const bf16x8*)(sB + (wc * 64 + n * 16) * 64);
#pragma unroll
        for (int m = 0; m < 8; ++m) {
            const bf16x8 af = *(const bf16x8*)(sA + (wr * 128 + m * 16) * 64);
#pragma unroll
            for (int n = 0; n < 4; ++n)
                acc[m][n] = __builtin_amdgcn_mfma_f32_16x16x32_bf16(bfr[n], af, acc[m][n], 0, 0, 0);
        }
    }
    asm volatile("s_waitcnt lgkmcnt(0)" ::: "memory");
    __syncthreads();
#undef GSTAGE2
}

template <int EPI>
__device__ __forceinline__ void gemm_tile_256(const Params& p, const bf16_t* __restrict__ A, const bf16_t* __restrict__ Bt, int K, int layer, int row0, int col0, char* smem) {
    constexpr int ELD = 272;
    const int tidx = tid_opaque();
    const int lane = tidx & 63, wid = tidx >> 6, wr = wid >> 1, wc = wid & 1;
    f32x4 acc[8][4];
#pragma unroll
    for (int m = 0; m < 8; ++m)
#pragma unroll
        for (int n = 0; n < 4; ++n) acc[m][n] = (f32x4){0.f, 0.f, 0.f, 0.f};
    gemm_mainloop_256(acc, A, K, Bt, K, K, row0, col0, smem);
    if (EPI == 0) {
        const int j = layer >> 1;
        if (col0 == C_AB || col0 < CONV_CH) {
#pragma unroll
            for (int m = 0; m < 8; ++m) {
                const int row = row0 + wr * 128 + m * 16 + (lane & 15);
#pragma unroll
                for (int n = 0; n < 4; ++n) {
                    const int col = col0 + wc * 64 + n * 16 + 4 * (lane >> 4);
                    const f32x4 v = acc[m][n];
                    if (col >= C_AB && col < C_AB + 8) *(float4*)(p.aux + (size_t)row * 8 + (col - C_AB)) = make_float4(v[0], v[1], v[2], v[3]);
                    if (col < CONV_CH) {
                        if (row < TP) {
                            const int b = row / SEQ, sq = row % SEQ;
                            if (sq >= SEQ - 3) *(float4*)(p.conv_p + (((size_t)j * NB + b) * 3 + (sq - (SEQ - 3))) * CONV_CH + col) = make_float4(v[0], v[1], v[2], v[3]);
                        } else {
                            const int r2 = row - TP, nn = r2 / LS, sq = r2 % LS;
                            if (sq >= LS - 3) *(float4*)(p.conv_s + (((size_t)j * NS + nn) * 3 + (sq - (LS - 3))) * CONV_CH + col) = make_float4(v[0], v[1], v[2], v[3]);
                        }
                    }
                }
            }
        }
    }
#pragma unroll
    for (int hf = 0; hf < 2; ++hf) {
        if (wr == hf) {
#pragma unroll
            for (int m = 0; m < 8; ++m) {
                const int r = m * 16 + (lane & 15);
#pragma unroll
                for (int n = 0; n < 4; ++n) {
                    const int c = wc * 64 + n * 16 + 4 * (lane >> 4);
                    uint2 o; o.x = pack_bf16(acc[m][n][0], acc[m][n][1]); o.y = pack_bf16(acc[m][n][2], acc[m][n][3]);
                    *(uint2*)(smem + r * ELD + c * 2) = o;
                }
            }
        }
        __syncthreads();
        const int chunk = tidx & 15, rbase = tidx >> 4;
#pragma unroll
        for (int i = 0; i < 8; ++i) {
            const int rl = rbase + 16 * i, row = row0 + hf * 128 + rl, col = col0 + chunk * 8;
            const uint4 sv = *(const uint4*)(smem + rl * ELD + chunk * 16);
            if (EPI == 0) *(uint4*)(p.proj + (size_t)row * EVEN_LD + col) = sv;
            else *(uint4*)(p.proj + (size_t)row * ODD_LD + col) = sv;
        }
        __syncthreads();
    }
}

template <int EPI>
__device__ __forceinline__ void ph_gemm_in(const Params& p, const bf16_t* __restrict__ A, const bf16_t* __restrict__ Bt, int N, int K, int layer, char* smem) {
    const int ntn = N / 128, nt = 68 * ntn, G = gridDim.x;
    const int full = nt / G;
    for (int it = 0; it < full; ++it) {
        const int i = blockIdx.x + it * G;
        gemm_tile_256<EPI>(p, A, Bt, K, layer, (i / ntn) * 256, (i % ntn) * 128, smem);
    }
    const int rem = nt - full * G;
    for (int q = blockIdx.x; q < 2 * rem; q += G) {
        const int i = full * G + (q >> 1);
        gemm_tile_body<EPI, 128>(p, A, Bt, K, layer, (i / ntn) * 256 + (q & 1) * 128, (i % ntn) * 128, smem);
    }
}

template <int EPI>
__device__ __forceinline__ void ph_gemm(const Params& p, const TileCtx& tc, const bf16_t* __restrict__ A, const bf16_t* __restrict__ Bt, int N, int K, int layer, char* smem) {
    const int ntn = N / 128;
    for (int it = 0;; ++it) {
        int pm, pn, quarter;
        if (!gemm_next(tc, it, ntn, pm, pn, quarter)) break;
        if (quarter < 0) gemm_tile_body<EPI, 128>(p, A, Bt, K, layer, pm * 128, pn * 128, smem);
        else gemm_tile_body<EPI, 64>(p, A, Bt, K, layer, pm * 128 + (quarter >> 1) * 64, pn * 128 + (quarter & 1) * 64, smem);
    }
}

__device__ __forceinline__ void ph_layernorm(const Params& p, int layer, char* smem) {
    const int tidx = tid_opaque();
    const float* g = p.ln_g + (size_t)layer * D; const float* b = p.ln_b + (size_t)layer * D;
    const int lane = tidx & 63;
    const int wave = blockIdx.x * 4 + (tidx >> 6), nw = gridDim.x * 4;
    for (int row = wave; row < T; row += nw) {
        const bf16_t* xr = p.xb + (size_t)row * D + lane * 8;
        float v[2][8];
#pragma unroll
        for (int u = 0; u < 2; ++u) unpack8(*(const uint4*)(xr + u * 512), v[u]);
        float s = 0.f;
#pragma unroll
        for (int u = 0; u < 2; ++u)
#pragma unroll
            for (int i = 0; i < 8; ++i) s += v[u][i];
        for (int o = 32; o > 0; o >>= 1) s += __shfl_xor(s, o);
        const float mu = s * (1.0f / D);
        float q = 0.f;
#pragma unroll
        for (int u = 0; u < 2; ++u)
#pragma unroll
            for (int i = 0; i < 8; ++i) { v[u][i] -= mu; q += v[u][i] * v[u][i]; }
        for (int o = 32; o > 0; o >>= 1) q += __shfl_xor(q, o);
        const float rs = rsqrtf(q * (1.0f / D) + EPS);
#pragma unroll
        for (int u = 0; u < 2; ++u) {
            const float* gp = g + lane * 8 + u * 512; const float* bp = b + lane * 8 + u * 512;
            const float4 g0 = *(const float4*)gp, g1 = *(const float4*)(gp + 4), b0 = *(const float4*)bp, b1 = *(const float4*)(bp + 4);
            uint4 ob;
            ob.x = pack_bf16(v[u][0] * rs * g0.x + b0.x, v[u][1] * rs * g0.y + b0.y); ob.y = pack_bf16(v[u][2] * rs * g0.z + b0.z, v[u][3] * rs * g0.w + b0.w);
            ob.z = pack_bf16(v[u][4] * rs * g1.x + b1.x, v[u][5] * rs * g1.y + b1.y); ob.w = pack_bf16(v[u][6] * rs * g1.z + b1.z, v[u][7] * rs * g1.w + b1.w);
            *(uint4*)(p.qb + (size_t)row * D + lane * 8 + u * 512) = ob;
        }
    }
}

__device__ __forceinline__ void ph_conv_p(const Params& p, int layer) {
    const int tidx = tid_opaque();
    const size_t gtid = (size_t)blockIdx.x * 256 + tidx, gsz = (size_t)gridDim.x * 256;
    for (size_t i = gtid; i < (size_t)T * PLE / 4; i += gsz) {
        const size_t e = i * 4;
        const int t = (int)(e / PLE);
        const float4 v = (t < TP) ? *(const float4*)(p.p_prompt + (size_t)layer * TP * PLE + e) : *(const float4*)(p.p_sample + (size_t)layer * TS * PLE + (e - (size_t)TP * PLE));
        ushort4 o; o.x = f2bf(v.x); o.y = f2bf(v.y); o.z = f2bf(v.z); o.w = f2bf(v.w);
        *(ushort4*)(p.pb + e) = o;
    }
}

__device__ __forceinline__ void tok_info(int t, int& smp, int& seq, int& s) {
    if (t < TP) { smp = 0; seq = t / SEQ; s = t % SEQ; } else { smp = 1; seq = (t - TP) / LS; s = (t - TP) % LS; }
}

__device__ __forceinline__ void ph_dn_pre(const Params& p, int j) {
    const int tidx = tid_opaque();
    const int lane = tidx & 63;
    const int wave = blockIdx.x * 4 + (tidx >> 6), nw = gridDim.x * 4;
    const float* cw = p.conv_w + (size_t)j * 4 * CONV_CH;
    for (int item = TP * 4 + wave; item < T * 4; item += nw) {
        const int t = item >> 2, h = item & 3;
        int smp, seq, s; tok_info(t, smp, seq, s);
        float out[3][2];
#pragma unroll
        for (int part = 0; part < 3; ++part) {
#pragma unroll
            for (int u = 0; u < 2; ++u) {
                const int c = part * 512 + h * 128 + lane + 64 * u;
                float y = 0.f;
#pragma unroll
                for (int jj = 0; jj < 4; ++jj) {
                    const int sp = s - 3 + jj;
                    float xv;
                    if (sp >= 0) xv = bf2f(p.proj[(size_t)(t - 3 + jj) * EVEN_LD + C_QKV + c]);
                    else if (smp) xv = p.state_conv[(((size_t)j * NS + seq) * 3 + (sp + 3)) * CONV_CH + c];
                    else xv = 0.f;
                    y += cw[jj * CONV_CH + c] * xv;
                }
                out[part][u] = siluf_(y);
            }
        }
#pragma unroll
        for (int part = 0; part < 2; ++part) {
            float ss = out[part][0] * out[part][0] + out[part][1] * out[part][1];
            for (int o = 32; o > 0; o >>= 1) ss += __shfl_xor(ss, o);
            const float r = rsqrtf(ss + EPS);
            out[part][0] *= r; out[part][1] *= r;
        }
#pragma unroll
        for (int part = 0; part < 3; ++part)
#pragma unroll
            for (int u = 0; u < 2; ++u)
                p.dnqkv[(size_t)(t - TP) * CONV_CH + part * 512 + h * 128 + lane + 64 * u] = f2bf(out[part][u]);
        if (lane == 0) {
            const float a_in = p.aux[(size_t)t * 8 + h], b_in = p.aux[(size_t)t * 8 + 4 + h];
            const float g = -__expf(p.a_log[j * 4 + h]) * softplusf_(a_in + p.dt_bias[j * 4 + h]);
            p.dngb[(size_t)(t - TP) * 8 + h] = g;
            p.dngb[(size_t)(t - TP) * 8 + 4 + h] = sigmoidf_(b_in);
        }
    }
}

__device__ __forceinline__ void ph_dn_rec(const Params& p, int j, int bid, int nblk) {
    const int tidx = tid_opaque();
    const int lane = tidx & 63;
    const int wave = (tidx >> 6) * nblk + bid, nw = nblk * 4;
    const int e = lane & 3, dg = lane >> 2;
    const int nitems = (NB + NS) * 4 * 32;
    for (int item = NB * 4 * 32 + wave; item < nitems; item += nw) {
        const int es = item & 31, h = (item >> 5) & 3, st = item >> 7;
        const int smp = st >= NB, seq = smp ? st - NB : st;
        const int t0 = smp ? TP + seq * LS : seq * SEQ, len = smp ? LS : SEQ;
        const int ec = es * 4 + e;
        float S[8];
        if (smp) {
            const float* s0 = p.state_delta + (((size_t)j * NS + seq) * 4 + h) * 128 * 128;
#pragma unroll
            for (int i = 0; i < 8; ++i) S[i] = s0[(size_t)(dg * 8 + i) * 128 + ec];
        } else {
#pragma unroll
            for (int i = 0; i < 8; ++i) S[i] = 0.f;
        }
        for (int s = 0; s < len; ++s) {
            const int t = t0 + s;
            const bf16x8 qv = *(const bf16x8*)(p.dnqkv + (size_t)(t - TP) * CONV_CH + h * 128 + dg * 8);
            const bf16x8 kv = *(const bf16x8*)(p.dnqkv + (size_t)(t - TP) * CONV_CH + 512 + h * 128 + dg * 8);
            const float v = bf2f(p.dnqkv[(size_t)(t - TP) * CONV_CH + 1024 + h * 128 + ec]);
            const float g = p.dngb[(size_t)(t - TP) * 8 + h], beta = p.dngb[(size_t)(t - TP) * 8 + 4 + h];
            float q[8], k[8];
#pragma unroll
            for (int i = 0; i < 8; ++i) { q[i] = bf2f((bf16_t)qv[i]); k[i] = bf2f((bf16_t)kv[i]); }
            float kS = 0.f, qS = 0.f, qk = 0.f;
#pragma unroll
            for (int i = 0; i < 8; ++i) { kS += k[i] * S[i]; qS += q[i] * S[i]; qk += q[i] * k[i]; }
            for (int o = 4; o < 64; o <<= 1) { kS += __shfl_xor(kS, o); qS += __shfl_xor(qS, o); qk += __shfl_xor(qk, o); }
            const float a = __expf(g);
            const float vn = beta * (v - a * kS);
            const float o = 0.08838834764831845f * (a * qS + qk * vn);
#pragma unroll
            for (int i = 0; i < 8; ++i) S[i] = a * S[i] + k[i] * vn;
            if (dg == 0) p.dno[(size_t)(t - TP) * 512 + h * 128 + ec] = o;
        }
        float* so = smp ? p.delta_s + (((size_t)j * NS + seq) * 4 + h) * 128 * 128 : p.delta_p + (((size_t)j * NB + seq) * 4 + h) * 128 * 128;
#pragma unroll
        for (int i = 0; i < 8; ++i) so[(size_t)(dg * 8 + i) * 128 + ec] = S[i];
    }
}

__device__ __forceinline__ void ph_dn_post(const Params& p, int j) {
    const int tidx = tid_opaque();
    const int lane = tidx & 63;
    const int wave = blockIdx.x * 4 + (tidx >> 6), nw = gridDim.x * 4;
    for (int item = TP * 4 + wave; item < T * 4; item += nw) {
        const int t = item >> 2, h = item & 3;
        const float o0 = p.dno[(size_t)(t - TP) * 512 + h * 128 + lane], o1 = p.dno[(size_t)(t - TP) * 512 + h * 128 + lane + 64];
        float ss = o0 * o0 + o1 * o1;
        for (int o = 32; o > 0; o >>= 1) ss += __shfl_xor(ss, o);
        const float r = rsqrtf(ss * (1.0f / 128.0f) + EPS);
        const float g0 = bf2f(p.proj[(size_t)t * EVEN_LD + C_GA + h * 128 + lane]), g1 = bf2f(p.proj[(size_t)t * EVEN_LD + C_GA + h * 128 + lane + 64]);
        p.qb[(size_t)t * D + h * 128 + lane] = f2bf(o0 * r * p.norm_a[j * 128 + lane] * siluf_(g0));
        p.qb[(size_t)t * D + h * 128 + lane + 64] = f2bf(o1 * r * p.norm_a[j * 128 + lane + 64] * siluf_(g1));
    }
}


constexpr int DR_N = 0, DR_B = 32768, DR_Q = 65536, DR_O = 81920, DR_SIZE = 98304;
constexpr int DN_R1 = 0, DN_R2 = 16384, DN_R3 = 32768, DN_R4 = 49152, DN_R5 = 58368;


__device__ __forceinline__ void ph_dn_prep(const Params& p, int j, char* smem) {
    char* const smem0 = smem;
    const float* cw = p.conv_w + (size_t)j * 4 * CONV_CH;
    for (int item = blockIdx.x; item < 16 * 64; item += gridDim.x) {
        const int st = item >> 6, c = item & 63, b = st >> 2, h = st & 3;
        const int t0 = b * SEQ + c * 64;
        char* rec = p.dnrec + (size_t)item * DR_SIZE;
        const int tidx = tid_opaque();
        char* smem = smem0; LAUNDER(smem);
        float* sG = (float*)(smem + DN_R5);
        float* sBeta = sG + 64;
        float* sRq = sBeta + 64;
        float* sRk = sRq + 64;
        float* sFw = sRk + 64;
        float* sFk = sFw + 64;
        float* sg0 = sFk + 64;
        float* sA = (float*)(smem + DN_R1);
        const int lane = tidx & 63, wid = tidx >> 6, n = lane & 15, q = lane >> 4;
        __syncthreads();
        if (tidx < 64) {
            const int t = t0 + tidx;
            const float a_in = p.aux[(size_t)t * 8 + h], b_in = p.aux[(size_t)t * 8 + 4 + h];
            sg0[tidx] = -__expf(p.a_log[j * 4 + h]) * softplusf_(a_in + p.dt_bias[j * 4 + h]);
            sBeta[tidx] = sigmoidf_(b_in);
        }
        __syncthreads();
        if (tidx < 64) {
            float G = 0.f;
            for (int k = 0; k <= tidx; ++k) G += sg0[k];
            sG[tidx] = G;
        }
        float X[64];
        {
            const int cch = tidx & 127;
            if (tidx < 128) {
                const int colq = h * 128 + cch, colk = 512 + h * 128 + cch;
                const float wq0 = cw[colq], wq1 = cw[CONV_CH + colq], wq2 = cw[2 * CONV_CH + colq], wq3 = cw[3 * CONV_CH + colq];
                const float wk0 = cw[colk], wk1 = cw[CONV_CH + colk], wk2 = cw[2 * CONV_CH + colk], wk3 = cw[3 * CONV_CH + colk];
                float q0 = 0.f, q1 = 0.f, q2 = 0.f, k0 = 0.f, k1 = 0.f, k2 = 0.f;
                if (c > 0) {
                    const bf16_t* r0 = p.proj + (size_t)(t0 - 3) * EVEN_LD + C_QKV;
                    q0 = bf2f(r0[colq]); q1 = bf2f(r0[EVEN_LD + colq]); q2 = bf2f(r0[2 * EVEN_LD + colq]);
                    k0 = bf2f(r0[colk]); k1 = bf2f(r0[EVEN_LD + colk]); k2 = bf2f(r0[2 * EVEN_LD + colk]);
                }
                const bf16_t* r = p.proj + (size_t)t0 * EVEN_LD + C_QKV + colq;
                bf16_t lq[8], lk[8], nq[8], nk[8];
#pragma unroll
                for (int u = 0; u < 8; ++u) { lq[u] = r[(size_t)u * EVEN_LD]; lk[u] = r[(size_t)u * EVEN_LD + 512]; }
#pragma unroll
                for (int bb = 0; bb < 8; ++bb) {
                    if (bb < 7) {
#pragma unroll
                        for (int u = 0; u < 8; ++u) { nq[u] = r[(size_t)(bb * 8 + 8 + u) * EVEN_LD]; nk[u] = r[(size_t)(bb * 8 + 8 + u) * EVEN_LD + 512]; }
                    }
#pragma unroll
                    for (int u = 0; u < 8; ++u) {
                        const int i = bb * 8 + u;
                        const float q3 = bf2f(lq[u]), k3 = bf2f(lk[u]);
                        const float yq = siluf_(wq0 * q0 + wq1 * q1 + wq2 * q2 + wq3 * q3);
                        const float yk = siluf_(wk0 * k0 + wk1 * k1 + wk2 * k2 + wk3 * k3);
                        q0 = q1; q1 = q2; q2 = q3; k0 = k1; k1 = k2; k2 = k3;
                        X[i] = yk;
                        *(bf16_t*)(smem + DN_R1 + i * 256 + ((((cch >> 3) ^ (i & 15)) << 4) | ((cch & 7) << 1))) = f2bf(yq);
                        *(bf16_t*)(smem + DN_R2 + i * 256 + ((((cch >> 3) ^ (i & 15)) << 4) | ((cch & 7) << 1))) = f2bf(yk);
                        *(bf16_t*)(smem + DN_R3 + cch * 128 + ((((i >> 3) ^ (cch & 7)) << 4) | ((i & 7) << 1))) = f2bf(yk);
                    }
#pragma unroll
                    for (int u = 0; u < 8; ++u) { lq[u] = nq[u]; lk[u] = nk[u]; asm volatile("" : "+v"(X[bb * 8 + u])); }
                    MEMFENCE();
                }
            } else {
                const int colv = 1024 + h * 128 + cch;
                const float w0 = cw[colv], w1 = cw[CONV_CH + colv], w2 = cw[2 * CONV_CH + colv], w3 = cw[3 * CONV_CH + colv];
                float v0 = 0.f, v1 = 0.f, v2 = 0.f;
                if (c > 0) {
                    const bf16_t* r0 = p.proj + (size_t)(t0 - 3) * EVEN_LD + C_QKV;
                    v0 = bf2f(r0[colv]); v1 = bf2f(r0[EVEN_LD + colv]); v2 = bf2f(r0[2 * EVEN_LD + colv]);
                }
                const bf16_t* r = p.proj + (size_t)t0 * EVEN_LD + C_QKV + colv;
                bf16_t lv[8], nv[8];
#pragma unroll
                for (int u = 0; u < 8; ++u) lv[u] = r[(size_t)u * EVEN_LD];
#pragma unroll
                for (int bb = 0; bb < 8; ++bb) {
                    if (bb < 7) {
#pragma unroll
                        for (int u = 0; u < 8; ++u) nv[u] = r[(size_t)(bb * 8 + 8 + u) * EVEN_LD];
                    }
#pragma unroll
                    for (int u = 0; u < 8; ++u) {
                        const float v3 = bf2f(lv[u]);
                        X[bb * 8 + u] = siluf_(w0 * v0 + w1 * v1 + w2 * v2 + w3 * v3);
                        v0 = v1; v1 = v2; v2 = v3;
                    }
#pragma unroll
                    for (int u = 0; u < 8; ++u) { lv[u] = nv[u]; asm volatile("" : "+v"(X[bb * 8 + u])); }
                    MEMFENCE();
                }
            }
        }
        __syncthreads();
        {
            const int i = tidx >> 2, qt = tidx & 3;
            float sq = 0.f, sk = 0.f;
#pragma unroll
            for (int u = 0; u < 4; ++u) {
                const int chn = (qt * 4 + u) ^ (i & 15);
                const bf16x8 a = *(const bf16x8*)(smem + DN_R1 + i * 256 + (chn << 4));
                const bf16x8 bb = *(const bf16x8*)(smem + DN_R2 + i * 256 + (chn << 4));
#pragma unroll
                for (int e = 0; e < 8; ++e) { const float x = bf2f((bf16_t)a[e]), y = bf2f((bf16_t)bb[e]); sq += x * x; sk += y * y; }
            }
            sq += __shfl_xor(sq, 1); sq += __shfl_xor(sq, 2);
            sk += __shfl_xor(sk, 1); sk += __shfl_xor(sk, 2);
            if (qt == 0) {
                const float rq = rsqrtf(sq + EPS) * 0.08838834764831845f, rk = rsqrtf(sk + EPS);
                const float G = sG[i], Gl = sG[63];
                sRq[i] = rq; sRk[i] = rk;
                sFw[i] = rk * sBeta[i] * __expf(G);
                sFk[i] = rk * __expf(Gl - G);
            }
        }
        __syncthreads();
        {
            const int dd = tidx & 127, cg = tidx >> 7;
#pragma unroll
            for (int u = 0; u < 4; ++u) {
                const int chn = cg * 4 + u;
                char* ptr = smem + DN_R3 + dd * 128 + ((chn ^ (dd & 7)) << 4);
                const uint4 v = *(const uint4*)ptr;
                const float* f = sFk + chn * 8;
                uint4 o;
                o.x = pack_bf16(__uint_as_float(v.x << 16) * f[0], __uint_as_float(v.x & 0xffff0000u) * f[1]);
                o.y = pack_bf16(__uint_as_float(v.y << 16) * f[2], __uint_as_float(v.y & 0xffff0000u) * f[3]);
                o.z = pack_bf16(__uint_as_float(v.z << 16) * f[4], __uint_as_float(v.z & 0xffff0000u) * f[5]);
                o.w = pack_bf16(__uint_as_float(v.w << 16) * f[6], __uint_as_float(v.w & 0xffff0000u) * f[7]);
                *(uint4*)ptr = o;
            }
        }
        const int irow = wid * 16 + n;
        {
            const float fq = sRq[irow] * __expf(sG[irow]);
#pragma unroll
            for (int kk = 0; kk < 4; ++kk) {
                uint4 o;
                {
                    const int chn = ((2 * kk) * 2 + (q >> 1)) ^ (irow & 15);
                    const float4 f = unpack4(*(const uint2*)(smem + DN_R1 + irow * 256 + (chn << 4) + ((q & 1) << 3)));
                    o.x = pack_bf16(f.x * fq, f.y * fq); o.y = pack_bf16(f.z * fq, f.w * fq);
                }
                {
                    const int chn = ((2 * kk + 1) * 2 + (q >> 1)) ^ (irow & 15);
                    const float4 f = unpack4(*(const uint2*)(smem + DN_R1 + irow * 256 + (chn << 4) + ((q & 1) << 3)));
                    o.z = pack_bf16(f.x * fq, f.y * fq); o.w = pack_bf16(f.z * fq, f.w * fq);
                }
                *(uint4*)(rec + DR_Q + (((wid * 4 + kk) * 64) + lane) * 16) = o;
            }
        }
        {
            bf16x8 kfi[4], qfi[4];
#pragma unroll
            for (int kk = 0; kk < 4; ++kk) {
                const int chn = (kk * 4 + q) ^ (irow & 15);
                kfi[kk] = *(const bf16x8*)(smem + DN_R2 + irow * 256 + (chn << 4));
                qfi[kk] = *(const bf16x8*)(smem + DN_R1 + irow * 256 + (chn << 4));
            }
            const float Gi = sG[irow], bi = sBeta[irow], rki = sRk[irow], rqi = sRq[irow];
            __syncthreads();
#pragma unroll
            for (int jt = 0; jt < 4; ++jt) {
                f32x4 aA = {0.f, 0.f, 0.f, 0.f}, aQ = {0.f, 0.f, 0.f, 0.f};
                if (jt <= wid) {
                    const int jrow = jt * 16 + n;
#pragma unroll
                    for (int kk = 0; kk < 4; ++kk) {
                        const int chn = (kk * 4 + q) ^ (jrow & 15);
                        const bf16x8 kfj = *(const bf16x8*)(smem + DN_R2 + jrow * 256 + (chn << 4));
                        aA = __builtin_amdgcn_mfma_f32_16x16x32_bf16(kfj, kfi[kk], aA, 0, 0, 0);
                        aQ = __builtin_amdgcn_mfma_f32_16x16x32_bf16(kfj, qfi[kk], aQ, 0, 0, 0);
                    }
                }
                float qkv[4], av[4];
#pragma unroll
                for (int rr = 0; rr < 4; ++rr) {
                    const int jj = jt * 16 + 4 * q + rr;
                    const float dec = (jj <= irow) ? __expf(Gi - sG[jj]) : 0.f;
                    const float rkj = sRk[jj];
                    qkv[rr] = rqi * rkj * aQ[rr] * dec;
                    av[rr] = (jj < irow) ? bi * rki * rkj * aA[rr] * dec : 0.f;
                }
                uint2 o; o.x = pack_bf16(qkv[0], qkv[1]); o.y = pack_bf16(qkv[2], qkv[3]);
                *(uint2*)(smem + DN_R4 + irow * 144 + (jt * 16 + 4 * q) * 2) = o;
                *(float4*)(sA + irow * 64 + jt * 16 + 4 * q) = make_float4(av[0], av[1], av[2], av[3]);
            }
        }
        __syncthreads();
        {
            const float* fac = (tidx < 128) ? sFw : sBeta;
            const float* sAl = sA;
            asm volatile("" : "+v"(sAl));
#pragma unroll
            for (int i4 = 0; i4 < 16; ++i4) {
                const float4 f = *(const float4*)(fac + i4 * 4);
                X[i4 * 4] *= f.x; X[i4 * 4 + 1] *= f.y; X[i4 * 4 + 2] *= f.z; X[i4 * 4 + 3] *= f.w;
            }
#pragma unroll
            for (int ib = 0; ib < 8; ++ib) {
                float a[8];
#pragma unroll
                for (int r = 0; r < 8; ++r) a[r] = X[8 * ib + r];
#pragma unroll
                for (int jb = 0; jb < 2 * ib; ++jb) {
#pragma unroll
                    for (int r = 0; r < 8; ++r) {
                        const float4 av = *(const float4*)(sAl + (8 * ib + r) * 64 + 4 * jb);
                        a[r] -= av.x * X[4 * jb]; a[r] -= av.y * X[4 * jb + 1]; a[r] -= av.z * X[4 * jb + 2]; a[r] -= av.w * X[4 * jb + 3];
                    }
                }
#pragma unroll
                for (int r = 1; r < 8; ++r) {
                    const float4 d0 = *(const float4*)(sAl + (8 * ib + r) * 64 + 8 * ib), d1 = *(const float4*)(sAl + (8 * ib + r) * 64 + 8 * ib + 4);
                    const float dv[8] = {d0.x, d0.y, d0.z, d0.w, d1.x, d1.y, d1.z, d1.w};
#pragma unroll
                    for (int c = 0; c < 8; ++c) if (c < r) a[r] -= dv[c] * a[c];
                }
#pragma unroll
                for (int r = 0; r < 8; ++r) X[8 * ib + r] = a[r];
                asm volatile("" : "+v"(X[8 * ib]), "+v"(X[8 * ib + 1]), "+v"(X[8 * ib + 2]), "+v"(X[8 * ib + 3]), "+v"(X[8 * ib + 4]), "+v"(X[8 * ib + 5]), "+v"(X[8 * ib + 6]), "+v"(X[8 * ib + 7]) :: "memory");
            }
        }
        __syncthreads();
        {
            const int cch = tidx & 127;
            char* base = smem + ((tidx < 128) ? DN_R2 : DN_R1) + cch * 128;
#pragma unroll
            for (int chn = 0; chn < 8; ++chn) {
                uint4 o;
                o.x = pack_bf16(X[chn * 8 + 0], X[chn * 8 + 1]); o.y = pack_bf16(X[chn * 8 + 2], X[chn * 8 + 3]);
                o.z = pack_bf16(X[chn * 8 + 4], X[chn * 8 + 5]); o.w = pack_bf16(X[chn * 8 + 6], X[chn * 8 + 7]);
                *(uint4*)(base + ((chn ^ (cch & 7)) << 4)) = o;
            }
        }
        if (tidx == 0) p.dngl[item] = __expf(sG[63]);
        __syncthreads();
#define TFRAG(REG, r0, kj) (*(const bf16x8*)(smem + (REG) + ((r0) + n) * 128 + (((((kj) * 4 + q)) ^ (((r0) + n) & 7)) << 4)))
        {
            f32x4 acc[2][8];
#pragma unroll
            for (int a = 0; a < 2; ++a)
#pragma unroll
                for (int nt = 0; nt < 8; ++nt) acc[a][nt] = (f32x4){0.f, 0.f, 0.f, 0.f};
#pragma unroll
            for (int kj = 0; kj < 2; ++kj) {
                const bf16x8 kd0 = TFRAG(DN_R3, (2 * wid) * 16, kj), kd1 = TFRAG(DN_R3, (2 * wid + 1) * 16, kj);
#pragma unroll
                for (int nt = 0; nt < 8; ++nt) {
                    const bf16x8 wf = TFRAG(DN_R2, nt * 16, kj);
                    acc[0][nt] = __builtin_amdgcn_mfma_f32_16x16x32_bf16(wf, kd0, acc[0][nt], 0, 0, 0);
                    acc[1][nt] = __builtin_amdgcn_mfma_f32_16x16x32_bf16(wf, kd1, acc[1][nt], 0, 0, 0);
                }
            }
#pragma unroll
            for (int a = 0; a < 2; ++a)
#pragma unroll
                for (int kk = 0; kk < 4; ++kk) {
                    const f32x4 lo = acc[a][2 * kk], hi = acc[a][2 * kk + 1];
                    uint4 o;
                    o.x = pack_bf16(-lo[0], -lo[1]); o.y = pack_bf16(-lo[2], -lo[3]); o.z = pack_bf16(-hi[0], -hi[1]); o.w = pack_bf16(-hi[2], -hi[3]);
                    *(uint4*)(rec + DR_N + ((((2 * wid + a) * 4 + kk) * 64) + lane) * 16) = o;
                }
        }
        {
            f32x4 acc[8][2];
#pragma unroll
            for (int mt = 0; mt < 8; ++mt) { acc[mt][0] = (f32x4){0.f, 0.f, 0.f, 0.f}; acc[mt][1] = (f32x4){0.f, 0.f, 0.f, 0.f}; }
#pragma unroll
            for (int kj = 0; kj < 2; ++kj) {
                const bf16x8 u0 = TFRAG(DN_R1, (2 * wid) * 16, kj), u1 = TFRAG(DN_R1, (2 * wid + 1) * 16, kj);
#pragma unroll
                for (int mt = 0; mt < 8; ++mt) {
                    const bf16x8 kd = TFRAG(DN_R3, mt * 16, kj);
                    acc[mt][0] = __builtin_amdgcn_mfma_f32_16x16x32_bf16(kd, u0, acc[mt][0], 0, 0, 0);
                    acc[mt][1] = __builtin_amdgcn_mfma_f32_16x16x32_bf16(kd, u1, acc[mt][1], 0, 0, 0);
                }
            }
#pragma unroll
            for (int mt = 0; mt < 8; ++mt)
#pragma unroll
                for (int a = 0; a < 2; ++a) {
                    uint2 o; o.x = pack_bf16(acc[mt][a][0], acc[mt][a][1]); o.y = pack_bf16(acc[mt][a][2], acc[mt][a][3]);
                    *(uint2*)(rec + DR_B + ((((2 * wid + a) * 8 + mt) * 64) + lane) * 8) = o;
                }
        }
        {
            bf16x8 qkf[2];
#pragma unroll
            for (int kj = 0; kj < 2; ++kj) qkf[kj] = *(const bf16x8*)(smem + DN_R4 + irow * 144 + (kj * 32 + 8 * q) * 2);
            f32x4 pq[8];
#pragma unroll
            for (int dt = 0; dt < 8; ++dt) {
                pq[dt] = (f32x4){0.f, 0.f, 0.f, 0.f};
#pragma unroll
                for (int kj = 0; kj < 2; ++kj) pq[dt] = __builtin_amdgcn_mfma_f32_16x16x32_bf16(TFRAG(DN_R2, dt * 16, kj), qkf[kj], pq[dt], 0, 0, 0);
            }
#pragma unroll
            for (int kk = 0; kk < 4; ++kk) {
                uint4* qp = (uint4*)(rec + DR_Q + (((wid * 4 + kk) * 64) + lane) * 16);
                const uint4 qv = *qp;
                const float4 lo = unpack4(make_uint2(qv.x, qv.y)), hi = unpack4(make_uint2(qv.z, qv.w));
                uint4 o;
                o.x = pack_bf16(lo.x - pq[2 * kk][0], lo.y - pq[2 * kk][1]);
                o.y = pack_bf16(lo.z - pq[2 * kk][2], lo.w - pq[2 * kk][3]);
                o.z = pack_bf16(hi.x - pq[2 * kk + 1][0], hi.y - pq[2 * kk + 1][1]);
                o.w = pack_bf16(hi.z - pq[2 * kk + 1][2], hi.w - pq[2 * kk + 1][3]);
                *qp = o;
            }
#pragma unroll
            for (int et = 0; et < 8; ++et) {
                f32x4 po = {0.f, 0.f, 0.f, 0.f};
#pragma unroll
                for (int kj = 0; kj < 2; ++kj) po = __builtin_amdgcn_mfma_f32_16x16x32_bf16(TFRAG(DN_R1, et * 16, kj), qkf[kj], po, 0, 0, 0);
                uint2 o; o.x = pack_bf16(po[0], po[1]); o.y = pack_bf16(po[2], po[3]);
                *(uint2*)(rec + DR_O + (((wid * 8 + et) * 64) + lane) * 8) = o;
            }
        }
#undef TFRAG
    }
}

__device__ __forceinline__ void ph_dn_scan(const Params& p, int j, char* smem, int item0) {
    const int tidx = tid_opaque();
    const int lane = tidx & 63, wid = tidx >> 6, n = lane & 15, q = lane >> 4;
    const unsigned lbase = __builtin_amdgcn_readfirstlane(lds_base_addr() + wid * 1024);
    for (int item = item0; item < 32; item += gridDim.x) {
        const int st = item >> 1, et = (item & 1) * 4 + wid;
        const int b = st >> 2, h = st & 3;
        f32x4 acc[8];
#pragma unroll
        for (int mt = 0; mt < 8; ++mt) acc[mt] = (f32x4){0.f, 0.f, 0.f, 0.f};
        const char* rec = p.dnrec + (size_t)st * 64 * DR_SIZE;
        const char* nsrc = rec + DR_N + tidx * 16;
        char* sp = p.dnsp + (size_t)st * 64 * 32768 + (et >> 1) * 8192 + (et & 1) * 1024 + lane * 16;
        const char* brec = rec + DR_B + (size_t)et * 8 * 512 + lane * 8;
        __syncthreads();
#pragma unroll
        for (int k = 0; k < 8; ++k) glds16_asm(nsrc + k * 4096, lbase + k * 4096);
        uint2 bcur[8];
#pragma unroll
        for (int mt = 0; mt < 8; ++mt) bcur[mt] = *(const uint2*)(brec + mt * 512);
        float gl = p.dngl[st * 64];
        asm volatile("s_waitcnt vmcnt(0)" ::: "memory");
        __syncthreads();
#pragma unroll 1
        for (int c = 0; c < 64; ++c) {
            const char* slot = smem + (c & 1) * 32768;
            bf16x8 sB[4];
#pragma unroll
            for (int kk = 0; kk < 4; ++kk) {
                const f32x4 lo = acc[2 * kk], hi = acc[2 * kk + 1];
                uint4 cu;
                cu.x = pack_bf16(lo[0], lo[1]); cu.y = pack_bf16(lo[2], lo[3]); cu.z = pack_bf16(hi[0], hi[1]); cu.w = pack_bf16(hi[2], hi[3]);
                sB[kk] = __builtin_bit_cast(bf16x8, cu);
                *(uint4*)(sp + (size_t)c * 32768 + kk * 2048) = cu;
            }
#pragma unroll
            for (int mt = 0; mt < 8; ++mt) {
                const float4 b0 = unpack4(bcur[mt]);
                acc[mt][0] = gl * acc[mt][0] + b0.x; acc[mt][1] = gl * acc[mt][1] + b0.y; acc[mt][2] = gl * acc[mt][2] + b0.z; acc[mt][3] = gl * acc[mt][3] + b0.w;
            }
            {
                const int cn = (c + 1 < 64) ? c + 1 : c;
                const char* nb = brec + (size_t)cn * DR_SIZE;
#pragma unroll
                for (int mt = 0; mt < 8; ++mt) bcur[mt] = *(const uint2*)(nb + mt * 512);
                gl = p.dngl[st * 64 + cn];
                if (c + 1 < 64) {
                    const unsigned dst = lbase + ((c + 1) & 1) * 32768;
#pragma unroll
                    for (int k = 0; k < 8; ++k) glds16_asm(nsrc + (size_t)(c + 1) * DR_SIZE + k * 4096, dst + k * 4096);
                }
            }
#pragma unroll
            for (int mt = 0; mt < 8; ++mt) {
                f32x4 c0 = acc[mt];
#pragma unroll
                for (int kk = 0; kk < 4; ++kk) {
                    const bf16x8 nf = *(const bf16x8*)(slot + ((mt * 4 + kk) * 64 + lane) * 16);
                    c0 = __builtin_amdgcn_mfma_f32_16x16x32_bf16(nf, sB[kk], c0, 0, 0, 0);
                }
                acc[mt] = c0;
            }
            asm volatile("s_waitcnt vmcnt(0) lgkmcnt(0)" ::: "memory");
            __builtin_amdgcn_s_barrier();
            MEMFENCE();
        }
        float* so = p.delta_p + (((size_t)j * NB + b) * 4 + h) * 128 * 128;
#pragma unroll
        for (int mt = 0; mt < 8; ++mt)
#pragma unroll
            for (int rr = 0; rr < 4; ++rr) so[(size_t)(mt * 16 + 4 * q + rr) * 128 + et * 16 + n] = acc[mt][rr];
    }
}

__device__ __forceinline__ void ph_dn_out(const Params& p, int j) {
    const int tidx = tid_opaque();
    const int lane = tidx & 63, wid = tidx >> 6, n = lane & 15, q = lane >> 4;
    for (int item = blockIdx.x; item < 16 * 64; item += gridDim.x) {
        const int st = item >> 6, c = item & 63, b = st >> 2, h = st & 3;
        const char* rec = p.dnrec + (size_t)item * DR_SIZE;
        const char* sp = p.dnsp + (size_t)item * 32768 + lane * 16;
        bf16x8 qf[4];
#pragma unroll
        for (int kk = 0; kk < 4; ++kk) qf[kk] = *(const bf16x8*)(rec + DR_Q + (((wid * 4 + kk) * 64) + lane) * 16);
        f32x4 o[8];
        float ss = 0.f;
#pragma unroll
        for (int et = 0; et < 8; ++et) {
            const float4 oi = unpack4(*(const uint2*)(rec + DR_O + (((wid * 8 + et) * 64) + lane) * 8));
            f32x4 a = {oi.x, oi.y, oi.z, oi.w};
#pragma unroll
            for (int kk = 0; kk < 4; ++kk) {
                const bf16x8 sf = *(const bf16x8*)(sp + (et >> 1) * 8192 + (kk * 2 + (et & 1)) * 1024);
                a = __builtin_amdgcn_mfma_f32_16x16x32_bf16(sf, qf[kk], a, 0, 0, 0);
            }
            o[et] = a;
            ss += a[0] * a[0] + a[1] * a[1] + a[2] * a[2] + a[3] * a[3];
        }
        ss += __shfl_xor(ss, 16); ss += __shfl_xor(ss, 32);
        const float r = rsqrtf(ss * (1.0f / 128.0f) + EPS);
        const int t = b * SEQ + c * 64 + wid * 16 + n;
#pragma unroll
        for (int et = 0; et < 8; ++et) {
            const int e0 = et * 16 + 4 * q;
            const float4 g = unpack4(*(const uint2*)(p.proj + (size_t)t * EVEN_LD + C_GA + h * 128 + e0));
            const float4 na = *(const float4*)(p.norm_a + j * 128 + e0);
            uint2 w;
            w.x = pack_bf16(o[et][0] * r * na.x * siluf_(g.x), o[et][1] * r * na.y * siluf_(g.y));
            w.y = pack_bf16(o[et][2] * r * na.z * siluf_(g.z), o[et][3] * r * na.w * siluf_(g.w));
            *(uint2*)(p.qb + (size_t)t * D + h * 128 + e0) = w;
        }
    }
}

__device__ __forceinline__ void rope_chunk(float (&x)[8], int chunk_in_head, const float* rp, int lane) {
    float o[8];
#pragma unroll
    for (int i = 0; i < 8; ++i) o[i] = __shfl_xor(x[i], 1);
    if (chunk_in_head < 2) {
        const float4 c0 = *(const float4*)rp, c1 = *(const float4*)(rp + 4), s0 = *(const float4*)(rp + 8), s1 = *(const float4*)(rp + 12);
        const float c[8] = {c0.x, c0.y, c0.z, c0.w, c1.x, c1.y, c1.z, c1.w}, sn[8] = {s0.x, s0.y, s0.z, s0.w, s1.x, s1.y, s1.z, s1.w};
        const float sg = chunk_in_head == 0 ? -1.f : 1.f;
#pragma unroll
        for (int i = 0; i < 8; ++i) x[i] = x[i] * c[i] + sg * o[i] * sn[i];
    }
}

__device__ __forceinline__ void ph_swa_pre(const Params& p, int j) {
    const int tidx = tid_opaque();
    const int lane = tidx & 63;
    const int wave = blockIdx.x * 4 + (tidx >> 6), nw = gridDim.x * 4;
    for (int t = wave; t < T; t += nw) {
        int smp, seq, s; tok_info(t, smp, seq, s);
        const int pi = smp ? SEQ + s : s;
        const float* rp = p.rope + (size_t)pi * 16;
        const bf16_t* row = p.proj + (size_t)t * EVEN_LD;
        {
            float x[8]; unpack8(*(const uint4*)(row + C_QB + lane * 8), x);
            rope_chunk(x, lane & 7, rp, lane);
            uint4 o; o.x = pack_bf16(x[0], x[1]); o.y = pack_bf16(x[2], x[3]); o.z = pack_bf16(x[4], x[5]); o.w = pack_bf16(x[6], x[7]);
            *(uint4*)(p.qr + (size_t)t * 512 + lane * 8) = o;
        }
        {
            const int l32 = lane & 31, isv = (lane >> 4) & 1, l16 = lane & 15;
            float x[8]; unpack8(*(const uint4*)(row + (isv ? C_VB : C_KB) + l16 * 8), x);
            float xr[8];
#pragma unroll
            for (int i = 0; i < 8; ++i) xr[i] = x[i];
            rope_chunk(xr, l16 & 7, rp, lane);
            if (lane < 32) {
                const int kh = l16 >> 3, d0 = (l16 & 7) * 8;
                if (!isv) {
                    uint4 o; o.x = pack_bf16(xr[0], xr[1]); o.y = pack_bf16(xr[2], xr[3]); o.z = pack_bf16(xr[4], xr[5]); o.w = pack_bf16(xr[6], xr[7]);
                    if (!smp) *(uint4*)(p.krb + (size_t)t * 128 + l16 * 8) = o;
                    else *(uint4*)(p.kcat + (((size_t)seq * 2 + kh) * 144 + 128 + s) * 64 + d0) = o;
                }
                float src[8];
#pragma unroll
                for (int i = 0; i < 8; ++i) src[i] = isv ? x[i] : xr[i];
                float* dst = nullptr;
                if (!smp) { if (s >= SEQ - 128) dst = (isv ? p.wv_p : p.wk_p) + ((((size_t)j * NB + seq) * 128 + (s - (SEQ - 128))) * 2 + kh) * 64 + d0; }
                else dst = (isv ? p.wv_s : p.wk_s) + ((((size_t)j * NS + seq) * 128 + (120 + s)) * 2 + kh) * 64 + d0;
                if (dst) { *(float4*)dst = make_float4(src[0], src[1], src[2], src[3]); *(float4*)(dst + 4) = make_float4(src[4], src[5], src[6], src[7]); }
                (void)l32;
            }
        }
    }
    const size_t gtid = (size_t)blockIdx.x * 256 + tidx, gsz = (size_t)gridDim.x * 256;
    for (size_t i = gtid; i < (size_t)NS * 120 * 128; i += gsz) {
        const int nn = (int)(i / (120 * 128)); const int rem = (int)(i % (120 * 128));
        const size_t src = ((size_t)j * NS + nn) * 128 * 128 + 8 * 128 + rem;
        const size_t dst = ((size_t)j * NS + nn) * 128 * 128 + rem;
        p.wk_s[dst] = p.cache_k[src];
        p.wv_s[dst] = p.cache_v[src];
    }
}

__device__ __forceinline__ void ph_swa_attn(const Params& p, int j) {
    const int tidx = tid_opaque();
    const int lane = tidx & 63;
    const int wave = blockIdx.x * 4 + (tidx >> 6), nw = gridDim.x * 4;
    for (int item = wave; item < T * 8; item += nw) {
        const int t = item >> 3, hq = item & 7, kh = hq >> 2;
        int smp, seq, s; tok_info(t, smp, seq, s);
        const int t0 = t - s;
        float q[64];
        {
            const bf16_t* qp = p.qr + (size_t)t * 512 + hq * 64;
#pragma unroll
            for (int c = 0; c < 8; ++c) {
                const bf16x8 v = *(const bf16x8*)(qp + c * 8);
#pragma unroll
                for (int i = 0; i < 8; ++i) q[c * 8 + i] = bf2f((bf16_t)v[i]);
            }
        }
        const float sink = p.sinks[j * 8 + hq];
        float sc[3]; bool valid[3];
        float mx = -1e30f;
#pragma unroll
        for (int rr = 0; rr < 3; ++rr) {
            const int r = lane + 64 * rr;
            const int kp = s - 128 + r;
            bool ok = (r <= 128);
            const float* kptr = nullptr;
            if (ok) {
                if (kp >= 0) kptr = p.kr + (size_t)(t0 + kp) * 128 + kh * 64;
                else if (smp) kptr = p.cache_k + ((((size_t)j * NS + seq) * 128 + (128 + kp)) * 2 + kh) * 64;
                else ok = false;
            }
            float d = 0.f;
            if (ok) {
#pragma unroll
                for (int c = 0; c < 16; ++c) {
                    const float4 kv = *(const float4*)(kptr + c * 4);
                    d += q[c * 4] * kv.x + q[c * 4 + 1] * kv.y + q[c * 4 + 2] * kv.z + q[c * 4 + 3] * kv.w;
                }
                d *= 0.125f;
                mx = fmaxf(mx, d);
            }
            sc[rr] = d; valid[rr] = ok;
        }
        for (int o = 32; o > 0; o >>= 1) mx = fmaxf(mx, __shfl_xor(mx, o));
        const float m = fmaxf(mx, sink);
        float pr[3]; float sum = 0.f;
#pragma unroll
        for (int rr = 0; rr < 3; ++rr) { pr[rr] = valid[rr] ? __expf(sc[rr] - m) : 0.f; sum += pr[rr]; }
        for (int o = 32; o > 0; o >>= 1) sum += __shfl_xor(sum, o);
        const float denom = sum + __expf(sink - m);
        float acc = 0.f;
        for (int r = 0; r <= 128; ++r) {
            const float pj = __shfl(r < 64 ? pr[0] : (r < 128 ? pr[1] : pr[2]), r & 63);
            const int kp = s - 128 + r;
            float vv = 0.f;
            if (kp >= 0) vv = bf2f(p.proj[(size_t)(t0 + kp) * EVEN_LD + C_VB + kh * 64 + lane]);
            else if (smp) vv = p.cache_v[((((size_t)j * NS + seq) * 128 + (128 + kp)) * 2 + kh) * 64 + lane];
            acc += pj * vv;
        }
        const float o = acc / denom;
        const float g = bf2f(p.proj[(size_t)t * EVEN_LD + C_GB + hq * 64 + lane]);
        p.qb[(size_t)t * D + 512 + hq * 64 + lane] = f2bf(o * siluf_(g));
    }
}


__device__ __forceinline__ void ph_swa_prep2(const Params& p, int j, char* smem) {
    const int tidx = tid_opaque();
    bf16_t* tile = (bf16_t*)smem;
    for (int item = blockIdx.x; item < NB * (SEQ / 64); item += gridDim.x) {
        const int b = item / (SEQ / 64), pt = item % (SEQ / 64);
        const int t0 = b * SEQ + pt * 64;
        __syncthreads();
#pragma unroll
        for (int u = 0; u < 4; ++u) {
            const int cidx = tidx + 256 * u, tok = cidx >> 4, ch = cidx & 15;
            *(uint4*)(tile + tok * 128 + ch * 8) = *(const uint4*)(p.proj + (size_t)(t0 + tok) * EVEN_LD + C_VB + ch * 8);
        }
        __syncthreads();
#pragma unroll
        for (int u = 0; u < 8; ++u) {
            const int pidx = tidx + 256 * u;
            const int ln = pidx & 63, dt = (pidx >> 6) & 3, kvh = (pidx >> 8) & 1, Tl = pidx >> 9;
            const int n = ln & 15, q = ln >> 4;
            const int col = kvh * 64 + dt * 16 + n, tk = Tl * 16 + 4 * q;
            uint2 w;
            w.x = (unsigned)tile[tk * 128 + col] | ((unsigned)tile[(tk + 1) * 128 + col] << 16);
            w.y = (unsigned)tile[(tk + 2) * 128 + col] | ((unsigned)tile[(tk + 3) * 128 + col] << 16);
            *(uint2*)(p.vT + ((((size_t)(b * 2 + kvh) * 256 + pt * 4 + Tl) * 4 + dt) * 64 + ln) * 4) = w;
        }
    }
    for (int item = blockIdx.x; item < NS; item += gridDim.x) {
        const int nn = item;
        __syncthreads();
        for (int e = tidx; e < 128 * 32; e += 256) {
            const int c = e >> 5, k4 = e & 31;
            const size_t src = (((size_t)j * NS + nn) * 128 + c) * 128 + k4 * 4;
            const float4 kv = *(const float4*)(p.cache_k + src), vv = *(const float4*)(p.cache_v + src);
            const int kvh = k4 >> 4, d0 = (k4 & 15) * 4;
            ushort4 ko; ko.x = f2bf(kv.x); ko.y = f2bf(kv.y); ko.z = f2bf(kv.z); ko.w = f2bf(kv.w);
            *(ushort4*)(p.kcat + (((size_t)nn * 2 + kvh) * 144 + c) * 64 + d0) = ko;
            bf16_t* tp_ = tile + c * 130 + k4 * 4;
            tp_[0] = f2bf(vv.x); tp_[1] = f2bf(vv.y); tp_[2] = f2bf(vv.z); tp_[3] = f2bf(vv.w);
        }
        for (int e = tidx; e < 8 * 128; e += 256) {
            const int c = e >> 7, kd = e & 127;
            tile[(128 + c) * 130 + kd] = p.proj[(size_t)(TP + nn * LS + c) * EVEN_LD + C_VB + kd];
            p.kcat[(((size_t)nn * 2 + (kd >> 6)) * 144 + 136 + c) * 64 + (kd & 63)] = 0;
        }
        __syncthreads();
        for (int pidx = tidx; pidx < 10 * 2 * 4 * 64; pidx += 256) {
            const int ln = pidx & 63, dt = (pidx >> 6) & 3, kvh = (pidx >> 8) & 1, Tl = pidx >> 9;
            const int n = ln & 15, q = ln >> 4;
            const int col = kvh * 64 + dt * 16 + n, tk = Tl * 16 + 4 * q;
            unsigned v4[4];
#pragma unroll
            for (int e = 0; e < 4; ++e) v4[e] = (tk + e < 136) ? (unsigned)tile[(tk + e) * 130 + col] : 0u;
            uint2 w; w.x = v4[0] | (v4[1] << 16); w.y = v4[2] | (v4[3] << 16);
            *(uint2*)(p.vTcat + ((((size_t)(nn * 2 + kvh) * 10 + Tl) * 4 + dt) * 64 + ln) * 4) = w;
        }
    }
}

__device__ __forceinline__ void ph_swa_attn2(const Params& p, int j, int bid, int nblk) {
    const int tidx = tid_opaque();
    const int lane = tidx & 63, n = lane & 15, q = lane >> 4;
    const int wave = bid * 4 + (tidx >> 6), nw = nblk * 4;
    const int nprompt = NB * (SEQ / 16) * 8;
    for (int item = wave; item < nprompt + NS * 8; item += nw) {
        int hq, qc0, tq0, kstride, kmax, vstride, vmax, nvalid;
        const bf16_t* Kb; const bf16_t* VTb;
        if (item < nprompt) {
            const int b = item / ((SEQ / 16) * 8), rem = item % ((SEQ / 16) * 8);
            hq = rem & 7; qc0 = (rem >> 3) * 16; tq0 = b * SEQ + qc0;
            Kb = p.krb + (size_t)b * SEQ * 128 + (hq >> 2) * 64; kstride = 128; kmax = SEQ - 1;
            VTb = p.vT + (size_t)(b * 2 + (hq >> 2)) * 256 * 4 * 64 * 4; vstride = 0; vmax = 255;
            nvalid = 16;
        } else {
            const int it2 = item - nprompt, nn = it2 >> 3;
            hq = it2 & 7; qc0 = 128; tq0 = TP + nn * LS;
            Kb = p.kcat + ((size_t)nn * 2 + (hq >> 2)) * 144 * 64; kstride = 64; kmax = 143;
            VTb = p.vTcat + (size_t)(nn * 2 + (hq >> 2)) * 10 * 4 * 64 * 4; vstride = 0; vmax = 9;
            nvalid = 8;
        }
        const int key0 = qc0 - 128;
        const int tq = tq0 + (n < nvalid ? n : nvalid - 1);
        bf16x8 qf[2];
        qf[0] = *(const bf16x8*)(p.qr + (size_t)tq * 512 + hq * 64 + 8 * q);
        qf[1] = *(const bf16x8*)(p.qr + (size_t)tq * 512 + hq * 64 + 32 + 8 * q);
        bf16x8 kf[20];
#pragma unroll
        for (int kt = 0; kt < 10; ++kt) {
            int kc = key0 + 16 * kt + n; kc = kc < 0 ? 0 : (kc > kmax ? kmax : kc);
            const bf16_t* kp = Kb + (size_t)kc * kstride + 8 * q;
            kf[2 * kt] = *(const bf16x8*)(kp); kf[2 * kt + 1] = *(const bf16x8*)(kp + 32);
        }
        uint2 vv[40];
#pragma unroll
        for (int k2 = 0; k2 < 5; ++k2) {
            int tA = (key0 >> 4) + 2 * k2, tB = tA + 1;
            tA = tA < 0 ? 0 : (tA > vmax ? vmax : tA); tB = tB < 0 ? 0 : (tB > vmax ? vmax : tB);
#pragma unroll
            for (int dt = 0; dt < 4; ++dt) {
                vv[(dt * 5 + k2) * 2] = *(const uint2*)(VTb + (((size_t)tA * 4 + dt) * 64 + lane) * 4);
                vv[(dt * 5 + k2) * 2 + 1] = *(const uint2*)(VTb + (((size_t)tB * 4 + dt) * 64 + lane) * 4);
            }
        }
        uint2 gg[4];
#pragma unroll
        for (int dt = 0; dt < 4; ++dt) gg[dt] = *(const uint2*)(p.proj + (size_t)tq * EVEN_LD + C_GB + hq * 64 + dt * 16 + 4 * q);
        const float sink = p.sinks[j * 8 + hq];
        __builtin_amdgcn_sched_barrier(0);
        f32x4 sc[10];
#pragma unroll
        for (int kt = 0; kt < 10; ++kt) {
            f32x4 a = {0.f, 0.f, 0.f, 0.f};
            a = __builtin_amdgcn_mfma_f32_16x16x32_bf16(kf[2 * kt], qf[0], a, 0, 0, 0);
            a = __builtin_amdgcn_mfma_f32_16x16x32_bf16(kf[2 * kt + 1], qf[1], a, 0, 0, 0);
            sc[kt] = a;
        }
        const int qc = qc0 + n;
        float mx = -1e30f;
#pragma unroll
        for (int kt = 0; kt < 10; ++kt)
#pragma unroll
            for (int rr = 0; rr < 4; ++rr) {
                const int kc = key0 + 16 * kt + 4 * q + rr, rel = qc - kc;
                const bool ok = (kc >= 0) && (rel >= 0) && (rel <= 128);
                const float sv = ok ? sc[kt][rr] * 0.125f : -1e30f;
                sc[kt][rr] = sv;
                mx = fmaxf(mx, sv);
            }
        mx = fmaxf(mx, __shfl_xor(mx, 16)); mx = fmaxf(mx, __shfl_xor(mx, 32));
        const float m = fmaxf(mx, sink);
        float sum = 0.f;
#pragma unroll
        for (int kt = 0; kt < 10; ++kt)
#pragma unroll
            for (int rr = 0; rr < 4; ++rr) {
                const float pv = (sc[kt][rr] > -1e29f) ? __expf(sc[kt][rr] - m) : 0.f;
                sc[kt][rr] = pv; sum += pv;
            }
        sum += __shfl_xor(sum, 16); sum += __shfl_xor(sum, 32);
        const float inv = 1.0f / (sum + __expf(sink - m));
        bf16x8 pf[5];
#pragma unroll
        for (int k2 = 0; k2 < 5; ++k2) {
            uint4 cu;
            cu.x = pack_bf16(sc[2 * k2][0], sc[2 * k2][1]); cu.y = pack_bf16(sc[2 * k2][2], sc[2 * k2][3]);
            cu.z = pack_bf16(sc[2 * k2 + 1][0], sc[2 * k2 + 1][1]); cu.w = pack_bf16(sc[2 * k2 + 1][2], sc[2 * k2 + 1][3]);
            pf[k2] = __builtin_bit_cast(bf16x8, cu);
        }
#pragma unroll
        for (int dt = 0; dt < 4; ++dt) {
            f32x4 o = {0.f, 0.f, 0.f, 0.f};
#pragma unroll
            for (int k2 = 0; k2 < 5; ++k2) {
                const uint2 va = vv[(dt * 5 + k2) * 2], vb = vv[(dt * 5 + k2) * 2 + 1];
                const bf16x8 vf = __builtin_bit_cast(bf16x8, make_uint4(va.x, va.y, vb.x, vb.y));
                o = __builtin_amdgcn_mfma_f32_16x16x32_bf16(vf, pf[k2], o, 0, 0, 0);
            }
            if (n < nvalid) {
                const int d0 = dt * 16 + 4 * q;
                const float4 g = unpack4(gg[dt]);
                uint2 w;
                w.x = pack_bf16(o[0] * inv * siluf_(g.x), o[1] * inv * siluf_(g.y));
                w.y = pack_bf16(o[2] * inv * siluf_(g.z), o[3] * inv * siluf_(g.w));
                *(uint2*)(p.qb + (size_t)tq * D + 512 + hq * 64 + d0) = w;
            }
        }
    }
}

__device__ __forceinline__ void ph_hg_rec(const Params& p, int j, int first_stream) {
    const int tidx = tid_opaque();
    const int lane = tidx & 63;
    const int wave = (tidx >> 6) * gridDim.x + blockIdx.x, nw = gridDim.x * 4;
    const int e = lane & 3, dg = lane >> 2;
    const int nitems = (NB + NS) * 8 * 32;
    for (int item = wave + first_stream * 8 * 32; item < nitems; item += nw) {
        const int es = item & 31, h = (item >> 5) & 7, st = item >> 8;
        const int smp = st >= NB, seq = smp ? st - NB : st;
        const int t0 = smp ? TP + seq * LS : seq * SEQ, len = smp ? LS : SEQ;
        const int ec = es * 4 + e;
        float lb[8];
#pragma unroll
        for (int i = 0; i < 8; ++i) {
            const int c = h * 128 + dg * 8 + i;
            if (j == 0) lb[i] = 0.f;
            else {
                const float r0 = p.lb_raw[c], r1 = p.lb_raw[D + c];
                const float mm = fmaxf(r0, r1);
                const float e0 = __expf(r0 - mm), e1 = __expf(r1 - mm);
                lb[i] = e1 / (e0 + e1);
            }
        }
        float S[8];
        if (smp) {
            const float* s0 = p.state_hgrn + (((size_t)j * NS + seq) * 8 + h) * 128 * 128;
#pragma unroll
            for (int i = 0; i < 8; ++i) S[i] = s0[(size_t)(dg * 8 + i) * 128 + ec];
        } else {
#pragma unroll
            for (int i = 0; i < 8; ++i) S[i] = 0.f;
        }
        for (int s = 0; s < len; ++s) {
            const int t = t0 + s;
            const bf16_t* row = p.proj + (size_t)t * ODD_LD;
            const bf16x8 qv = *(const bf16x8*)(row + h * 128 + dg * 8);
            const bf16x8 fv = *(const bf16x8*)(row + 1024 + h * 128 + dg * 8);
            const float v = bf2f(row[2048 + h * 128 + ec]);
            float o = 0.f;
#pragma unroll
            for (int i = 0; i < 8; ++i) {
                const float qq = siluf_(bf2f((bf16_t)qv[i])) * 0.08838834764831845f;
                const float z = bf2f((bf16_t)fv[i]);
                const float f = fmaxf(lb[i] + (1.0f - lb[i]) * sigmoidf_(z), 1e-30f);
                const float k = (1.0f - lb[i]) * sigmoidf_(-z);
                S[i] = f * S[i] + k * v;
                o += qq * S[i];
            }
            for (int off = 4; off < 64; off <<= 1) o += __shfl_xor(o, off);
            if (dg == 0) p.hgo[(size_t)t * D + h * 128 + ec] = o;
        }
        float* so = smp ? p.hg_s + (((size_t)j * NS + seq) * 8 + h) * 128 * 128 : p.hg_p + (((size_t)j * NB + seq) * 8 + h) * 128 * 128;
#pragma unroll
        for (int i = 0; i < 8; ++i) so[(size_t)(dg * 8 + i) * 128 + ec] = S[i];
    }
}


constexpr int REC_Q = 0, REC_KT = 8192, REC_A = 16384, REC_D = 18432, REC_BYTES = 18944, REC_SIZE = 19456, REC_V = 20480, HG_SLOT = 28672;

__device__ __forceinline__ void ph_hg_prep(const Params& p, int j, char* smem) {
    const int tidx = tid_opaque();
    const int lane = tidx & 63, wid = tidx >> 6;
    char* const smem0 = smem;
    const int d = tidx & 127, half = tidx >> 7;
    bf16_t rq[16], rz[16], rv[16];
#define HG_LOAD_RAW(it_) { const int st_ = (it_) >> 7, c_ = (it_) & 127; \
        const bf16_t* row_ = p.proj + (size_t)((st_ >> 3) * SEQ + c_ * 32 + half * 16) * ODD_LD + (st_ & 7) * 128 + d; \
        _Pragma("unroll") for (int ii = 0; ii < 16; ++ii) { rq[ii] = row_[(size_t)ii * ODD_LD]; rz[ii] = row_[(size_t)ii * ODD_LD + 1024]; rv[ii] = row_[(size_t)ii * ODD_LD + 2048]; } }
    if ((int)blockIdx.x < 32 * 128) HG_LOAD_RAW(blockIdx.x);
    for (int item = blockIdx.x; item < 32 * 128; item += gridDim.x) {
        const int st = item >> 7, c = item & 127, b = st >> 3, h = st & 7;
        const int ch = h * 128 + d;
        float lb = 0.f;
        if (j != 0) {
            const float r0 = p.lb_raw[ch], r1 = p.lb_raw[D + ch];
            const float mm = fmaxf(r0, r1);
            const float e0 = __expf(r0 - mm), e1 = __expf(r1 - mm);
            lb = e1 / (e0 + e1);
        }
        char* rec = p.hgrec + (size_t)item * REC_SIZE;
        char* vrec = p.hgv + (size_t)item * 8192;
        char* smem = smem0;
        float* sQ = (float*)smem;
        float* sK = sQ + 32 * 132;
        float* sG = sK + 32 * 132;
        bf16_t* sQh = (bf16_t*)(sG + 32 * 132);
        bf16_t* sKh = sQh + 16 * 128;
        float* sA = (float*)(sKh + 16 * 128);
        float* sTot = sA + 32 * 33;
        __syncthreads();
        float qv[16], kv[16], gl_[16];
        unsigned vb[8];
        float gacc = 0.f;
#pragma unroll
        for (int ii = 0; ii < 16; ++ii) {
            const int i = half * 16 + ii;
            const float qraw = bf2f(rq[ii]), z = bf2f(rz[ii]);
            const unsigned vraw = rv[ii];
            if (ii & 1) vb[ii >> 1] |= vraw << 16; else vb[ii >> 1] = vraw;
            const float sg = sigmoidf_(z);
            const float f = fmaxf(lb + (1.0f - lb) * sg, 1e-30f);
            gacc += __logf(f);
            qv[ii] = siluf_(qraw) * 0.08838834764831845f;
            kv[ii] = (1.0f - lb) * (1.0f - sg);
            gl_[ii] = gacc;
            sQ[i * 132 + d] = qv[ii];
            sK[i * 132 + d] = kv[ii];
        }
        if (item + (int)gridDim.x < 32 * 128) HG_LOAD_RAW(item + gridDim.x);
        sTot[half * 128 + d] = gacc;
#pragma unroll
        for (int ii = 0; ii < 16; ++ii) {
            const int off = ii * 128 + ((((d >> 3) ^ (ii & 7)) << 3) | (d & 7));
            if (half) sQh[off] = f2bf(qv[ii] * __expf(gl_[ii]));
            else sKh[off] = f2bf(kv[ii] * __expf(gacc - gl_[ii]));
        }
        for (int e = tidx; e < 32 * 33; e += 256) sA[e] = 0.f;
        __syncthreads();
        const float tot0 = sTot[d], tot1 = sTot[128 + d];
        const float glv = tot0 + tot1, goff = half ? tot0 : 0.f;
#pragma unroll
        for (int ii = 0; ii < 16; ++ii) { gl_[ii] += goff; sG[(half * 16 + ii) * 132 + d] = gl_[ii] * 1.4426950408889634f; }
#pragma unroll
        for (int g = 0; g < 2; ++g) {
            const int kg = 2 * half + g;
            uint4 w;
            w.x = pack_bf16(kv[g * 8 + 0] * __expf(glv - gl_[g * 8 + 0]), kv[g * 8 + 1] * __expf(glv - gl_[g * 8 + 1]));
            w.y = pack_bf16(kv[g * 8 + 2] * __expf(glv - gl_[g * 8 + 2]), kv[g * 8 + 3] * __expf(glv - gl_[g * 8 + 3]));
            w.z = pack_bf16(kv[g * 8 + 4] * __expf(glv - gl_[g * 8 + 4]), kv[g * 8 + 5] * __expf(glv - gl_[g * 8 + 5]));
            w.w = pack_bf16(kv[g * 8 + 6] * __expf(glv - gl_[g * 8 + 6]), kv[g * 8 + 7] * __expf(glv - gl_[g * 8 + 7]));
            *(uint4*)(rec + REC_KT + (((d >> 4) * 64) + kg * 16 + (d & 15)) * 16) = w;
            uint4 vv; vv.x = vb[g * 4 + 0]; vv.y = vb[g * 4 + 1]; vv.z = vb[g * 4 + 2]; vv.w = vb[g * 4 + 3];
            *(uint4*)(vrec + ((((d >> 5) * 2 + ((d >> 4) & 1)) * 64) + kg * 16 + (d & 15)) * 16) = vv;
        }
        if (half == 0) *(float*)(rec + REC_D + d * 4) = __expf(glv);
        __syncthreads();
#pragma unroll
        for (int u = 0; u < 2; ++u) {
            const int sidx = tidx + 256 * u;
            const int mt = sidx >> 8, kk = (sidx >> 6) & 3, ln = sidx & 63, r = ln & 15, q = ln >> 4;
            const int i = mt * 16 + r, dA = kk * 32 + 4 * q, dB = dA + 16;
            const float4 qa = *(const float4*)(sQ + i * 132 + dA), ga = *(const float4*)(sG + i * 132 + dA);
            const float4 qb_ = *(const float4*)(sQ + i * 132 + dB), gb_ = *(const float4*)(sG + i * 132 + dB);
            uint4 w;
            w.x = pack_bf16(qa.x * __builtin_amdgcn_exp2f(ga.x), qa.y * __builtin_amdgcn_exp2f(ga.y));
            w.y = pack_bf16(qa.z * __builtin_amdgcn_exp2f(ga.z), qa.w * __builtin_amdgcn_exp2f(ga.w));
            w.z = pack_bf16(qb_.x * __builtin_amdgcn_exp2f(gb_.x), qb_.y * __builtin_amdgcn_exp2f(gb_.y));
            w.w = pack_bf16(qb_.z * __builtin_amdgcn_exp2f(gb_.z), qb_.w * __builtin_amdgcn_exp2f(gb_.w));
            *(uint4*)(rec + REC_Q + sidx * 16) = w;
        }
        if (wid == 0) {
            f32x4 acc = {0.f, 0.f, 0.f, 0.f};
            const int r = lane & 15, kg = lane >> 4;
#pragma unroll
            for (int kk = 0; kk < 4; ++kk) {
                const int chn = kk * 4 + kg;
                const bf16x8 a = *(const bf16x8*)(sQh + r * 128 + ((chn ^ (r & 7)) << 3));
                const bf16x8 bb = *(const bf16x8*)(sKh + r * 128 + ((chn ^ (r & 7)) << 3));
                acc = __builtin_amdgcn_mfma_f32_16x16x32_bf16(a, bb, acc, 0, 0, 0);
            }
#pragma unroll
            for (int rr = 0; rr < 4; ++rr) sA[(16 + 4 * kg + rr) * 33 + r] = acc[rr];
        }
        {
            const int sl = tidx & 7;
#pragma unroll 1
            for (int pidx = tidx >> 3; pidx < 272; pidx += 32) {
                const int blk2 = pidx >= 136, tt = pidx - (blk2 ? 136 : 0);
                int r = (int)((__builtin_sqrtf(8.0f * tt + 1.0f) - 1.0f) * 0.5f);
                if ((r + 1) * (r + 2) / 2 <= tt) ++r;
                if (r * (r + 1) / 2 > tt) --r;
                const int cidx = tt - r * (r + 1) / 2;
                const int i = blk2 * 16 + r, jr = blk2 * 16 + cidx;
                float sum = 0.f;
#pragma unroll
                for (int u = 0; u < 4; ++u) {
                    const float4 qa = *(const float4*)(sQ + i * 132 + sl * 16 + u * 4), gi = *(const float4*)(sG + i * 132 + sl * 16 + u * 4);
                    const float4 kq = *(const float4*)(sK + jr * 132 + sl * 16 + u * 4), g = *(const float4*)(sG + jr * 132 + sl * 16 + u * 4);
                    sum += qa.x * kq.x * __builtin_amdgcn_exp2f(gi.x - g.x);
                    sum += qa.y * kq.y * __builtin_amdgcn_exp2f(gi.y - g.y);
                    sum += qa.z * kq.z * __builtin_amdgcn_exp2f(gi.z - g.z);
                    sum += qa.w * kq.w * __builtin_amdgcn_exp2f(gi.w - g.w);
                }
                sum += __shfl_xor(sum, 1); sum += __shfl_xor(sum, 2); sum += __shfl_xor(sum, 4);
                if (sl == 0) sA[i * 33 + jr] = sum;
            }
        }
        __syncthreads();
        if (tidx < 128) {
            const int mt = tidx >> 6, ln = tidx & 63, r = ln & 15, kg = ln >> 4;
            const float* ap = sA + (mt * 16 + r) * 33 + kg * 8;
            uint4 w;
            w.x = pack_bf16(ap[0], ap[1]); w.y = pack_bf16(ap[2], ap[3]); w.z = pack_bf16(ap[4], ap[5]); w.w = pack_bf16(ap[6], ap[7]);
            *(uint4*)(rec + REC_A + tidx * 16) = w;
        }
    }
}

__device__ __forceinline__ void ph_hg_scan(const Params& p, int j, char* smem, int item0) {
    const int tidx = tid_opaque();
    const int lane = tidx & 63, wid = tidx >> 6, n = lane & 15, q = lane >> 4;
    const unsigned lbase = __builtin_amdgcn_readfirstlane(lds_base_addr() + wid * 1024);
    for (int item = item0; item < 64; item += gridDim.x) {
        const int st = item >> 1, et = (item & 1) * 4 + wid;
        const int b = st >> 3, h = st & 7;
        f32x4 acc[8];
#pragma unroll
        for (int mt = 0; mt < 8; ++mt) acc[mt] = (f32x4){0.f, 0.f, 0.f, 0.f};
        const char* rec = p.hgrec + (size_t)st * 128 * REC_SIZE + tidx * 16;
        const char* vrec = p.hgv + (size_t)st * 128 * 8192 + tidx * 16;
        __syncthreads();
#pragma unroll
        for (int k = 0; k < 5; ++k) glds16_asm(rec + k * 4096, lbase + k * 4096);
#pragma unroll
        for (int k = 0; k < 2; ++k) glds16_asm(vrec + k * 4096, lbase + REC_V + k * 4096);
        asm volatile("s_waitcnt vmcnt(0)" ::: "memory");
        __syncthreads();
        f32x4 po[2];
        po[0] = (f32x4){0.f, 0.f, 0.f, 0.f}; po[1] = (f32x4){0.f, 0.f, 0.f, 0.f};
#pragma unroll 1
        for (int c = 0; c <= 128; ++c) {
            if (c > 0) {
                const int tc = b * SEQ + (c - 1) * 32;
#pragma unroll
                for (int mt = 0; mt < 2; ++mt)
#pragma unroll
                    for (int rr = 0; rr < 4; ++rr) p.hgo[(size_t)(tc + mt * 16 + 4 * q + rr) * D + h * 128 + et * 16 + n] = po[mt][rr];
            }
            if (c == 128) break;
            MEMFENCE();
            if (c + 1 < 128) {
                const unsigned dst = lbase + ((c + 1) & 1) * HG_SLOT;
#pragma unroll
                for (int k = 0; k < 5; ++k) glds16_asm(rec + (size_t)(c + 1) * REC_SIZE + k * 4096, dst + k * 4096);
#pragma unroll
                for (int k = 0; k < 2; ++k) glds16_asm(vrec + (size_t)(c + 1) * 8192 + k * 4096, dst + REC_V + k * 4096);
            }
            const char* slot = smem + (c & 1) * HG_SLOT;
            const bf16x8 vf = *(const bf16x8*)(slot + REC_V + et * 1024 + lane * 16);
            bf16x8 sB[4];
#pragma unroll
            for (int kk = 0; kk < 4; ++kk) {
                const f32x4 lo = acc[2 * kk], hi = acc[2 * kk + 1];
                uint4 cu;
                cu.x = pack_bf16(lo[0], lo[1]); cu.y = pack_bf16(lo[2], lo[3]); cu.z = pack_bf16(hi[0], hi[1]); cu.w = pack_bf16(hi[2], hi[3]);
                sB[kk] = __builtin_bit_cast(bf16x8, cu);
            }
#pragma unroll
            for (int mt = 0; mt < 2; ++mt) {
                const bf16x8 af = *(const bf16x8*)(slot + REC_A + (mt * 64 + lane) * 16);
                f32x4 o0 = {0.f, 0.f, 0.f, 0.f};
#pragma unroll
                for (int kk = 0; kk < 4; ++kk) {
                    const bf16x8 qf = *(const bf16x8*)(slot + REC_Q + ((mt * 4 + kk) * 64 + lane) * 16);
                    o0 = __builtin_amdgcn_mfma_f32_16x16x32_bf16(qf, sB[kk], o0, 0, 0, 0);
                }
                po[mt] = __builtin_amdgcn_mfma_f32_16x16x32_bf16(af, vf, o0, 0, 0, 0);
            }
#pragma unroll
            for (int mt = 0; mt < 8; ++mt) {
                const float4 dv = *(const float4*)(slot + REC_D + (mt * 16 + 4 * q) * 4);
                const bf16x8 kt = *(const bf16x8*)(slot + REC_KT + (mt * 64 + lane) * 16);
                f32x4 c0 = acc[mt];
                c0[0] *= dv.x; c0[1] *= dv.y; c0[2] *= dv.z; c0[3] *= dv.w;
                acc[mt] = __builtin_amdgcn_mfma_f32_16x16x32_bf16(kt, vf, c0, 0, 0, 0);
            }
            asm volatile("s_waitcnt vmcnt(0) lgkmcnt(0)" ::: "memory");
            __builtin_amdgcn_s_barrier();
            MEMFENCE();
        }
        float* so = p.hg_p + (((size_t)j * NB + b) * 8 + h) * 128 * 128;
#pragma unroll
        for (int mt = 0; mt < 8; ++mt)
#pragma unroll
            for (int rr = 0; rr < 4; ++rr) so[(size_t)(mt * 16 + 4 * q + rr) * 128 + et * 16 + n] = acc[mt][rr];
    }
}


__device__ __forceinline__ void ph_hg_rec2(const Params& p, int j, char* smem, int bid, int nblk) {
    const int tidx = tid_opaque();
    const int lane = tidx & 63, wid = tidx >> 6;
    float* sb = (float*)(smem + wid * 2048);
    const int wave = wid * nblk + bid, nw = nblk * 4;
    __syncthreads();
    for (int item = wave; item < NS * 8 * 2; item += nw) {
        const int hf = item & 1, h = (item >> 1) & 7, nn = item >> 4;
        const int e = hf * 64 + lane;
        float lb0 = 0.f, lb1 = 0.f;
        if (j != 0) {
            const int c0 = h * 128 + lane, c1 = c0 + 64;
            { const float r0 = p.lb_raw[c0], r1 = p.lb_raw[D + c0], mm = fmaxf(r0, r1), e0 = __expf(r0 - mm), e1 = __expf(r1 - mm); lb0 = e1 / (e0 + e1); }
            { const float r0 = p.lb_raw[c1], r1 = p.lb_raw[D + c1], mm = fmaxf(r0, r1), e0 = __expf(r0 - mm), e1 = __expf(r1 - mm); lb1 = e1 / (e0 + e1); }
        }
        const float* s0 = p.state_hgrn + (((size_t)j * NS + nn) * 8 + h) * 128 * 128 + e;
        float S[128];
#pragma unroll
        for (int d = 0; d < 128; ++d) S[d] = s0[(size_t)d * 128];
        for (int st = 0; st < LS; ++st) {
            const int t = TP + nn * LS + st;
            const bf16_t* row = p.proj + (size_t)t * ODD_LD + h * 128;
            {
                const float q0 = bf2f(row[lane]), q1 = bf2f(row[lane + 64]);
                const float z0 = bf2f(row[1024 + lane]), z1 = bf2f(row[1024 + lane + 64]);
                const float g0 = sigmoidf_(z0), g1 = sigmoidf_(z1);
                sb[lane] = siluf_(q0) * 0.08838834764831845f; sb[lane + 64] = siluf_(q1) * 0.08838834764831845f;
                sb[128 + lane] = fmaxf(lb0 + (1.0f - lb0) * g0, 1e-30f); sb[128 + lane + 64] = fmaxf(lb1 + (1.0f - lb1) * g1, 1e-30f);
                sb[256 + lane] = (1.0f - lb0) * (1.0f - g0); sb[256 + lane + 64] = (1.0f - lb1) * (1.0f - g1);
            }
            const float v = bf2f(row[2048 + e]);
            float o = 0.f;
#pragma unroll
            for (int d4 = 0; d4 < 32; ++d4) {
                const float4 qv = *(const float4*)(sb + d4 * 4), fv = *(const float4*)(sb + 128 + d4 * 4), kv = *(const float4*)(sb + 256 + d4 * 4);
                S[d4 * 4] = fv.x * S[d4 * 4] + kv.x * v; o += qv.x * S[d4 * 4];
                S[d4 * 4 + 1] = fv.y * S[d4 * 4 + 1] + kv.y * v; o += qv.y * S[d4 * 4 + 1];
                S[d4 * 4 + 2] = fv.z * S[d4 * 4 + 2] + kv.z * v; o += qv.z * S[d4 * 4 + 2];
                S[d4 * 4 + 3] = fv.w * S[d4 * 4 + 3] + kv.w * v; o += qv.w * S[d4 * 4 + 3];
                if ((d4 & 3) == 3) asm volatile("" : "+v"(o) :: "memory");
            }
            p.hgo[(size_t)t * D + h * 128 + e] = o;
        }
        float* so = p.hg_s + (((size_t)j * NS + nn) * 8 + h) * 128 * 128 + e;
#pragma unroll
        for (int d = 0; d < 128; ++d) so[(size_t)d * 128] = S[d];
    }
}

__device__ __forceinline__ void ph_dn_rec2(const Params& p, int j, char* smem, int bid, int nblk) {
    const int tidx = tid_opaque();
    const int lane = tidx & 63, wid = tidx >> 6;
    float* sb = (float*)(smem + wid * 2048);
    const int wave = wid * nblk + bid, nw = nblk * 4;
    for (int item = wave; item < NS * 4 * 2; item += nw) {
        const int hf = item & 1, h = (item >> 1) & 3, nn = item >> 3;
        const int e = hf * 64 + lane;
        const float* s0 = p.state_delta + (((size_t)j * NS + nn) * 4 + h) * 128 * 128 + e;
        float S[128];
#pragma unroll
        for (int d = 0; d < 128; ++d) S[d] = s0[(size_t)d * 128];
        for (int st = 0; st < LS; ++st) {
            const int ts = nn * LS + st;
            const bf16_t* row = p.dnqkv + (size_t)ts * CONV_CH + h * 128;
            const float q0 = bf2f(row[lane]), q1 = bf2f(row[lane + 64]), k0 = bf2f(row[512 + lane]), k1 = bf2f(row[512 + lane + 64]);
            sb[lane] = q0; sb[lane + 64] = q1; sb[128 + lane] = k0; sb[128 + lane + 64] = k1;
            float qk = q0 * k0 + q1 * k1;
            for (int off = 32; off > 0; off >>= 1) qk += __shfl_xor(qk, off);
            const float v = bf2f(row[1024 + e]);
            const float g = p.dngb[(size_t)ts * 8 + h], beta = p.dngb[(size_t)ts * 8 + 4 + h];
            float kS = 0.f, qS = 0.f;
#pragma unroll
            for (int d4 = 0; d4 < 32; ++d4) {
                const float4 qv = *(const float4*)(sb + d4 * 4), kv = *(const float4*)(sb + 128 + d4 * 4);
                kS += kv.x * S[d4 * 4] + kv.y * S[d4 * 4 + 1] + kv.z * S[d4 * 4 + 2] + kv.w * S[d4 * 4 + 3];
                qS += qv.x * S[d4 * 4] + qv.y * S[d4 * 4 + 1] + qv.z * S[d4 * 4 + 2] + qv.w * S[d4 * 4 + 3];
                if ((d4 & 3) == 3) asm volatile("" : "+v"(kS), "+v"(qS) :: "memory");
            }
            const float a = __expf(g);
            const float vn = beta * (v - a * kS);
            p.dno[(size_t)ts * 512 + h * 128 + e] = 0.08838834764831845f * (a * qS + qk * vn);
#pragma unroll
            for (int d4 = 0; d4 < 32; ++d4) {
                const float4 kv = *(const float4*)(sb + 128 + d4 * 4);
                S[d4 * 4] = a * S[d4 * 4] + kv.x * vn; S[d4 * 4 + 1] = a * S[d4 * 4 + 1] + kv.y * vn;
                S[d4 * 4 + 2] = a * S[d4 * 4 + 2] + kv.z * vn; S[d4 * 4 + 3] = a * S[d4 * 4 + 3] + kv.w * vn;
                if ((d4 & 3) == 3) asm volatile("" : "+v"(S[d4 * 4 + 3]) :: "memory");
            }
        }
        float* so = p.delta_s + (((size_t)j * NS + nn) * 4 + h) * 128 * 128 + e;
#pragma unroll
        for (int d = 0; d < 128; ++d) so[(size_t)d * 128] = S[d];
    }
}

__device__ __forceinline__ void ph_hg_post(const Params& p, int j) {
    const int tidx = tid_opaque();
    const int lane = tidx & 63, grp = lane >> 4, l16 = lane & 15;
    const int wave = blockIdx.x * 4 + (tidx >> 6), nw = gridDim.x * 4;
    const float4 nc0 = *(const float4*)(p.norm_c + j * 128 + l16 * 8), nc1 = *(const float4*)(p.norm_c + j * 128 + l16 * 8 + 4);
    for (int it = wave; it < T * 2; it += nw) {
        const int item = it * 4 + grp, t = item >> 3, h = item & 7;
        const float* op = p.hgo + (size_t)t * D + h * 128 + l16 * 8;
        const float4 a0 = *(const float4*)op, a1 = *(const float4*)(op + 4);
        const uint4 gv = *(const uint4*)(p.proj + (size_t)t * ODD_LD + 3072 + h * 128 + l16 * 8);
        float ss = a0.x * a0.x + a0.y * a0.y + a0.z * a0.z + a0.w * a0.w + a1.x * a1.x + a1.y * a1.y + a1.z * a1.z + a1.w * a1.w;
        ss += __shfl_xor(ss, 1); ss += __shfl_xor(ss, 2); ss += __shfl_xor(ss, 4); ss += __shfl_xor(ss, 8);
        const float r = rsqrtf(ss * (1.0f / 128.0f) + EPS);
        const float4 g0 = unpack4(make_uint2(gv.x, gv.y)), g1 = unpack4(make_uint2(gv.z, gv.w));
        uint4 o;
        o.x = pack_bf16(a0.x * r * nc0.x * siluf_(g0.x), a0.y * r * nc0.y * siluf_(g0.y));
        o.y = pack_bf16(a0.z * r * nc0.z * siluf_(g0.z), a0.w * r * nc0.w * siluf_(g0.w));
        o.z = pack_bf16(a1.x * r * nc1.x * siluf_(g1.x), a1.y * r * nc1.y * siluf_(g1.y));
        o.w = pack_bf16(a1.z * r * nc1.z * siluf_(g1.z), a1.w * r * nc1.w * siluf_(g1.w));
        *(uint4*)(p.qb + (size_t)t * D + h * 128 + l16 * 8) = o;
    }
}

#define XB_TMO      128
#define XB_XCNT(j)  (256  + 64 * (j))
#define XB_XSUB(j)  (1280 + 64 * (j))
#define XB_XGEN(j)  (2304 + 64 * (j))
#define XB_TOP      3328
#define XB_TOPGEN   3392
#define XB_CUCNT    3456
#define XB_CUIDX    7552
#define XB_NA       11648
#define XB_BAD      11649
#define XCD_BAR_WORDS 11712
#define XB_SPIN_CAP (1u << 20)
__device__ __forceinline__ unsigned xb_ld(unsigned* p)              { return __hip_atomic_load(p, __ATOMIC_RELAXED, __HIP_MEMORY_SCOPE_AGENT); }
__device__ __forceinline__ unsigned xb_add(unsigned* p, unsigned v) { return __hip_atomic_fetch_add(p, v, __ATOMIC_RELAXED, __HIP_MEMORY_SCOPE_AGENT); }
__device__ __forceinline__ unsigned xb_xcc_id() { return (unsigned)__builtin_amdgcn_s_getreg((3 << 11) | 20) & 0xFu; }
#define XB_SPIN(cond, bar) do { unsigned _sp = 0; while (cond) { __builtin_amdgcn_s_sleep(1); \
    if ((++_sp & 255u) == 0u) { if (xb_ld(&(bar)[XB_TMO])) break; if (_sp > XB_SPIN_CAP) { atomicAdd(&(bar)[XB_TMO], 1u); break; } } } } while (0)
__device__ __forceinline__ unsigned xb_cu_key() { return (unsigned)__builtin_amdgcn_s_getreg((7 << 11) | (8 << 6) | 4) & 0xFFu; }
struct XcdBarrier { unsigned* bar; unsigned x, nloc, nx, rank, even, cukey; int dn_item, dn_bid, hg_item, hg_bid, hg_nbk; };

__device__ __forceinline__ XcdBarrier xcd_setup(unsigned* bar, char* smem) {
    XcdBarrier b; b.bar = bar; b.x = xb_xcc_id();
    volatile unsigned* st = (volatile unsigned*)smem;
    if (threadIdx.x == 0) {
        {
            const unsigned key = b.x * 256u + xb_cu_key();
            const unsigned r = xb_add(&bar[XB_CUCNT + key], 1u);
            if (r == 0u) { const unsigned ia = xb_add(&bar[XB_NA], 1u); xb_add(&bar[XB_CUIDX + key], ia + 1u); }
            else if (r >= 2u) xb_add(&bar[XB_BAD], 1u);
            st[4] = key; st[5] = r;
        }
        st[2] = xb_add(&bar[XB_XCNT(b.x)], 1u);
        const unsigned G = gridDim.x;
        unsigned sum, cnt, mine, sp = 0u;
        for (;;) {
            sum = 0u; cnt = 0u; mine = 0u;
#pragma unroll
            for (unsigned jx = 0; jx < 16; ++jx) { const unsigned c = xb_ld(&bar[XB_XCNT(jx)]); sum += c; cnt += (c > 0u) ? 1u : 0u; mine = (jx == b.x) ? c : mine; }
            if (sum == G) break;
            __builtin_amdgcn_s_sleep(1);
            if ((++sp & 255u) == 0u) { if (xb_ld(&bar[XB_TMO])) break; if (sp > XB_SPIN_CAP) { atomicAdd(&bar[XB_TMO], 1u); break; } }
        }
        st[0] = mine > 0u ? mine : 1u; st[1] = cnt > 0u ? cnt : 1u;
        unsigned ev = (sum == G && cnt == 8u) ? 1u : 0u;
#pragma unroll
        for (unsigned jx = 0; jx < 16; ++jx) { const unsigned c = xb_ld(&bar[XB_XCNT(jx)]); if (c != 0u && c * 8u != G) ev = 0u; }
        st[3] = ev;
    }
    __syncthreads();
    b.nloc = __builtin_amdgcn_readfirstlane(st[0]); b.nx = __builtin_amdgcn_readfirstlane(st[1]); b.rank = __builtin_amdgcn_readfirstlane(st[2]); b.even = __builtin_amdgcn_readfirstlane(st[3]);
    b.cukey = __builtin_amdgcn_readfirstlane(st[4]) | (__builtin_amdgcn_readfirstlane(st[5]) << 16);
    b.dn_item = b.dn_bid = b.hg_item = b.hg_bid = b.hg_nbk = 0;
    __syncthreads();
    return b;
}

__device__ __forceinline__ void xcd_barrier(const XcdBarrier& b) {
    asm volatile("s_waitcnt vmcnt(0)" ::: "memory");
    __syncthreads();
    if (threadIdx.x == 0) {
        unsigned* bar = b.bar;
        __builtin_amdgcn_s_waitcnt(0);
        const unsigned nloc = b.nloc, nx = b.nx;
        const unsigned old = xb_add(&bar[XB_XSUB(b.x)], 1u);
        const unsigned gen = old / nloc;
        if (old + 1u == (gen + 1u) * nloc) {
            __builtin_amdgcn_fence(__ATOMIC_RELEASE, "agent");
            asm volatile("s_waitcnt vmcnt(0)" ::: "memory");
            const unsigned og = xb_add(&bar[XB_TOP], 1u);
            const unsigned tg = og / nx;
            if (og + 1u == (tg + 1u) * nx) xb_add(&bar[XB_TOPGEN], 1u);
            else XB_SPIN(xb_ld(&bar[XB_TOPGEN]) == tg, bar);
            __builtin_amdgcn_fence(__ATOMIC_ACQUIRE, "agent");
            xb_add(&bar[XB_XGEN(b.x)], 1u);
            asm volatile("s_waitcnt vmcnt(0)" ::: "memory");
        } else {
            XB_SPIN(xb_ld(&bar[XB_XGEN(b.x)]) == gen, bar);
            __builtin_amdgcn_fence(__ATOMIC_ACQUIRE, "agent");
            asm volatile("s_waitcnt vmcnt(0)" ::: "memory");
        }
    }
    __syncthreads();
}

__device__ __forceinline__ void xcd_roles(XcdBarrier& b, char* smem) {
    volatile unsigned* st = (volatile unsigned*)smem;
    const unsigned key = b.cukey & 0xFFFFu, r = b.cukey >> 16;
    if (threadIdx.x == 0) { st[0] = xb_ld(&b.bar[XB_CUIDX + key]); st[1] = xb_ld(&b.bar[XB_NA]); st[2] = xb_ld(&b.bar[XB_BAD]); }
    __syncthreads();
    const int ia = (int)__builtin_amdgcn_readfirstlane(st[0]) - 1, nA = (int)__builtin_amdgcn_readfirstlane(st[1]), bad = (int)__builtin_amdgcn_readfirstlane(st[2]);
    __syncthreads();
    const int G = gridDim.x;
    const bool paired = (bad == 0) && (nA * 2 == G) && (nA >= 64) && (ia >= 0) && (r < 2u);
    if (paired) {
        b.dn_item = (r == 0u && ia < 32) ? ia : -1; b.dn_bid = (r != 0u) ? ia : nA + (ia - 32);
        b.hg_item = (r == 0u && ia < 64) ? ia : -1; b.hg_bid = (ia < 64) ? -1 : ((r == 0u) ? ia - 64 : (nA - 64) + (ia - 64));
        b.hg_nbk = G - 128;
    } else {
        b.dn_item = ((int)blockIdx.x < 32) ? (int)blockIdx.x : -1; b.dn_bid = (int)blockIdx.x - 32;
        b.hg_item = ((int)blockIdx.x < 64) ? (int)blockIdx.x : -1; b.hg_bid = (int)blockIdx.x - 64; b.hg_nbk = G - 64;
    }
}

template <int LAYER>
__device__ __forceinline__ void run_layer(const Params& p, const XcdBarrier& xb, const TileCtx& tc, char* smem) {
    constexpr int layer = LAYER;
    constexpr int j = LAYER >> 1;
        if constexpr ((LAYER & 1) == 0) {
            ph_gemm_in<0>(p, p.xb, p.wt_in_even + (size_t)j * EVEN_LD * D, EVEN_LD, D, layer, smem);
            ph_conv_p(p, layer);
            xcd_barrier(xb);
            ph_dn_prep(p, j, smem);
            ph_dn_pre(p, j);
            ph_swa_pre(p, j);
            ph_swa_prep2(p, j, smem);
            xcd_barrier(xb);
            if (xb.dn_item >= 0) ph_dn_scan(p, j, smem, xb.dn_item);
            else { const int bid = __builtin_amdgcn_readfirstlane(xb.dn_bid), nbk = __builtin_amdgcn_readfirstlane((int)gridDim.x - 32); ph_dn_rec2(p, j, smem, bid, nbk); ph_swa_attn2(p, j, bid, nbk);
                   TileCtx ts; ts.x = -1; ts.lb = bid; ts.nlb = nbk;
                   ph_gemm<3>(p, ts, p.pb, p.wt_proj + (size_t)layer * D * PLE, D, PLE, layer, smem);
                   if (LAYER == 0) ph_weights(p, 1, smem, bid, nbk); }
            xcd_barrier(xb);
            ph_dn_out(p, j);
            ph_dn_post(p, j);
            xcd_barrier(xb);
            ph_gemm<2>(p, tc, p.qb, p.wt_out_even + (size_t)j * D * D, D, D, layer, smem);
        } else {
            ph_gemm_in<1>(p, p.xb, p.wt_in_odd + (size_t)j * ODD_LD * D, ODD_LD, D, layer, smem);
            ph_conv_p(p, layer);
            xcd_barrier(xb);
            ph_hg_prep(p, j, smem);
            xcd_barrier(xb);
            if (xb.hg_item >= 0) ph_hg_scan(p, j, smem, xb.hg_item);
            else if (xb.hg_bid >= 0) {
                const int bid = __builtin_amdgcn_readfirstlane(xb.hg_bid), nbk = __builtin_amdgcn_readfirstlane(xb.hg_nbk);
                TileCtx ts; ts.x = -1; ts.lb = bid; ts.nlb = nbk;
                ph_hg_rec2(p, j, smem, bid, nbk);
                ph_gemm<3>(p, ts, p.pb, p.wt_proj + (size_t)layer * D * PLE, D, PLE, layer, smem);
                if (LAYER == 1) { ph_weights(p, 2, smem, bid, nbk); ph_weights(p, 3, smem, bid, nbk); }
            }
            xcd_barrier(xb);
            ph_hg_post(p, j);
            xcd_barrier(xb);
            ph_gemm<2>(p, tc, p.qb, p.wt_out_odd + (size_t)j * D * D, D, D, layer, smem);
        }
        xcd_barrier(xb);
        ph_layernorm(p, layer, smem);
        xcd_barrier(xb);
        ph_gemm<4>(p, tc, p.qb, p.wt_gate + (size_t)layer * D * D, D, D, layer, smem);
        if (layer < 3) xcd_barrier(xb);
}

__global__ void __launch_bounds__(256, 2) mega(Params p) {
    char* smem = g_smem;
    XcdBarrier xb = xcd_setup(p.bar, smem);
    ph_weights(p, 0, smem, blockIdx.x, gridDim.x);
    ph_prep_act(p);
    xcd_barrier(xb);
    xcd_roles(xb, smem);
    TileCtx tc;
    if (xb.even) { tc.x = (int)xb.x; tc.lb = (int)xb.rank; tc.nlb = (int)xb.nloc; }
    else { tc.x = blockIdx.x & 7; tc.lb = blockIdx.x >> 3; tc.nlb = gridDim.x >> 3; }
    run_layer<0>(p, xb, tc, smem);
    run_layer<1>(p, xb, tc, smem);
    run_layer<2>(p, xb, tc, smem);
    run_layer<3>(p, xb, tc, smem);
}

static inline size_t align_up(size_t x) { return (x + 255) & ~(size_t)255; }

extern "C" void kernel_launch(void* const* d_in, const int* in_sizes, int n_in, void* d_out, int out_size, void* d_ws, size_t ws_size, hipStream_t stream) {
    Params p{};
    p.x_prompt = (const float*)d_in[0]; p.x_sample = (const float*)d_in[1]; p.state_conv = (const float*)d_in[2]; p.state_delta = (const float*)d_in[3];
    p.cache_k = (const float*)d_in[4]; p.cache_v = (const float*)d_in[5]; p.state_hgrn = (const float*)d_in[6]; p.p_prompt = (const float*)d_in[7]; p.p_sample = (const float*)d_in[8];
    p.w_in_even = (const float*)d_in[9]; p.conv_w = (const float*)d_in[10]; p.a_log = (const float*)d_in[11]; p.dt_bias = (const float*)d_in[12]; p.norm_a = (const float*)d_in[13];
    p.sinks = (const float*)d_in[14]; p.w_out_even = (const float*)d_in[15]; p.w_in_odd = (const float*)d_in[16]; p.lb_raw = (const float*)d_in[17]; p.norm_c = (const float*)d_in[18];
    p.w_out_odd = (const float*)d_in[19]; p.ln_g = (const float*)d_in[20]; p.ln_b = (const float*)d_in[21]; p.w_ple_proj = (const float*)d_in[22]; p.w_ple_gate = (const float*)d_in[23];
    float* o = (float*)d_out;
    p.y_prompt = o; o += (size_t)TP * D;
    p.y_sample = o; o += (size_t)TS * D;
    p.conv_p = o; o += (size_t)2 * NB * 3 * CONV_CH;
    p.conv_s = o; o += (size_t)2 * NS * 3 * CONV_CH;
    p.delta_p = o; o += (size_t)2 * NB * 4 * 128 * 128;
    p.delta_s = o; o += (size_t)2 * NS * 4 * 128 * 128;
    p.wk_p = o; o += (size_t)2 * NB * 128 * 128;
    p.wk_s = o; o += (size_t)2 * NS * 128 * 128;
    p.wv_p = o; o += (size_t)2 * NB * 128 * 128;
    p.wv_s = o; o += (size_t)2 * NS * 128 * 128;
    p.hg_p = o; o += (size_t)2 * NB * 8 * 128 * 128;
    p.hg_s = o; o += (size_t)2 * NS * 8 * 128 * 128;

    char* w = (char*)d_ws; size_t off = 0;
    auto carve = [&](size_t bytes) { char* r = w + off; off += align_up(bytes); return r; };
    p.wt_in_even = (bf16_t*)carve((size_t)2 * EVEN_LD * D * 2);
    p.wt_out_even = (bf16_t*)carve((size_t)2 * D * D * 2);
    p.wt_in_odd = (bf16_t*)carve((size_t)2 * ODD_LD * D * 2);
    p.wt_out_odd = (bf16_t*)carve((size_t)2 * D * D * 2);
    p.wt_gate = (bf16_t*)carve((size_t)4 * D * D * 2);
    p.wt_proj = (bf16_t*)carve((size_t)4 * D * PLE * 2);
    p.p2 = (bf16_t*)carve((size_t)T * D * 2);
    p.xb = (bf16_t*)carve((size_t)T * D * 2);
    p.qb = (bf16_t*)carve((size_t)T * D * 2);
    p.pb = (bf16_t*)carve((size_t)T * PLE * 2);
    p.proj = (bf16_t*)carve((size_t)T * ODD_LD * 2);
    p.aux = (float*)carve((size_t)T * 8 * 4);
    p.rope = (float*)carve((size_t)(SEQ + LS) * 16 * 4);
    p.bar = (unsigned*)carve((size_t)XCD_BAR_WORDS * 4);
    char* scr = w + off;
    {
        size_t o2 = 0;
        auto c2 = [&](size_t bytes) { char* r = scr + o2; o2 += align_up(bytes); return r; };
        p.dnqkv = (bf16_t*)c2((size_t)TS * CONV_CH * 2);
        p.dngb = (float*)c2((size_t)TS * 8 * 4);
        p.dno = (float*)c2((size_t)TS * 512 * 4);
        p.qr = (bf16_t*)c2((size_t)T * 512 * 2);
        p.dnrec = c2((size_t)16 * 64 * DR_SIZE);
        p.dnsp = c2((size_t)16 * 64 * 32768);
        p.dngl = (float*)c2((size_t)16 * 64 * 4);
        p.krb = (bf16_t*)c2((size_t)TP * 128 * 2);
        p.vT = (bf16_t*)c2((size_t)NB * 128 * SEQ * 2);
        p.kcat = (bf16_t*)c2((size_t)NS * 2 * 144 * 64 * 2);
        p.vTcat = (bf16_t*)c2((size_t)NS * 128 * 160 * 2);
    }
    p.hgo = (float*)scr;
    p.hgrec = scr + align_up((size_t)T * D * 4);
    p.hgv = p.hgrec + (size_t)32 * 128 * REC_SIZE;

    static int grid_blocks = 0;
    if (!grid_blocks) {
        int dev = 0, cus = 0, per_cu = 0;
        hipGetDevice(&dev);
        hipDeviceGetAttribute(&cus, hipDeviceAttributeMultiprocessorCount, dev);
        hipOccupancyMaxActiveBlocksPerMultiprocessor(&per_cu, mega, 256, 0);
        if (per_cu > 2) per_cu = 2;
        grid_blocks = cus * per_cu;
    }
    hipMemsetAsync(p.bar, 0, (size_t)XCD_BAR_WORDS * 4, stream);
    void* args[] = {&p};
    hipError_t e = hipLaunchCooperativeKernel((void*)mega, dim3(grid_blocks), dim3(256), args, 0, stream);
    if (e != hipSuccess) fprintf(stderr, "cooperative launch failed: %s (grid %d)\n", hipGetErrorString(e), grid_blocks);
}
```

```cpp
#include <hip/hip_runtime.h>
#include <hip/hip_cooperative_groups.h>
#include <cstdio>
namespace cg = cooperative_groups;
#include <stdint.h>
#include <math.h>

typedef unsigned short bf16_t;
typedef __attribute__((ext_vector_type(8))) short bf16x8;
typedef __attribute__((ext_vector_type(4))) float f32x4;

constexpr int D = 1024;
constexpr int NB = 4, SEQ = 4096, NS = 128, LS = 8;
constexpr int TP = NB * SEQ;
constexpr int TS = NS * LS;
constexpr int T = TP + TS;
constexpr int PLE = 256;
constexpr int EVEN_IN = 3336, EVEN_LD = 3456, ODD_LD = 4096;
constexpr int CONV_CH = 1536;
constexpr int C_QKV = 0, C_GA = 1536, C_QB = 2048, C_KB = 2560, C_VB = 2688, C_GB = 2816, C_AB = 3328;
constexpr float ALPHA = 1.681792830507429f;
constexpr float EPS = 1e-6f;

typedef __bf16 hw_bf16x2 __attribute__((ext_vector_type(2)));
typedef float hw_f32x2 __attribute__((ext_vector_type(2)));
__device__ __forceinline__ bf16_t f2bf(float f) { return __builtin_bit_cast(unsigned short, (__bf16)f); }
__device__ __forceinline__ unsigned pack_bf16(float lo, float hi) { const hw_f32x2 v = {lo, hi}; return __builtin_bit_cast(unsigned, __builtin_convertvector(v, hw_bf16x2)); }
__device__ __forceinline__ float4 unpack4(uint2 v) {
    float4 r; r.x = __uint_as_float(v.x << 16); r.y = __uint_as_float(v.x & 0xffff0000u); r.z = __uint_as_float(v.y << 16); r.w = __uint_as_float(v.y & 0xffff0000u); return r;
}
__device__ __forceinline__ void unpack8(const uint4 v, float (&f)[8]) {
    f[0] = __uint_as_float(v.x << 16); f[1] = __uint_as_float(v.x & 0xffff0000u); f[2] = __uint_as_float(v.y << 16); f[3] = __uint_as_float(v.y & 0xffff0000u);
    f[4] = __uint_as_float(v.z << 16); f[5] = __uint_as_float(v.z & 0xffff0000u); f[6] = __uint_as_float(v.w << 16); f[7] = __uint_as_float(v.w & 0xffff0000u);
}
__device__ __forceinline__ float bf2f(bf16_t h) { return __uint_as_float(((unsigned)h) << 16); }
__device__ __forceinline__ float sigmoidf_(float x) { return 1.0f / (1.0f + __expf(-x)); }
__device__ __forceinline__ float siluf_(float x) { return x / (1.0f + __expf(-x)); }
__device__ __forceinline__ float softplusf_(float x) { return fmaxf(x, 0.0f) + log1pf(__expf(-fabsf(x))); }

__shared__ __attribute__((aligned(16))) char g_smem[65536];

#define GRID_X ((int)__builtin_amdgcn_readfirstlane((int)gridDim.x))
__device__ __forceinline__ int tid_opaque() { int t = threadIdx.x; asm volatile("" : "+v"(t)); return t; }

#define MEMFENCE() asm volatile("" ::: "memory")
#define LAUNDER(ptr) asm volatile("" : "+v"(ptr))

#define LAS __attribute__((address_space(3)))
__device__ __forceinline__ unsigned lds_base_addr() { return (unsigned)(size_t)(LAS char*)g_smem; }
__device__ __forceinline__ void glds16_asm(const void* gsrc, unsigned lds_dst) {
    unsigned keep;
    asm volatile("s_mov_b32 %0, m0\n\ts_mov_b32 m0, %2\n\ts_nop 0\n\tglobal_load_lds_dwordx4 %1, off\n\ts_mov_b32 m0, %0" : "=&s"(keep) : "v"(gsrc), "s"(lds_dst) : "memory");
}

struct Params {
    const float* x_prompt; const float* x_sample; const float* state_conv; const float* state_delta;
    const float* cache_k; const float* cache_v; const float* state_hgrn; const float* p_prompt; const float* p_sample;
    const float* w_in_even; const float* conv_w; const float* a_log; const float* dt_bias; const float* norm_a; const float* sinks;
    const float* w_out_even; const float* w_in_odd; const float* lb_raw; const float* norm_c; const float* w_out_odd;
    const float* ln_g; const float* ln_b; const float* w_ple_proj; const float* w_ple_gate;
    float* y_prompt; float* y_sample; float* conv_p; float* conv_s; float* delta_p; float* delta_s;
    float* wk_p; float* wk_s; float* wv_p; float* wv_s; float* hg_p; float* hg_s;
    bf16_t* wt_in_even; bf16_t* wt_out_even; bf16_t* wt_in_odd; bf16_t* wt_out_odd; bf16_t* wt_gate; bf16_t* wt_proj;
    bf16_t* p2; bf16_t* xb; bf16_t* qb; bf16_t* pb; bf16_t* proj; float* aux; float* rope;
    bf16_t* dnqkv; float* dngb; float* dno; bf16_t* qr; float* kr; bf16_t* krb; bf16_t* vT; bf16_t* kcat; bf16_t* vTcat; float* hgo; char* hgrec; char* hgv; char* dnrec; char* dnsp; float* dngl; unsigned* bar;
};

__device__ __forceinline__ int even_col_map(int n) {
    if (n < 2048) return n;
    if (n < 3328) return n + 8;
    if (n < 3336) return n - 3328 + 2048;
    return -1;
}
__device__ __forceinline__ void ph_transpose(const float* __restrict__ src, bf16_t* __restrict__ dst, int K, int Nsrc, int Ndst, int remap, char* smem, int bid, int nblk) {
    const int tidx = tid_opaque();
    float (*tile)[65] = (float (*)[65])smem;
    const int ntn = Ndst / 64, ntk = K / 64;
    for (int tIdx = bid; tIdx < ntn * ntk; tIdx += nblk) {
        const int tn = tIdx % ntn, tk = tIdx / ntn;
        const int n0 = tn * 64, k0 = tk * 64;
#pragma unroll
        for (int u = 0; u < 4; ++u) {
            const int e = tidx + 256 * u, kk = e >> 4, n4 = (e & 15) * 4;
            const int n = n0 + n4;
            const int sn = remap ? even_col_map(n) : n;
            float4 v = make_float4(0.f, 0.f, 0.f, 0.f);
            if (sn >= 0 && sn + 3 < Nsrc) v = *(const float4*)(src + (size_t)(k0 + kk) * Nsrc + sn);
            tile[kk][n4] = v.x; tile[kk][n4 + 1] = v.y; tile[kk][n4 + 2] = v.z; tile[kk][n4 + 3] = v.w;
        }
        __syncthreads();
#pragma unroll
        for (int u = 0; u < 2; ++u) {
            const int e = tidx + 256 * u, nn = e >> 3, kc = (e & 7) * 8;
            uint4 o;
            o.x = pack_bf16(tile[kc][nn], tile[kc + 1][nn]); o.y = pack_bf16(tile[kc + 2][nn], tile[kc + 3][nn]);
            o.z = pack_bf16(tile[kc + 4][nn], tile[kc + 5][nn]); o.w = pack_bf16(tile[kc + 6][nn], tile[kc + 7][nn]);
            *(uint4*)(dst + (size_t)(n0 + nn) * K + k0 + kc) = o;
        }
        __syncthreads();
    }
}

__device__ __forceinline__ void ph_weights(const Params& p, int layer, char* smem, int bid, int nblk) {
    const int j = layer >> 1;
    __syncthreads();
    if ((layer & 1) == 0) {
        ph_transpose(p.w_in_even + (size_t)j * D * EVEN_IN, p.wt_in_even + (size_t)j * EVEN_LD * D, D, EVEN_IN, EVEN_LD, 1, smem, bid, nblk);
        ph_transpose(p.w_out_even + (size_t)j * D * D, p.wt_out_even + (size_t)j * D * D, D, D, D, 0, smem, bid, nblk);
    } else {
        ph_transpose(p.w_in_odd + (size_t)j * D * ODD_LD, p.wt_in_odd + (size_t)j * ODD_LD * D, D, ODD_LD, ODD_LD, 0, smem, bid, nblk);
        ph_transpose(p.w_out_odd + (size_t)j * D * D, p.wt_out_odd + (size_t)j * D * D, D, D, D, 0, smem, bid, nblk);
    }
    ph_transpose(p.w_ple_gate + (size_t)layer * D * D, p.wt_gate + (size_t)layer * D * D, D, D, D, 0, smem, bid, nblk);
    ph_transpose(p.w_ple_proj + (size_t)layer * PLE * D, p.wt_proj + (size_t)layer * D * PLE, PLE, D, D, 0, smem, bid, nblk);
}

__device__ __forceinline__ void ph_prep_act(const Params& p) {
    const int tidx = tid_opaque();
    const size_t gtid = (size_t)blockIdx.x * 256 + tidx, gsz = (size_t)GRID_X * 256;
    for (size_t i0 = gtid; i0 < (size_t)T * D / 4; i0 += 4 * gsz) {
        float4 v[4]; size_t e[4];
#pragma unroll
        for (int u = 0; u < 4; ++u) {
            size_t i = i0 + u * gsz; i = i < (size_t)T * D / 4 ? i : (size_t)T * D / 4 - 1;
            e[u] = i * 4;
            const float* src = (e[u] < (size_t)TP * D) ? p.x_prompt + e[u] : p.x_sample + (e[u] - (size_t)TP * D);
            v[u] = *(const float4*)src;
        }
        __builtin_amdgcn_sched_barrier(0);
#pragma unroll
        for (int u = 0; u < 4; ++u) {
            ushort4 o; o.x = f2bf(v[u].x); o.y = f2bf(v[u].y); o.z = f2bf(v[u].z); o.w = f2bf(v[u].w);
            *(ushort4*)(p.xb + e[u]) = o;
        }
    }
    for (size_t i = gtid; i < (size_t)(SEQ + LS) * 8; i += gsz) {
        const int pi = (int)(i / 8), fi = (int)(i % 8);
        const float pos = (pi < SEQ) ? (float)pi : (float)(8192 + pi - SEQ);
        const float inv = powf(500000.0f, -(float)(2 * fi) / 16.0f);
        const float ang = pos * inv;
        float s, c; sincosf(ang, &s, &c);
        p.rope[(size_t)pi * 16 + fi] = c; p.rope[(size_t)pi * 16 + 8 + fi] = s;
    }
}

template <int TS>
__device__ __forceinline__ void gemm_mainloop(f32x4 (&acc)[TS / 32][TS / 32], const bf16_t* __restrict__ A, int lda, const bf16_t* __restrict__ Bt, int ldb,
                                              int K, int row0, int col0, char* smem) {
    constexpr int NI = TS / 64, F = TS / 32, WT = TS / 2, OPB = TS * 64, SS = 2 * OPB;
    const int tidx = tid_opaque();
    const int lane = tidx & 63, wid = tidx >> 6;
    const int wr = wid >> 1, wc = wid & 1;
    const int nk = K / 32;
    const int srow = wid * (16 * NI) + (lane >> 2), schk = (lane & 3) ^ (2 * (lane >> 5));
    const bf16_t* gA = A + (size_t)(row0 + srow) * lda + schk * 8;
    const bf16_t* gB = Bt + (size_t)(col0 + srow) * ldb + schk * 8;
    const unsigned lbase = __builtin_amdgcn_readfirstlane(lds_base_addr() + wid * (NI * 1024));
#define GSTAGE(stage, kt_) { const unsigned d_ = lbase + (stage) * SS; const int k0_ = (kt_) * 32; \
        glds16_asm(gA + k0_, d_); if (NI == 2) glds16_asm(gA + (size_t)16 * lda + k0_, d_ + 1024); \
        glds16_asm(gB + k0_, d_ + OPB); if (NI == 2) glds16_asm(gB + (size_t)16 * ldb + k0_, d_ + OPB + 1024); }
    const int fr = lane & 15, fq = lane >> 4;
    const int foff = fr * 64 + ((fq ^ (2 * (fr >> 3))) << 4);
    __syncthreads();
    GSTAGE(0, 0);
    if (nk > 1) GSTAGE(1, 1);
    if (nk > 2) GSTAGE(2, 2);
#pragma unroll 1
    for (int kt = 0; kt < nk; ++kt) {
        if (NI == 2) {
            if (kt + 2 < nk) asm volatile("s_waitcnt vmcnt(8)" ::: "memory");
            else if (kt + 1 < nk) asm volatile("s_waitcnt vmcnt(4)" ::: "memory");
            else asm volatile("s_waitcnt vmcnt(0)" ::: "memory");
        } else {
            if (kt + 2 < nk) asm volatile("s_waitcnt vmcnt(4)" ::: "memory");
            else if (kt + 1 < nk) asm volatile("s_waitcnt vmcnt(2)" ::: "memory");
            else asm volatile("s_waitcnt vmcnt(0)" ::: "memory");
        }
        __builtin_amdgcn_s_barrier();
        MEMFENCE();
        if (kt + 3 < nk) GSTAGE((kt + 3) & 3, kt + 3);
        const char* sA = smem + (kt & 3) * SS + foff;
        const char* sB = sA + OPB;
        bf16x8 af[F], bfr[F];
#pragma unroll
        for (int m = 0; m < F; ++m) af[m] = *(const bf16x8*)(sA + (wr * WT + m * 16) * 64);
#pragma unroll
        for (int n = 0; n < F; ++n) bfr[n] = *(const bf16x8*)(sB + (wc * WT + n * 16) * 64);
#pragma unroll
        for (int m = 0; m < F; ++m)
#pragma unroll
            for (int n = 0; n < F; ++n)
                acc[m][n] = __builtin_amdgcn_mfma_f32_16x16x32_bf16(bfr[n], af[m], acc[m][n], 0, 0, 0);
    }
    asm volatile("s_waitcnt lgkmcnt(0)" ::: "memory");
    __syncthreads();
#undef GSTAGE
}

struct TileCtx { int x, lb, nlb; };
__device__ __forceinline__ bool gemm_next(const TileCtx& tc, int it, int ntn, int& pm, int& pn, int& quarter) {
    const int total = (tc.x < 0 ? 136 : 17) * ntn;
    const int full_rounds = total / tc.nlb, nfull = full_rounds * tc.nlb;
    int i;
    if (it < full_rounds) { i = tc.lb + it * tc.nlb; quarter = -1; }
    else {
        const int qi = tc.lb + (it - full_rounds) * tc.nlb;
        if (qi >= 4 * (total - nfull)) return false;
        i = nfull + (qi >> 2); quarter = qi & 3;
    }
    if (tc.x < 0) { pm = i / ntn; pn = i % ntn; return true; }
    const int g = i / (17 * 8);
    const int w = (ntn - g * 8) < 8 ? (ntn - g * 8) : 8;
    const int r = i - g * 17 * 8;
    pm = tc.x * 17 + r / w; pn = g * 8 + r % w;
    return true;
}

template <int EPI>
__device__ __forceinline__ void epi_load(const Params& p, int row, int col, uint4& ia, uint4& ib) {
    if (EPI == 2) ia = *(const uint4*)(p.xb + (size_t)row * D + col);
    else if (EPI == 4) { ia = *(const uint4*)(p.qb + (size_t)row * D + col); ib = *(const uint4*)(p.p2 + (size_t)row * D + col); }
}
template <int EPI>
__device__ __forceinline__ void epi_finish(const Params& p, int layer, int row, int col, const uint4 sv, const uint4 ia, const uint4 ib) {
    if (EPI == 0) *(uint4*)(p.proj + (size_t)row * EVEN_LD + col) = sv;
    else if (EPI == 1) *(uint4*)(p.proj + (size_t)row * ODD_LD + col) = sv;
    else if (EPI == 3) *(uint4*)(p.p2 + (size_t)row * D + col) = sv;
    else {
        const float4 a0 = unpack4(make_uint2(sv.x, sv.y)), a1 = unpack4(make_uint2(sv.z, sv.w));
        const float4 x0 = unpack4(make_uint2(ia.x, ia.y)), x1 = unpack4(make_uint2(ia.z, ia.w));
        if (EPI == 2) {
            uint4 o;
            o.x = pack_bf16(ALPHA * x0.x + a0.x, ALPHA * x0.y + a0.y); o.y = pack_bf16(ALPHA * x0.z + a0.z, ALPHA * x0.w + a0.w);
            o.z = pack_bf16(ALPHA * x1.x + a1.x, ALPHA * x1.y + a1.y); o.w = pack_bf16(ALPHA * x1.z + a1.z, ALPHA * x1.w + a1.w);
            *(uint4*)(p.xb + (size_t)row * D + col) = o;
        } else {
            const float4 p0 = unpack4(make_uint2(ib.x, ib.y)), p1 = unpack4(make_uint2(ib.z, ib.w));
            float4 o0, o1;
            o0.x = x0.x + sigmoidf_(a0.x) * p0.x; o0.y = x0.y + sigmoidf_(a0.y) * p0.y; o0.z = x0.z + sigmoidf_(a0.z) * p0.z; o0.w = x0.w + sigmoidf_(a0.w) * p0.w;
            o1.x = x1.x + sigmoidf_(a1.x) * p1.x; o1.y = x1.y + sigmoidf_(a1.y) * p1.y; o1.z = x1.z + sigmoidf_(a1.z) * p1.z; o1.w = x1.w + sigmoidf_(a1.w) * p1.w;
            if (layer == 3) {
                float* yp = (row < TP) ? p.y_prompt + (size_t)row * D + col : p.y_sample + (size_t)(row - TP) * D + col;
                *(float4*)yp = o0; *(float4*)(yp + 4) = o1;
            } else {
                uint4 ob; ob.x = pack_bf16(o0.x, o0.y); ob.y = pack_bf16(o0.z, o0.w); ob.z = pack_bf16(o1.x, o1.y); ob.w = pack_bf16(o1.z, o1.w);
                *(uint4*)(p.xb + (size_t)row * D + col) = ob;
            }
        }
    }
}
template <int EPI>
__device__ __forceinline__ void epi_store(const Params& p, int layer, int row, int col, const uint4 sv) {
    uint4 ia = make_uint4(0u, 0u, 0u, 0u), ib = ia;
    epi_load<EPI>(p, row, col, ia, ib);
    epi_finish<EPI>(p, layer, row, col, sv, ia, ib);
}

template <int EPI, int TS>
__device__ __forceinline__ void gemm_tile_body(const Params& p, const bf16_t* __restrict__ A, const bf16_t* __restrict__ Bt, int K, int layer, int row0, int col0, char* smem) {
    constexpr int F = TS / 32, WT = TS / 2, ELD = TS * 2 + 16, CH = TS / 8, RPP = 256 / CH, NP = TS / RPP;
    const int tidx = tid_opaque();
    const int lane = tidx & 63, wid = tidx >> 6, wr = wid >> 1, wc = wid & 1;
    f32x4 acc[F][F];
#pragma unroll
    for (int m = 0; m < F; ++m)
#pragma unroll
        for (int n = 0; n < F; ++n) acc[m][n] = (f32x4){0.f, 0.f, 0.f, 0.f};
    gemm_mainloop<TS>(acc, A, K, Bt, K, K, row0, col0, smem);
    if (EPI == 0) {
        const int j = layer >> 1;
        if ((col0 & ~127) == C_AB || col0 < CONV_CH) {
#pragma unroll
            for (int m = 0; m < F; ++m) {
                const int row = row0 + wr * WT + m * 16 + (lane & 15);
#pragma unroll
                for (int n = 0; n < F; ++n) {
                    const int col = col0 + wc * WT + n * 16 + 4 * (lane >> 4);
                    const f32x4 v = acc[m][n];
                    if (col >= C_AB && col < C_AB + 8) *(float4*)(p.aux + (size_t)row * 8 + (col - C_AB)) = make_float4(v[0], v[1], v[2], v[3]);
                    if (col < CONV_CH) {
                        if (row < TP) {
                            const int b = row / SEQ, sq = row % SEQ;
                            if (sq >= SEQ - 3) *(float4*)(p.conv_p + (((size_t)j * NB + b) * 3 + (sq - (SEQ - 3))) * CONV_CH + col) = make_float4(v[0], v[1], v[2], v[3]);
                        } else {
                            const int r2 = row - TP, nn = r2 / LS, sq = r2 % LS;
                            if (sq >= LS - 3) *(float4*)(p.conv_s + (((size_t)j * NS + nn) * 3 + (sq - (LS - 3))) * CONV_CH + col) = make_float4(v[0], v[1], v[2], v[3]);
                        }
                    }
                }
            }
        }
    }
#pragma unroll
    for (int m = 0; m < F; ++m) {
        const int r = wr * WT + m * 16 + (lane & 15);
#pragma unroll
        for (int n = 0; n < F; ++n) {
            const int c = wc * WT + n * 16 + 4 * (lane >> 4);
            uint2 o; o.x = pack_bf16(acc[m][n][0], acc[m][n][1]); o.y = pack_bf16(acc[m][n][2], acc[m][n][3]);
            *(uint2*)(smem + r * ELD + c * 2) = o;
        }
    }
    __syncthreads();
    const int chunk = tidx & (CH - 1), rbase = tidx / CH;
#pragma unroll
    for (int i = 0; i < NP; ++i) {
        const int rl = rbase + RPP * i, row = row0 + rl, col = col0 + chunk * 8;
        const uint4 sv = *(const uint4*)(smem + rl * ELD + chunk * 16);
        epi_store<EPI>(p, layer, row, col, sv);
    }
}

__device__ __forceinline__ void gemm_mainloop_256(f32x4 (&acc)[8][4], const bf16_t* __restrict__ A, int lda, const bf16_t* __restrict__ Bt, int ldb,
                                                  int K, int row0, int col0, char* smem) {
    const int tidx = tid_opaque();
    const int lane = tidx & 63, wid = tidx >> 6;
    const int wr = wid >> 1, wc = wid & 1;
    const int nk = K / 32;
    const int schk = (lane & 3) ^ (2 * (lane >> 5));
    const bf16_t* gA = A + (size_t)(row0 + wid * 64 + (lane >> 2)) * lda + schk * 8;
    const bf16_t* gB = Bt + (size_t)(col0 + wid * 32 + (lane >> 2)) * ldb + schk * 8;
    const unsigned lA = __builtin_amdgcn_readfirstlane(lds_base_addr() + wid * 4096);
    const unsigned lB = __builtin_amdgcn_readfirstlane(lds_base_addr() + 16384 + wid * 2048);
#define GSTAGE2(stage, kt_) { const int k0_ = (kt_) * 32; const unsigned so_ = (stage) * 24576; \
        glds16_asm(gA + k0_, lA + so_); glds16_asm(gA + (size_t)16 * lda + k0_, lA + so_ + 1024); glds16_asm(gA + (size_t)32 * lda + k0_, lA + so_ + 2048); glds16_asm(gA + (size_t)48 * lda + k0_, lA + so_ + 3072); \
        glds16_asm(gB + k0_, lB + so_); glds16_asm(gB + (size_t)16 * ldb + k0_, lB + so_ + 1024); }
    const int fr = lane & 15, fq = lane >> 4;
    const int foff = fr * 64 + ((fq ^ (2 * (fr >> 3))) << 4);
    __syncthreads();
    GSTAGE2(0, 0);
#pragma unroll 1
    for (int kt = 0; kt < nk; ++kt) {
        asm volatile("s_waitcnt vmcnt(0)" ::: "memory");
        __builtin_amdgcn_s_barrier();
        MEMFENCE();
        if (kt + 1 < nk) GSTAGE2((kt + 1) & 1, kt + 1);
        const char* sA = smem + (kt & 1) * 24576 + foff;
        const char* sB = sA + 16384;
        bf16x8 bfr[4];
#pragma unroll
        for (int n = 0; n < 4; ++n) bfr[n] = *(const bf16x8*)(sB + (wc * 64 + n * 16) * 64);
#pragma unroll
        for (int m = 0; m < 8; ++m) {
            const bf16x8 af = *(const bf16x8*)(sA + (wr * 128 + m * 16) * 64);
#pragma unroll
            for (int n = 0; n < 4; ++n)
                acc[m][n] = __builtin_amdgcn_mfma_f32_16x16x32_bf16(bfr[n], af, acc[m][n], 0, 0, 0);
        }
    }
    asm volatile("s_waitcnt lgkmcnt(0)" ::: "memory");
    __syncthreads();
#undef GSTAGE2
}

template <int EPI>
__device__ __forceinline__ void gemm_tile_256(const Params& p, const bf16_t* __restrict__ A, const bf16_t* __restrict__ Bt, int K, int layer, int row0, int col0, char* smem) {
    constexpr int ELD = 272;
    const int tidx = tid_opaque();
    const int lane = tidx & 63, wid = tidx >> 6, wr = wid >> 1, wc = wid & 1;
    f32x4 acc[8][4];
#pragma unroll
    for (int m = 0; m < 8; ++m)
#pragma unroll
        for (int n = 0; n < 4; ++n) acc[m][n] = (f32x4){0.f, 0.f, 0.f, 0.f};
    gemm_mainloop_256(acc, A, K, Bt, K, K, row0, col0, smem);
    if (EPI == 0) {
        const int j = layer >> 1;
        if (col0 == C_AB || col0 < CONV_CH) {
#pragma unroll
            for (int m = 0; m < 8; ++m) {
                const int row = row0 + wr * 128 + m * 16 + (lane & 15);
#pragma unroll
                for (int n = 0; n < 4; ++n) {
                    const int col = col0 + wc * 64 + n * 16 + 4 * (lane >> 4);
                    const f32x4 v = acc[m][n];
                    if (col >= C_AB && col < C_AB + 8) *(float4*)(p.aux + (size_t)row * 8 + (col - C_AB)) = make_float4(v[0], v[1], v[2], v[3]);
                    if (col < CONV_CH) {
                        if (row < TP) {
                            const int b = row / SEQ, sq = row % SEQ;
                            if (sq >= SEQ - 3) *(float4*)(p.conv_p + (((size_t)j * NB + b) * 3 + (sq - (SEQ - 3))) * CONV_CH + col) = make_float4(v[0], v[1], v[2], v[3]);
                        } else {
                            const int r2 = row - TP, nn = r2 / LS, sq = r2 % LS;
                            if (sq >= LS - 3) *(float4*)(p.conv_s + (((size_t)j * NS + nn) * 3 + (sq - (LS - 3))) * CONV_CH + col) = make_float4(v[0], v[1], v[2], v[3]);
                        }
                    }
                }
            }
        }
    }
#pragma unroll
    for (int hf = 0; hf < 2; ++hf) {
        if (wr == hf) {
#pragma unroll
            for (int m = 0; m < 8; ++m) {
                const int r = m * 16 + (lane & 15);
#pragma unroll
                for (int n = 0; n < 4; ++n) {
                    const int c = wc * 64 + n * 16 + 4 * (lane >> 4);
                    uint2 o; o.x = pack_bf16(acc[m][n][0], acc[m][n][1]); o.y = pack_bf16(acc[m][n][2], acc[m][n][3]);
                    *(uint2*)(smem + r * ELD + c * 2) = o;
                }
            }
        }
        __syncthreads();
        const int chunk = tidx & 15, rbase = tidx >> 4;
#pragma unroll
        for (int i = 0; i < 8; ++i) {
            const int rl = rbase + 16 * i, row = row0 + hf * 128 + rl, col = col0 + chunk * 8;
            const uint4 sv = *(const uint4*)(smem + rl * ELD + chunk * 16);
            epi_store<EPI>(p, layer, row, col, sv);
        }
        __syncthreads();
    }
}

__device__ __forceinline__ void gemm_mainloop_192(f32x4 (&acc)[8][6], const bf16_t* __restrict__ A, int lda, const bf16_t* __restrict__ Bt, int ldb,
                                                  int K, int row0, int col0, char* smem) {
    const int tidx = tid_opaque();
    const int lane = tidx & 63, wid = tidx >> 6;
    const int wr = wid >> 1, wc = wid & 1;
    const int nk = K / 32;
    const int schk = (lane & 3) ^ (2 * (lane >> 5));
    const bf16_t* gA = A + (size_t)(row0 + wid * 64 + (lane >> 2)) * lda + schk * 8;
    const bf16_t* gB = Bt + (size_t)(col0 + wid * 48 + (lane >> 2)) * ldb + schk * 8;
    const unsigned lA = __builtin_amdgcn_readfirstlane(lds_base_addr() + wid * 4096);
    const unsigned lB = __builtin_amdgcn_readfirstlane(lds_base_addr() + 16384 + wid * 3072);
#define GSTAGE3(stage, kt_) { const int k0_ = (kt_) * 32; const unsigned so_ = (stage) * 28672; \
        glds16_asm(gA + k0_, lA + so_); glds16_asm(gA + (size_t)16 * lda + k0_, lA + so_ + 1024); glds16_asm(gA + (size_t)32 * lda + k0_, lA + so_ + 2048); glds16_asm(gA + (size_t)48 * lda + k0_, lA + so_ + 3072); \
        glds16_asm(gB + k0_, lB + so_); glds16_asm(gB + (size_t)16 * ldb + k0_, lB + so_ + 1024); glds16_asm(gB + (size_t)32 * ldb + k0_, lB + so_ + 2048); }
    const int fr = lane & 15, fq = lane >> 4;
    const int foff = fr * 64 + ((fq ^ (2 * (fr >> 3))) << 4);
    __syncthreads();
    GSTAGE3(0, 0);
#pragma unroll 1
    for (int kt = 0; kt < nk; ++kt) {
        asm volatile("s_waitcnt vmcnt(0)" ::: "memory");
        __builtin_amdgcn_s_barrier();
        MEMFENCE();
        if (kt + 1 < nk) GSTAGE3((kt + 1) & 1, kt + 1);
        const char* sA = smem + (kt & 1) * 28672 + foff;
        const char* sB = sA + 16384;
        bf16x8 bfr[6];
#pragma unroll
        for (int n = 0; n < 6; ++n) bfr[n] = *(const bf16x8*)(sB + (wc * 96 + n * 16) * 64);
#pragma unroll
        for (int m = 0; m < 8; ++m) {
            const bf16x8 af = *(const bf16x8*)(sA + (wr * 128 + m * 16) * 64);
#pragma unroll
            for (int n = 0; n < 6; ++n)
                acc[m][n] = __builtin_amdgcn_mfma_f32_16x16x32_bf16(bfr[n], af, acc[m][n], 0, 0, 0);
        }
    }
    asm volatile("s_waitcnt lgkmcnt(0)" ::: "memory");
    __syncthreads();
#undef GSTAGE3
}

template <int EPI>
__device__ __forceinline__ void gemm_tile_192(const Params& p, const bf16_t* __restrict__ A, const bf16_t* __restrict__ Bt, int K, int layer, int row0, int col0, char* smem) {
    constexpr int ELD = 400;
    const int tidx = tid_opaque();
    const int lane = tidx & 63, wid = tidx >> 6, wr = wid >> 1, wc = wid & 1;
    f32x4 acc[8][6];
#pragma unroll
    for (int m = 0; m < 8; ++m)
#pragma unroll
        for (int n = 0; n < 6; ++n) acc[m][n] = (f32x4){0.f, 0.f, 0.f, 0.f};
    gemm_mainloop_192(acc, A, K, Bt, K, K, row0, col0, smem);
    if (EPI == 0) {
        const int j = layer >> 1;
        if ((col0 <= C_AB && C_AB < col0 + 192) || col0 < CONV_CH) {
#pragma unroll
            for (int m = 0; m < 8; ++m) {
                const int row = row0 + wr * 128 + m * 16 + (lane & 15);
#pragma unroll
                for (int n = 0; n < 6; ++n) {
                    const int col = col0 + wc * 96 + n * 16 + 4 * (lane >> 4);
                    const f32x4 v = acc[m][n];
                    if (col >= C_AB && col < C_AB + 8) *(float4*)(p.aux + (size_t)row * 8 + (col - C_AB)) = make_float4(v[0], v[1], v[2], v[3]);
                    if (col < CONV_CH) {
                        if (row < TP) {
                            const int b = row / SEQ, sq = row % SEQ;
                            if (sq >= SEQ - 3) *(float4*)(p.conv_p + (((size_t)j * NB + b) * 3 + (sq - (SEQ - 3))) * CONV_CH + col) = make_float4(v[0], v[1], v[2], v[3]);
                        } else {
                            const int r2 = row - TP, nn = r2 / LS, sq = r2 % LS;
                            if (sq >= LS - 3) *(float4*)(p.conv_s + (((size_t)j * NS + nn) * 3 + (sq - (LS - 3))) * CONV_CH + col) = make_float4(v[0], v[1], v[2], v[3]);
                        }
                    }
                }
            }
        }
    }
#pragma unroll
    for (int hf = 0; hf < 2; ++hf) {
        if (wr == hf) {
#pragma unroll
            for (int m = 0; m < 8; ++m) {
                const int r = m * 16 + (lane & 15);
#pragma unroll
                for (int n = 0; n < 6; ++n) {
                    const int c = wc * 96 + n * 16 + 4 * (lane >> 4);
                    uint2 o; o.x = pack_bf16(acc[m][n][0], acc[m][n][1]); o.y = pack_bf16(acc[m][n][2], acc[m][n][3]);
                    *(uint2*)(smem + r * ELD + c * 2) = o;
                }
            }
        }
        __syncthreads();
#pragma unroll
        for (int i = 0; i < 12; ++i) {
            const int seg = tidx + 256 * i, rl = seg / 24, chunk = seg - rl * 24;
            const int row = row0 + hf * 128 + rl, col = col0 + chunk * 8;
            const uint4 sv = *(const uint4*)(smem + rl * ELD + chunk * 16);
            if (EPI == 0) *(uint4*)(p.proj + (size_t)row * EVEN_LD + col) = sv;
            else *(uint4*)(p.proj + (size_t)row * ODD_LD + col) = sv;
        }
        __syncthreads();
    }
}

template <int EPI>
__device__ __forceinline__ void ph_gemm_in192(const Params& p, const bf16_t* __restrict__ A, const bf16_t* __restrict__ Bt, int N, int K, int layer, char* smem) {
    const int G = GRID_X;
    int ntn = N / 192;
    if (ntn * 192 != N) ntn -= 1;
    const int nt = 68 * ntn, c0 = ntn * 192;
    for (int i = blockIdx.x; i < nt; i += G)
        gemm_tile_192<EPI>(p, A, Bt, K, layer, (i / ntn) * 256, (i % ntn) * 192, smem);
    const int ncol = (N - c0) / 128, nnar = 68 * ncol, first = nt % G, ns = G - first;
    if ((int)blockIdx.x >= first)
        for (int q = (int)blockIdx.x - first; q < nnar; q += ns)
            gemm_tile_256<EPI>(p, A, Bt, K, layer, (q / ncol) * 256, c0 + (q % ncol) * 128, smem);
}

template <int EPI>
__device__ __forceinline__ void ph_gemm_in(const Params& p, const bf16_t* __restrict__ A, const bf16_t* __restrict__ Bt, int N, int K, int layer, char* smem) {
    const int ntn = N / 128, nt = 68 * ntn, G = GRID_X;
    const int full = nt / G;
    for (int it = 0; it < full; ++it) {
        const int i = blockIdx.x + it * G;
        gemm_tile_256<EPI>(p, A, Bt, K, layer, (i / ntn) * 256, (i % ntn) * 128, smem);
    }
    const int rem = nt - full * G;
    for (int q = blockIdx.x; q < 2 * rem; q += G) {
        const int i = full * G + (q >> 1);
        gemm_tile_body<EPI, 128>(p, A, Bt, K, layer, (i / ntn) * 256 + (q & 1) * 128, (i % ntn) * 128, smem);
    }
}

__device__ __forceinline__ void gemm_mainloop_272(f32x4 (&acc)[9][4], const bf16_t* __restrict__ A, int lda, const bf16_t* __restrict__ Bt, int ldb,
                                                  int K, int row0, int col0, char* smem) {
    const int tidx = tid_opaque();
    const int lane = tidx & 63, wid = __builtin_amdgcn_readfirstlane(tidx >> 6);
    const int wr = wid >> 1, wc = wid & 1;
    const int nk = K / 32;
    const int schk = (lane & 3) ^ (2 * (lane >> 5));
    const bf16_t* gA = A + (size_t)(row0 + wid * 64 + (lane >> 2)) * lda + schk * 8;
    const bf16_t* gB = Bt + (size_t)(col0 + wid * 32 + (lane >> 2)) * ldb + schk * 8;
    const unsigned lA = __builtin_amdgcn_readfirstlane(lds_base_addr() + wid * 4096);
    const unsigned lB = __builtin_amdgcn_readfirstlane(lds_base_addr() + 17408 + wid * 2048);
#define GSTAGE4(stage, kt_) { const int k0_ = (kt_) * 32; const unsigned so_ = (stage) * 25600; \
        glds16_asm(gA + k0_, lA + so_); glds16_asm(gA + (size_t)16 * lda + k0_, lA + so_ + 1024); glds16_asm(gA + (size_t)32 * lda + k0_, lA + so_ + 2048); glds16_asm(gA + (size_t)48 * lda + k0_, lA + so_ + 3072); \
        if (wid == 0) glds16_asm(gA + (size_t)256 * lda + k0_, lA + so_ + 16384); \
        glds16_asm(gB + k0_, lB + so_); glds16_asm(gB + (size_t)16 * ldb + k0_, lB + so_ + 1024); }
    const int fr = lane & 15, fq = lane >> 4;
    const int foff = fr * 64 + ((fq ^ (2 * (fr >> 3))) << 4);
    __syncthreads();
    GSTAGE4(0, 0);
#pragma unroll 1
    for (int kt = 0; kt < nk; ++kt) {
        asm volatile("s_waitcnt vmcnt(0)" ::: "memory");
        __builtin_amdgcn_s_barrier();
        MEMFENCE();
        if (kt + 1 < nk) GSTAGE4((kt + 1) & 1, kt + 1);
        const char* sA = smem + (kt & 1) * 25600 + foff;
        const char* sB = sA + 17408;
        bf16x8 bfr[4];
#pragma unroll
        for (int n = 0; n < 4; ++n) bfr[n] = *(const bf16x8*)(sB + (wc * 64 + n * 16) * 64);
#pragma unroll
        for (int m = 0; m < 9; ++m) {
            const bf16x8 af = *(const bf16x8*)(sA + (wr * 144 + m * 16) * 64);
#pragma unroll
            for (int n = 0; n < 4; ++n)
                acc[m][n] = __builtin_amdgcn_mfma_f32_16x16x32_bf16(bfr[n], af, acc[m][n], 0, 0, 0);
        }
    }
    asm volatile("s_waitcnt lgkmcnt(0)" ::: "memory");
    __syncthreads();
#undef GSTAGE4
}

template <int EPI>
__device__ __forceinline__ void gemm_tile_272(const Params& p, const bf16_t* __restrict__ A, const bf16_t* __restrict__ Bt, int K, int layer, int row0, int col0, char* smem) {
    constexpr int ELD = 272;
    const int tidx = tid_opaque();
    const int lane = tidx & 63, wid = tidx >> 6, wr = wid >> 1, wc = wid & 1;
    f32x4 acc[9][4];
#pragma unroll
    for (int m = 0; m < 9; ++m)
#pragma unroll
        for (int n = 0; n < 4; ++n) acc[m][n] = (f32x4){0.f, 0.f, 0.f, 0.f};
    gemm_mainloop_272(acc, A, K, Bt, K, K, row0, col0, smem);
#pragma unroll
    for (int ps = 0; ps < 2; ++ps) {
        if (wr == ps) {
#pragma unroll
            for (int m = 0; m < 9; ++m) {
                if (ps == 1 && m == 8) continue;
                const int r = m * 16 + (lane & 15);
#pragma unroll
                for (int n = 0; n < 4; ++n) {
                    const int c = wc * 64 + n * 16 + 4 * (lane >> 4);
                    uint2 o; o.x = pack_bf16(acc[m][n][0], acc[m][n][1]); o.y = pack_bf16(acc[m][n][2], acc[m][n][3]);
                    *(uint2*)(smem + r * ELD + c * 2) = o;
                }
            }
        }
        __syncthreads();
        const int chunk = tidx & 15, rbase = tidx >> 4;
        uint4 ia[9], ib[9];
#pragma unroll
        for (int i = 0; i < 9; ++i) {
            ia[i] = make_uint4(0u, 0u, 0u, 0u); ib[i] = ia[i];
            if (ps == 1 && i == 8) continue;
            epi_load<EPI>(p, row0 + ps * 144 + rbase + 16 * i, col0 + chunk * 8, ia[i], ib[i]);
        }
        __builtin_amdgcn_sched_barrier(0);
#pragma unroll
        for (int i = 0; i < 9; ++i) {
            if (ps == 1 && i == 8) continue;
            const int rl = rbase + 16 * i, row = row0 + ps * 144 + rl, col = col0 + chunk * 8;
            const uint4 sv = *(const uint4*)(smem + rl * ELD + chunk * 16);
            epi_finish<EPI>(p, layer, row, col, sv, ia[i], ib[i]);
        }
        __syncthreads();
    }
}

template <int EPI>
__device__ __forceinline__ void ph_gemm(const Params& p, const TileCtx& tc, const bf16_t* __restrict__ A, const bf16_t* __restrict__ Bt, int N, int K, int layer, char* smem);
template <int EPI>
__device__ __forceinline__ void ph_gemm_n1024(const Params& p, const TileCtx& tc, const bf16_t* __restrict__ A, const bf16_t* __restrict__ Bt, int K, int layer, char* smem) {
    if (tc.x >= 0 && tc.nlb == 64 && GRID_X == 512) {
        gemm_tile_272<EPI>(p, A, Bt, K, layer, tc.x * 2176 + (tc.lb >> 3) * 272, (tc.lb & 7) * 128, smem);
    } else ph_gemm<EPI>(p, tc, A, Bt, 1024, K, layer, smem);
}

template <int EPI>
__device__ __forceinline__ void ph_gemm(const Params& p, const TileCtx& tc, const bf16_t* __restrict__ A, const bf16_t* __restrict__ Bt, int N, int K, int layer, char* smem) {
    const int ntn = N / 128;
    for (int it = 0;; ++it) {
        int pm, pn, quarter;
        if (!gemm_next(tc, it, ntn, pm, pn, quarter)) break;
        if (quarter < 0) gemm_tile_body<EPI, 128>(p, A, Bt, K, layer, pm * 128, pn * 128, smem);
        else gemm_tile_body<EPI, 64>(p, A, Bt, K, layer, pm * 128 + (quarter >> 1) * 64, pn * 128 + (quarter & 1) * 64, smem);
    }
}

__device__ __forceinline__ void ln_row(const Params& p, const float4 (&gv)[4], const float4 (&bv)[4], int row, int lane, const uint4 x0, const uint4 x1) {
    float v[2][8];
    unpack8(x0, v[0]); unpack8(x1, v[1]);
    float s = 0.f;
#pragma unroll
    for (int u = 0; u < 2; ++u)
#pragma unroll
        for (int i = 0; i < 8; ++i) s += v[u][i];
    for (int o = 32; o > 0; o >>= 1) s += __shfl_xor(s, o);
    const float mu = s * (1.0f / D);
    float q = 0.f;
#pragma unroll
    for (int u = 0; u < 2; ++u)
#pragma unroll
        for (int i = 0; i < 8; ++i) { v[u][i] -= mu; q += v[u][i] * v[u][i]; }
    for (int o = 32; o > 0; o >>= 1) q += __shfl_xor(q, o);
    const float rs = rsqrtf(q * (1.0f / D) + EPS);
#pragma unroll
    for (int u = 0; u < 2; ++u) {
        const float4 g0 = gv[2 * u], g1 = gv[2 * u + 1], b0 = bv[2 * u], b1 = bv[2 * u + 1];
        uint4 ob;
        ob.x = pack_bf16(v[u][0] * rs * g0.x + b0.x, v[u][1] * rs * g0.y + b0.y); ob.y = pack_bf16(v[u][2] * rs * g0.z + b0.z, v[u][3] * rs * g0.w + b0.w);
        ob.z = pack_bf16(v[u][4] * rs * g1.x + b1.x, v[u][5] * rs * g1.y + b1.y); ob.w = pack_bf16(v[u][6] * rs * g1.z + b1.z, v[u][7] * rs * g1.w + b1.w);
        *(uint4*)(p.qb + (size_t)row * D + lane * 8 + u * 512) = ob;
    }
}
__device__ __forceinline__ void ph_layernorm(const Params& p, int layer, char* smem) {
    const int tidx = tid_opaque();
    const float* g = p.ln_g + (size_t)layer * D; const float* b = p.ln_b + (size_t)layer * D;
    const int lane = tidx & 63;
    const int wave = blockIdx.x * 4 + (tidx >> 6), nw = GRID_X * 4;
    float4 gv[4], bv[4];
#pragma unroll
    for (int u = 0; u < 2; ++u) {
        gv[2 * u] = *(const float4*)(g + lane * 8 + u * 512); gv[2 * u + 1] = *(const float4*)(g + lane * 8 + u * 512 + 4);
        bv[2 * u] = *(const float4*)(b + lane * 8 + u * 512); bv[2 * u + 1] = *(const float4*)(b + lane * 8 + u * 512 + 4);
    }
    for (int r2 = wave; r2 < T / 2; r2 += nw) {
        const int row = 2 * r2;
        const bf16_t* xr = p.xb + (size_t)row * D + lane * 8;
        const uint4 a0 = *(const uint4*)xr, a1 = *(const uint4*)(xr + 512), c0 = *(const uint4*)(xr + D), c1 = *(const uint4*)(xr + D + 512);
        __builtin_amdgcn_sched_barrier(0);
        ln_row(p, gv, bv, row, lane, a0, a1);
        ln_row(p, gv, bv, row + 1, lane, c0, c1);
    }
}

__device__ __forceinline__ void ph_conv_p(const Params& p, int layer) {
    const int tidx = tid_opaque();
    const size_t gtid = (size_t)blockIdx.x * 256 + tidx, gsz = (size_t)GRID_X * 256;
    for (size_t i0 = gtid; i0 < (size_t)T * PLE / 4; i0 += 4 * gsz) {
        float4 v[4]; size_t e[4];
#pragma unroll
        for (int u = 0; u < 4; ++u) {
            size_t i = i0 + u * gsz; i = i < (size_t)T * PLE / 4 ? i : (size_t)T * PLE / 4 - 1;
            e[u] = i * 4;
            const float* src = (e[u] < (size_t)TP * PLE) ? p.p_prompt + (size_t)layer * TP * PLE + e[u] : p.p_sample + (size_t)layer * TS * PLE + (e[u] - (size_t)TP * PLE);
            v[u] = *(const float4*)src;
        }
        __builtin_amdgcn_sched_barrier(0);
#pragma unroll
        for (int u = 0; u < 4; ++u) {
            ushort4 o; o.x = f2bf(v[u].x); o.y = f2bf(v[u].y); o.z = f2bf(v[u].z); o.w = f2bf(v[u].w);
            *(ushort4*)(p.pb + e[u]) = o;
        }
    }
}

__device__ __forceinline__ void tok_info(int t, int& smp, int& seq, int& s) {
    if (t < TP) { smp = 0; seq = t / SEQ; s = t % SEQ; } else { smp = 1; seq = (t - TP) / LS; s = (t - TP) % LS; }
}

__device__ __forceinline__ void ph_dn_pre(const Params& p, int j) {
    const int tidx = tid_opaque();
    const int lane = tidx & 63;
    const int wave = blockIdx.x * 4 + (tidx >> 6), nw = GRID_X * 4;
    const float* cw = p.conv_w + (size_t)j * 4 * CONV_CH;
    for (int item = TP * 4 + wave; item < T * 4; item += nw) {
        const int t = item >> 2, h = item & 3;
        int smp, seq, s; tok_info(t, smp, seq, s);
        float out[3][2];
#pragma unroll
        for (int part = 0; part < 3; ++part) {
#pragma unroll
            for (int u = 0; u < 2; ++u) {
                const int c = part * 512 + h * 128 + lane + 64 * u;
                float y = 0.f;
#pragma unroll
                for (int jj = 0; jj < 4; ++jj) {
                    const int sp = s - 3 + jj;
                    float xv;
                    if (sp >= 0) xv = bf2f(p.proj[(size_t)(t - 3 + jj) * EVEN_LD + C_QKV + c]);
                    else if (smp) xv = p.state_conv[(((size_t)j * NS + seq) * 3 + (sp + 3)) * CONV_CH + c];
                    else xv = 0.f;
                    y += cw[jj * CONV_CH + c] * xv;
                }
                out[part][u] = siluf_(y);
            }
        }
#pragma unroll
        for (int part = 0; part < 2; ++part) {
            float ss = out[part][0] * out[part][0] + out[part][1] * out[part][1];
            for (int o = 32; o > 0; o >>= 1) ss += __shfl_xor(ss, o);
            const float r = rsqrtf(ss + EPS);
            out[part][0] *= r; out[part][1] *= r;
        }
#pragma unroll
        for (int part = 0; part < 3; ++part)
#pragma unroll
            for (int u = 0; u < 2; ++u)
                p.dnqkv[(size_t)(t - TP) * CONV_CH + part * 512 + h * 128 + lane + 64 * u] = f2bf(out[part][u]);
        if (lane == 0) {
            const float a_in = p.aux[(size_t)t * 8 + h], b_in = p.aux[(size_t)t * 8 + 4 + h];
            const float g = -__expf(p.a_log[j * 4 + h]) * softplusf_(a_in + p.dt_bias[j * 4 + h]);
            p.dngb[(size_t)(t - TP) * 8 + h] = g;
            p.dngb[(size_t)(t - TP) * 8 + 4 + h] = sigmoidf_(b_in);
        }
    }
}

__device__ __forceinline__ void ph_dn_rec(const Params& p, int j, int bid, int nblk) {
    const int tidx = tid_opaque();
    const int lane = tidx & 63;
    const int wave = (tidx >> 6) * nblk + bid, nw = nblk * 4;
    const int e = lane & 3, dg = lane >> 2;
    const int nitems = (NB + NS) * 4 * 32;
    for (int item = NB * 4 * 32 + wave; item < nitems; item += nw) {
        const int es = item & 31, h = (item >> 5) & 3, st = item >> 7;
        const int smp = st >= NB, seq = smp ? st - NB : st;
        const int t0 = smp ? TP + seq * LS : seq * SEQ, len = smp ? LS : SEQ;
        const int ec = es * 4 + e;
        float S[8];
        if (smp) {
            const float* s0 = p.state_delta + (((size_t)j * NS + seq) * 4 + h) * 128 * 128;
#pragma unroll
            for (int i = 0; i < 8; ++i) S[i] = s0[(size_t)(dg * 8 + i) * 128 + ec];
        } else {
#pragma unroll
            for (int i = 0; i < 8; ++i) S[i] = 0.f;
        }
        for (int s = 0; s < len; ++s) {
            const int t = t0 + s;
            const bf16x8 qv = *(const bf16x8*)(p.dnqkv + (size_t)(t - TP) * CONV_CH + h * 128 + dg * 8);
            const bf16x8 kv = *(const bf16x8*)(p.dnqkv + (size_t)(t - TP) * CONV_CH + 512 + h * 128 + dg * 8);
            const float v = bf2f(p.dnqkv[(size_t)(t - TP) * CONV_CH + 1024 + h * 128 + ec]);
            const float g = p.dngb[(size_t)(t - TP) * 8 + h], beta = p.dngb[(size_t)(t - TP) * 8 + 4 + h];
            float q[8], k[8];
#pragma unroll
            for (int i = 0; i < 8; ++i) { q[i] = bf2f((bf16_t)qv[i]); k[i] = bf2f((bf16_t)kv[i]); }
            float kS = 0.f, qS = 0.f, qk = 0.f;
#pragma unroll
            for (int i = 0; i < 8; ++i) { kS += k[i] * S[i]; qS += q[i] * S[i]; qk += q[i] * k[i]; }
            for (int o = 4; o < 64; o <<= 1) { kS += __shfl_xor(kS, o); qS += __shfl_xor(qS, o); qk += __shfl_xor(qk, o); }
            const float a = __expf(g);
            const float vn = beta * (v - a * kS);
            const float o = 0.08838834764831845f * (a * qS + qk * vn);
#pragma unroll
            for (int i = 0; i < 8; ++i) S[i] = a * S[i] + k[i] * vn;
            if (dg == 0) p.dno[(size_t)(t - TP) * 512 + h * 128 + ec] = o;
        }
        float* so = smp ? p.delta_s + (((size_t)j * NS + seq) * 4 + h) * 128 * 128 : p.delta_p + (((size_t)j * NB + seq) * 4 + h) * 128 * 128;
#pragma unroll
        for (int i = 0; i < 8; ++i) so[(size_t)(dg * 8 + i) * 128 + ec] = S[i];
    }
}

__device__ __forceinline__ void ph_dn_post(const Params& p, int j) {
    const int tidx = tid_opaque();
    const int lane = tidx & 63;
    const int wave = blockIdx.x * 4 + (tidx >> 6), nw = GRID_X * 4;
    for (int item = TP * 4 + wave; item < T * 4; item += nw) {
        const int t = item >> 2, h = item & 3;
        const float o0 = p.dno[(size_t)(t - TP) * 512 + h * 128 + lane], o1 = p.dno[(size_t)(t - TP) * 512 + h * 128 + lane + 64];
        float ss = o0 * o0 + o1 * o1;
        for (int o = 32; o > 0; o >>= 1) ss += __shfl_xor(ss, o);
        const float r = rsqrtf(ss * (1.0f / 128.0f) + EPS);
        const float g0 = bf2f(p.proj[(size_t)t * EVEN_LD + C_GA + h * 128 + lane]), g1 = bf2f(p.proj[(size_t)t * EVEN_LD + C_GA + h * 128 + lane + 64]);
        p.qb[(size_t)t * D + h * 128 + lane] = f2bf(o0 * r * p.norm_a[j * 128 + lane] * siluf_(g0));
        p.qb[(size_t)t * D + h * 128 + lane + 64] = f2bf(o1 * r * p.norm_a[j * 128 + lane + 64] * siluf_(g1));
    }
}


constexpr int DR_N = 0, DR_B = 32768, DR_Q = 65536, DR_O = 81920, DR_SIZE = 98304;
constexpr int DN_R1 = 0, DN_R2 = 16384, DN_R3 = 32768, DN_R4 = 49152, DN_R5 = 58368;


__device__ __forceinline__ void ph_dn_prep(const Params& p, int j, char* smem) {
    char* const smem0 = smem;
    const float* cw = p.conv_w + (size_t)j * 4 * CONV_CH;
    for (int item = blockIdx.x; item < 16 * 64; item += GRID_X) {
        const int st = item >> 6, c = item & 63, b = st >> 2, h = st & 3;
        const int t0 = b * SEQ + c * 64;
        char* rec = p.dnrec + (size_t)item * DR_SIZE;
        const int tidx = tid_opaque();
        unsigned soff = 0; asm volatile("" : "+v"(soff));
        char* smem = smem0 + soff;
        float* sG = (float*)(smem + DN_R5);
        float* sBeta = sG + 64;
        float* sRq = sBeta + 64;
        float* sRk = sRq + 64;
        float* sFw = sRk + 64;
        float* sFk = sFw + 64;
        float* sg0 = sFk + 64;
        float* sA = (float*)(smem + DN_R1);
        const int lane = tidx & 63, wid = tidx >> 6, n = lane & 15, q = lane >> 4;
        __syncthreads();
        if (tidx < 64) {
            const int t = t0 + tidx;
            const float a_in = p.aux[(size_t)t * 8 + h], b_in = p.aux[(size_t)t * 8 + 4 + h];
            sg0[tidx] = -__expf(p.a_log[j * 4 + h]) * softplusf_(a_in + p.dt_bias[j * 4 + h]);
            sBeta[tidx] = sigmoidf_(b_in);
        }
        __syncthreads();
        if (tidx < 64) {
            float G = 0.f;
            for (int k = 0; k <= tidx; ++k) G += sg0[k];
            sG[tidx] = G;
        }
        float X[64];
        {
            const int cch = tidx & 127;
            if (tidx < 128) {
                const int colq = h * 128 + cch, colk = 512 + h * 128 + cch;
                const float wq0 = cw[colq], wq1 = cw[CONV_CH + colq], wq2 = cw[2 * CONV_CH + colq], wq3 = cw[3 * CONV_CH + colq];
                const float wk0 = cw[colk], wk1 = cw[CONV_CH + colk], wk2 = cw[2 * CONV_CH + colk], wk3 = cw[3 * CONV_CH + colk];
                float q0 = 0.f, q1 = 0.f, q2 = 0.f, k0 = 0.f, k1 = 0.f, k2 = 0.f;
                if (c > 0) {
                    const bf16_t* r0 = p.proj + (size_t)(t0 - 3) * EVEN_LD + C_QKV;
                    q0 = bf2f(r0[colq]); q1 = bf2f(r0[EVEN_LD + colq]); q2 = bf2f(r0[2 * EVEN_LD + colq]);
                    k0 = bf2f(r0[colk]); k1 = bf2f(r0[EVEN_LD + colk]); k2 = bf2f(r0[2 * EVEN_LD + colk]);
                }
                const bf16_t* r = p.proj + (size_t)t0 * EVEN_LD + C_QKV + colq;
                bf16_t lq[8], lk[8], nq[8], nk[8];
#pragma unroll
                for (int u = 0; u < 8; ++u) { lq[u] = r[(size_t)u * EVEN_LD]; lk[u] = r[(size_t)u * EVEN_LD + 512]; }
#pragma unroll
                for (int bb = 0; bb < 8; ++bb) {
                    if (bb < 7) {
#pragma unroll
                        for (int u = 0; u < 8; ++u) { nq[u] = r[(size_t)(bb * 8 + 8 + u) * EVEN_LD]; nk[u] = r[(size_t)(bb * 8 + 8 + u) * EVEN_LD + 512]; }
                    }
#pragma unroll
                    for (int u = 0; u < 8; ++u) {
                        const int i = bb * 8 + u;
                        const float q3 = bf2f(lq[u]), k3 = bf2f(lk[u]);
                        const float yq = siluf_(wq0 * q0 + wq1 * q1 + wq2 * q2 + wq3 * q3);
                        const float yk = siluf_(wk0 * k0 + wk1 * k1 + wk2 * k2 + wk3 * k3);
                        q0 = q1; q1 = q2; q2 = q3; k0 = k1; k1 = k2; k2 = k3;
                        X[i] = yk;
                        *(bf16_t*)(smem + DN_R1 + i * 256 + ((((cch >> 3) ^ (i & 15)) << 4) | ((cch & 7) << 1))) = f2bf(yq);
                        *(bf16_t*)(smem + DN_R2 + i * 256 + ((((cch >> 3) ^ (i & 15)) << 4) | ((cch & 7) << 1))) = f2bf(yk);
                        *(bf16_t*)(smem + DN_R3 + cch * 128 + ((((i >> 3) ^ (cch & 7)) << 4) | ((i & 7) << 1))) = f2bf(yk);
                    }
#pragma unroll
                    for (int u = 0; u < 8; ++u) { lq[u] = nq[u]; lk[u] = nk[u]; asm volatile("" : "+v"(X[bb * 8 + u])); }
                    MEMFENCE();
                }
            } else {
                const int colv = 1024 + h * 128 + cch;
                const float w0 = cw[colv], w1 = cw[CONV_CH + colv], w2 = cw[2 * CONV_CH + colv], w3 = cw[3 * CONV_CH + colv];
                float v0 = 0.f, v1 = 0.f, v2 = 0.f;
                if (c > 0) {
                    const bf16_t* r0 = p.proj + (size_t)(t0 - 3) * EVEN_LD + C_QKV;
                    v0 = bf2f(r0[colv]); v1 = bf2f(r0[EVEN_LD + colv]); v2 = bf2f(r0[2 * EVEN_LD + colv]);
                }
                const bf16_t* r = p.proj + (size_t)t0 * EVEN_LD + C_QKV + colv;
                bf16_t lv[8], nv[8];
#pragma unroll
                for (int u = 0; u < 8; ++u) lv[u] = r[(size_t)u * EVEN_LD];
#pragma unroll
                for (int bb = 0; bb < 8; ++bb) {
                    if (bb < 7) {
#pragma unroll
                        for (int u = 0; u < 8; ++u) nv[u] = r[(size_t)(bb * 8 + 8 + u) * EVEN_LD];
                    }
#pragma unroll
                    for (int u = 0; u < 8; ++u) {
                        const float v3 = bf2f(lv[u]);
                        X[bb * 8 + u] = siluf_(w0 * v0 + w1 * v1 + w2 * v2 + w3 * v3);
                        v0 = v1; v1 = v2; v2 = v3;
                    }
#pragma unroll
                    for (int u = 0; u < 8; ++u) { lv[u] = nv[u]; asm volatile("" : "+v"(X[bb * 8 + u])); }
                    MEMFENCE();
                }
            }
        }
        __syncthreads();
        {
            const int i = tidx >> 2, qt = tidx & 3;
            float sq = 0.f, sk = 0.f;
#pragma unroll
            for (int u = 0; u < 4; ++u) {
                const int chn = (qt * 4 + u) ^ (i & 15);
                const bf16x8 a = *(const bf16x8*)(smem + DN_R1 + i * 256 + (chn << 4));
                const bf16x8 bb = *(const bf16x8*)(smem + DN_R2 + i * 256 + (chn << 4));
#pragma unroll
                for (int e = 0; e < 8; ++e) { const float x = bf2f((bf16_t)a[e]), y = bf2f((bf16_t)bb[e]); sq += x * x; sk += y * y; }
            }
            sq += __shfl_xor(sq, 1); sq += __shfl_xor(sq, 2);
            sk += __shfl_xor(sk, 1); sk += __shfl_xor(sk, 2);
            if (qt == 0) {
                const float rq = rsqrtf(sq + EPS) * 0.08838834764831845f, rk = rsqrtf(sk + EPS);
                const float G = sG[i], Gl = sG[63];
                sRq[i] = rq; sRk[i] = rk;
                sFw[i] = rk * sBeta[i] * __expf(G);
                sFk[i] = rk * __expf(Gl - G);
            }
        }
        __syncthreads();
        {
            const int dd = tidx & 127, cg = tidx >> 7;
#pragma unroll
            for (int u = 0; u < 4; ++u) {
                const int chn = cg * 4 + u;
                char* ptr = smem + DN_R3 + dd * 128 + ((chn ^ (dd & 7)) << 4);
                const uint4 v = *(const uint4*)ptr;
                const float* f = sFk + chn * 8;
                uint4 o;
                o.x = pack_bf16(__uint_as_float(v.x << 16) * f[0], __uint_as_float(v.x & 0xffff0000u) * f[1]);
                o.y = pack_bf16(__uint_as_float(v.y << 16) * f[2], __uint_as_float(v.y & 0xffff0000u) * f[3]);
                o.z = pack_bf16(__uint_as_float(v.z << 16) * f[4], __uint_as_float(v.z & 0xffff0000u) * f[5]);
                o.w = pack_bf16(__uint_as_float(v.w << 16) * f[6], __uint_as_float(v.w & 0xffff0000u) * f[7]);
                *(uint4*)ptr = o;
            }
        }
        const int irow = wid * 16 + n;
        uint4 qkeep[4];
        {
            const float fq = sRq[irow] * __expf(sG[irow]);
#pragma unroll
            for (int kk = 0; kk < 4; ++kk) {
                uint4 o;
                {
                    const int chn = ((2 * kk) * 2 + (q >> 1)) ^ (irow & 15);
                    const float4 f = unpack4(*(const uint2*)(smem + DN_R1 + irow * 256 + (chn << 4) + ((q & 1) << 3)));
                    o.x = pack_bf16(f.x * fq, f.y * fq); o.y = pack_bf16(f.z * fq, f.w * fq);
                }
                {
                    const int chn = ((2 * kk + 1) * 2 + (q >> 1)) ^ (irow & 15);
                    const float4 f = unpack4(*(const uint2*)(smem + DN_R1 + irow * 256 + (chn << 4) + ((q & 1) << 3)));
                    o.z = pack_bf16(f.x * fq, f.y * fq); o.w = pack_bf16(f.z * fq, f.w * fq);
                }
                qkeep[kk] = o;
            }
        }
        {
            bf16x8 kfi[4], qfi[4];
#pragma unroll
            for (int kk = 0; kk < 4; ++kk) {
                const int chn = (kk * 4 + q) ^ (irow & 15);
                kfi[kk] = *(const bf16x8*)(smem + DN_R2 + irow * 256 + (chn << 4));
                qfi[kk] = *(const bf16x8*)(smem + DN_R1 + irow * 256 + (chn << 4));
            }
            const float Gi = sG[irow], bi = sBeta[irow], rki = sRk[irow], rqi = sRq[irow];
            __syncthreads();
#pragma unroll
            for (int jt = 0; jt < 4; ++jt) {
                f32x4 aA = {0.f, 0.f, 0.f, 0.f}, aQ = {0.f, 0.f, 0.f, 0.f};
                if (jt <= wid) {
                    const int jrow = jt * 16 + n;
#pragma unroll
                    for (int kk = 0; kk < 4; ++kk) {
                        const int chn = (kk * 4 + q) ^ (jrow & 15);
                        const bf16x8 kfj = *(const bf16x8*)(smem + DN_R2 + jrow * 256 + (chn << 4));
                        aA = __builtin_amdgcn_mfma_f32_16x16x32_bf16(kfj, kfi[kk], aA, 0, 0, 0);
                        aQ = __builtin_amdgcn_mfma_f32_16x16x32_bf16(kfj, qfi[kk], aQ, 0, 0, 0);
                    }
                }
                float qkv[4], av[4];
#pragma unroll
                for (int rr = 0; rr < 4; ++rr) {
                    const int jj = jt * 16 + 4 * q + rr;
                    const float dec = (jj <= irow) ? __expf(Gi - sG[jj]) : 0.f;
                    const float rkj = sRk[jj];
                    qkv[rr] = rqi * rkj * aQ[rr] * dec;
                    av[rr] = (jj < irow) ? bi * rki * rkj * aA[rr] * dec : 0.f;
                }
                uint2 o; o.x = pack_bf16(qkv[0], qkv[1]); o.y = pack_bf16(qkv[2], qkv[3]);
                *(uint2*)(smem + DN_R4 + irow * 144 + (jt * 16 + 4 * q) * 2) = o;
                *(float4*)(sA + irow * 64 + jt * 16 + 4 * q) = make_float4(av[0], av[1], av[2], av[3]);
            }
        }
        __syncthreads();
        {
            const float* fac = (tidx < 128) ? sFw : sBeta;
            unsigned aoff = 0; asm volatile("" : "+v"(aoff));
            const float* sAl = (const float*)((const char*)sA + aoff);
#pragma unroll
            for (int i4 = 0; i4 < 16; ++i4) {
                const float4 f = *(const float4*)(fac + i4 * 4);
                X[i4 * 4] *= f.x; X[i4 * 4 + 1] *= f.y; X[i4 * 4 + 2] *= f.z; X[i4 * 4 + 3] *= f.w;
            }
#pragma unroll
            for (int ib = 0; ib < 8; ++ib) {
                float a[8];
#pragma unroll
                for (int r = 0; r < 8; ++r) a[r] = X[8 * ib + r];
#pragma unroll
                for (int jb = 0; jb < 2 * ib; ++jb) {
#pragma unroll
                    for (int r = 0; r < 8; ++r) {
                        const float4 av = *(const float4*)(sAl + (8 * ib + r) * 64 + 4 * jb);
                        a[r] -= av.x * X[4 * jb]; a[r] -= av.y * X[4 * jb + 1]; a[r] -= av.z * X[4 * jb + 2]; a[r] -= av.w * X[4 * jb + 3];
                    }
                }
#pragma unroll
                for (int r = 1; r < 8; ++r) {
                    const float4 d0 = *(const float4*)(sAl + (8 * ib + r) * 64 + 8 * ib), d1 = *(const float4*)(sAl + (8 * ib + r) * 64 + 8 * ib + 4);
                    const float dv[8] = {d0.x, d0.y, d0.z, d0.w, d1.x, d1.y, d1.z, d1.w};
#pragma unroll
                    for (int c = 0; c < 8; ++c) if (c < r) a[r] -= dv[c] * a[c];
                }
#pragma unroll
                for (int r = 0; r < 8; ++r) X[8 * ib + r] = a[r];
                asm volatile("" : "+v"(X[8 * ib]), "+v"(X[8 * ib + 1]), "+v"(X[8 * ib + 2]), "+v"(X[8 * ib + 3]), "+v"(X[8 * ib + 4]), "+v"(X[8 * ib + 5]), "+v"(X[8 * ib + 6]), "+v"(X[8 * ib + 7]) :: "memory");
            }
        }
        __syncthreads();
        {
            const int cch = tidx & 127;
            char* base = smem + ((tidx < 128) ? DN_R2 : DN_R1) + cch * 128;
#pragma unroll
            for (int chn = 0; chn < 8; ++chn) {
                uint4 o;
                o.x = pack_bf16(X[chn * 8 + 0], X[chn * 8 + 1]); o.y = pack_bf16(X[chn * 8 + 2], X[chn * 8 + 3]);
                o.z = pack_bf16(X[chn * 8 + 4], X[chn * 8 + 5]); o.w = pack_bf16(X[chn * 8 + 6], X[chn * 8 + 7]);
                *(uint4*)(base + ((chn ^ (cch & 7)) << 4)) = o;
            }
        }
        if (tidx == 0) p.dngl[item] = __expf(sG[63]);
        __syncthreads();
#define TFRAG(REG, r0, kj) (*(const bf16x8*)(smem + (REG) + ((r0) + n) * 128 + (((((kj) * 4 + q)) ^ (((r0) + n) & 7)) << 4)))
        {
            f32x4 acc[2][8];
#pragma unroll
            for (int a = 0; a < 2; ++a)
#pragma unroll
                for (int nt = 0; nt < 8; ++nt) acc[a][nt] = (f32x4){0.f, 0.f, 0.f, 0.f};
#pragma unroll
            for (int kj = 0; kj < 2; ++kj) {
                const bf16x8 kd0 = TFRAG(DN_R3, (2 * wid) * 16, kj), kd1 = TFRAG(DN_R3, (2 * wid + 1) * 16, kj);
#pragma unroll
                for (int nt = 0; nt < 8; ++nt) {
                    const bf16x8 wf = TFRAG(DN_R2, nt * 16, kj);
                    acc[0][nt] = __builtin_amdgcn_mfma_f32_16x16x32_bf16(wf, kd0, acc[0][nt], 0, 0, 0);
                    acc[1][nt] = __builtin_amdgcn_mfma_f32_16x16x32_bf16(wf, kd1, acc[1][nt], 0, 0, 0);
                }
            }
#pragma unroll
            for (int a = 0; a < 2; ++a)
#pragma unroll
                for (int kk = 0; kk < 4; ++kk) {
                    const f32x4 lo = acc[a][2 * kk], hi = acc[a][2 * kk + 1];
                    uint4 o;
                    o.x = pack_bf16(-lo[0], -lo[1]); o.y = pack_bf16(-lo[2], -lo[3]); o.z = pack_bf16(-hi[0], -hi[1]); o.w = pack_bf16(-hi[2], -hi[3]);
                    *(uint4*)(rec + DR_N + ((((2 * wid + a) * 4 + kk) * 64) + lane) * 16) = o;
                }
        }
        {
            f32x4 acc[8][2];
#pragma unroll
            for (int mt = 0; mt < 8; ++mt) { acc[mt][0] = (f32x4){0.f, 0.f, 0.f, 0.f}; acc[mt][1] = (f32x4){0.f, 0.f, 0.f, 0.f}; }
#pragma unroll
            for (int kj = 0; kj < 2; ++kj) {
                const bf16x8 u0 = TFRAG(DN_R1, (2 * wid) * 16, kj), u1 = TFRAG(DN_R1, (2 * wid + 1) * 16, kj);
#pragma unroll
                for (int mt = 0; mt < 8; ++mt) {
                    const bf16x8 kd = TFRAG(DN_R3, mt * 16, kj);
                    acc[mt][0] = __builtin_amdgcn_mfma_f32_16x16x32_bf16(kd, u0, acc[mt][0], 0, 0, 0);
                    acc[mt][1] = __builtin_amdgcn_mfma_f32_16x16x32_bf16(kd, u1, acc[mt][1], 0, 0, 0);
                }
            }
#pragma unroll
            for (int mt = 0; mt < 8; ++mt)
#pragma unroll
                for (int a = 0; a < 2; ++a) {
                    uint2 o; o.x = pack_bf16(acc[mt][a][0], acc[mt][a][1]); o.y = pack_bf16(acc[mt][a][2], acc[mt][a][3]);
                    *(uint2*)(rec + DR_B + ((((2 * wid + a) * 8 + mt) * 64) + lane) * 8) = o;
                }
        }
        {
            bf16x8 qkf[2];
#pragma unroll
            for (int kj = 0; kj < 2; ++kj) qkf[kj] = *(const bf16x8*)(smem + DN_R4 + irow * 144 + (kj * 32 + 8 * q) * 2);
            f32x4 pq[8];
#pragma unroll
            for (int dt = 0; dt < 8; ++dt) {
                pq[dt] = (f32x4){0.f, 0.f, 0.f, 0.f};
#pragma unroll
                for (int kj = 0; kj < 2; ++kj) pq[dt] = __builtin_amdgcn_mfma_f32_16x16x32_bf16(TFRAG(DN_R2, dt * 16, kj), qkf[kj], pq[dt], 0, 0, 0);
            }
#pragma unroll
            for (int kk = 0; kk < 4; ++kk) {
                uint4* qp = (uint4*)(rec + DR_Q + (((wid * 4 + kk) * 64) + lane) * 16);
                const uint4 qv = qkeep[kk];
                const float4 lo = unpack4(make_uint2(qv.x, qv.y)), hi = unpack4(make_uint2(qv.z, qv.w));
                uint4 o;
                o.x = pack_bf16(lo.x - pq[2 * kk][0], lo.y - pq[2 * kk][1]);
                o.y = pack_bf16(lo.z - pq[2 * kk][2], lo.w - pq[2 * kk][3]);
                o.z = pack_bf16(hi.x - pq[2 * kk + 1][0], hi.y - pq[2 * kk + 1][1]);
                o.w = pack_bf16(hi.z - pq[2 * kk + 1][2], hi.w - pq[2 * kk + 1][3]);
                *qp = o;
            }
#pragma unroll
            for (int et = 0; et < 8; ++et) {
                f32x4 po = {0.f, 0.f, 0.f, 0.f};
#pragma unroll
                for (int kj = 0; kj < 2; ++kj) po = __builtin_amdgcn_mfma_f32_16x16x32_bf16(TFRAG(DN_R1, et * 16, kj), qkf[kj], po, 0, 0, 0);
                uint2 o; o.x = pack_bf16(po[0], po[1]); o.y = pack_bf16(po[2], po[3]);
                *(uint2*)(rec + DR_O + (((wid * 8 + et) * 64) + lane) * 8) = o;
            }
        }
#undef TFRAG
    }
}

__device__ __forceinline__ void ph_dn_scan(const Params& p, int j, char* smem, int item0) {
    const int tidx = tid_opaque();
    const int lane = tidx & 63, wid = tidx >> 6, n = lane & 15, q = lane >> 4;
    const unsigned lbase = __builtin_amdgcn_readfirstlane(lds_base_addr() + wid * 1024);
    for (int item = item0; item < 32; item += GRID_X) {
        const int st = item >> 1, et = (item & 1) * 4 + wid;
        const int b = st >> 2, h = st & 3;
        f32x4 acc[8];
#pragma unroll
        for (int mt = 0; mt < 8; ++mt) acc[mt] = (f32x4){0.f, 0.f, 0.f, 0.f};
        const char* rec = p.dnrec + (size_t)st * 64 * DR_SIZE;
        const char* nsrc = rec + DR_N + tidx * 16;
        char* sp = p.dnsp + (size_t)st * 64 * 32768 + (et >> 1) * 8192 + (et & 1) * 1024 + lane * 16;
        const char* brec = rec + DR_B + (size_t)et * 8 * 512 + lane * 8;
        __syncthreads();
#pragma unroll
        for (int k = 0; k < 8; ++k) glds16_asm(nsrc + k * 4096, lbase + k * 4096);
        uint2 bcur[8];
#pragma unroll
        for (int mt = 0; mt < 8; ++mt) bcur[mt] = *(const uint2*)(brec + mt * 512);
        float gl = p.dngl[st * 64];
        asm volatile("s_waitcnt vmcnt(0)" ::: "memory");
        __syncthreads();
#pragma unroll 1
        for (int c = 0; c < 64; ++c) {
            const char* slot = smem + (c & 1) * 32768;
            bf16x8 sB[4];
#pragma unroll
            for (int kk = 0; kk < 4; ++kk) {
                const f32x4 lo = acc[2 * kk], hi = acc[2 * kk + 1];
                uint4 cu;
                cu.x = pack_bf16(lo[0], lo[1]); cu.y = pack_bf16(lo[2], lo[3]); cu.z = pack_bf16(hi[0], hi[1]); cu.w = pack_bf16(hi[2], hi[3]);
                sB[kk] = __builtin_bit_cast(bf16x8, cu);
                *(uint4*)(sp + (size_t)c * 32768 + kk * 2048) = cu;
            }
#pragma unroll
            for (int mt = 0; mt < 8; ++mt) {
                const float4 b0 = unpack4(bcur[mt]);
                acc[mt][0] = gl * acc[mt][0] + b0.x; acc[mt][1] = gl * acc[mt][1] + b0.y; acc[mt][2] = gl * acc[mt][2] + b0.z; acc[mt][3] = gl * acc[mt][3] + b0.w;
            }
            {
                const int cn = (c + 1 < 64) ? c + 1 : c;
                const char* nb = brec + (size_t)cn * DR_SIZE;
#pragma unroll
                for (int mt = 0; mt < 8; ++mt) bcur[mt] = *(const uint2*)(nb + mt * 512);
                gl = p.dngl[st * 64 + cn];
                if (c + 1 < 64) {
                    const unsigned dst = lbase + ((c + 1) & 1) * 32768;
#pragma unroll
                    for (int k = 0; k < 8; ++k) glds16_asm(nsrc + (size_t)(c + 1) * DR_SIZE + k * 4096, dst + k * 4096);
                }
            }
#pragma unroll
            for (int mt = 0; mt < 8; ++mt) {
                f32x4 c0 = acc[mt];
#pragma unroll
                for (int kk = 0; kk < 4; ++kk) {
                    const bf16x8 nf = *(const bf16x8*)(slot + ((mt * 4 + kk) * 64 + lane) * 16);
                    c0 = __builtin_amdgcn_mfma_f32_16x16x32_bf16(nf, sB[kk], c0, 0, 0, 0);
                }
                acc[mt] = c0;
            }
            asm volatile("s_waitcnt vmcnt(0) lgkmcnt(0)" ::: "memory");
            __builtin_amdgcn_s_barrier();
            MEMFENCE();
        }
        float* so = p.delta_p + (((size_t)j * NB + b) * 4 + h) * 128 * 128;
#pragma unroll
        for (int mt = 0; mt < 8; ++mt)
#pragma unroll
            for (int rr = 0; rr < 4; ++rr) so[(size_t)(mt * 16 + 4 * q + rr) * 128 + et * 16 + n] = acc[mt][rr];
    }
}

__device__ __forceinline__ void ph_dn_out(const Params& p, int j) {
    const int tidx = tid_opaque();
    const int lane = tidx & 63, wid = tidx >> 6, n = lane & 15, q = lane >> 4;
    float4 na[8];
#pragma unroll
    for (int et = 0; et < 8; ++et) na[et] = *(const float4*)(p.norm_a + j * 128 + et * 16 + 4 * q);
    for (int item = blockIdx.x; item < 16 * 64; item += GRID_X) {
        const int st = item >> 6, c = item & 63, b = st >> 2, h = st & 3;
        const char* rec = p.dnrec + (size_t)item * DR_SIZE;
        const char* sp = p.dnsp + (size_t)item * 32768 + lane * 16;
        const int t = b * SEQ + c * 64 + wid * 16 + n;
        bf16x8 qf[4];
#pragma unroll
        for (int kk = 0; kk < 4; ++kk) qf[kk] = *(const bf16x8*)(rec + DR_Q + (((wid * 4 + kk) * 64) + lane) * 16);
        uint2 oi[8], gg[8];
#pragma unroll
        for (int et = 0; et < 8; ++et) {
            oi[et] = *(const uint2*)(rec + DR_O + (((wid * 8 + et) * 64) + lane) * 8);
            gg[et] = *(const uint2*)(p.proj + (size_t)t * EVEN_LD + C_GA + h * 128 + et * 16 + 4 * q);
        }
        f32x4 o[8];
        float ss = 0.f;
#pragma unroll
        for (int hf = 0; hf < 2; ++hf) {
            bf16x8 sf[16];
#pragma unroll
            for (int e2 = 0; e2 < 4; ++e2)
#pragma unroll
                for (int kk = 0; kk < 4; ++kk) {
                    const int et = hf * 4 + e2;
                    sf[e2 * 4 + kk] = *(const bf16x8*)(sp + (et >> 1) * 8192 + (kk * 2 + (et & 1)) * 1024);
                }
            __builtin_amdgcn_sched_barrier(0);
#pragma unroll
            for (int e2 = 0; e2 < 4; ++e2) {
                const int et = hf * 4 + e2;
                const float4 of = unpack4(oi[et]);
                f32x4 a = {of.x, of.y, of.z, of.w};
#pragma unroll
                for (int kk = 0; kk < 4; ++kk) a = __builtin_amdgcn_mfma_f32_16x16x32_bf16(sf[e2 * 4 + kk], qf[kk], a, 0, 0, 0);
                o[et] = a;
                ss += a[0] * a[0] + a[1] * a[1] + a[2] * a[2] + a[3] * a[3];
            }
        }
        ss += __shfl_xor(ss, 16); ss += __shfl_xor(ss, 32);
        const float r = rsqrtf(ss * (1.0f / 128.0f) + EPS);
#pragma unroll
        for (int et = 0; et < 8; ++et) {
            const int e0 = et * 16 + 4 * q;
            const float4 g = unpack4(gg[et]);
            uint2 w;
            w.x = pack_bf16(o[et][0] * r * na[et].x * siluf_(g.x), o[et][1] * r * na[et].y * siluf_(g.y));
            w.y = pack_bf16(o[et][2] * r * na[et].z * siluf_(g.z), o[et][3] * r * na[et].w * siluf_(g.w));
            *(uint2*)(p.qb + (size_t)t * D + h * 128 + e0) = w;
        }
    }
}

__device__ __forceinline__ void rope_chunk_r(float (&x)[8], int chunk_in_head, const float4 c0, const float4 c1, const float4 s0, const float4 s1) {
    float o[8];
#pragma unroll
    for (int i = 0; i < 8; ++i) o[i] = __shfl_xor(x[i], 1);
    if (chunk_in_head < 2) {
        const float c[8] = {c0.x, c0.y, c0.z, c0.w, c1.x, c1.y, c1.z, c1.w}, sn[8] = {s0.x, s0.y, s0.z, s0.w, s1.x, s1.y, s1.z, s1.w};
        const float sg = chunk_in_head == 0 ? -1.f : 1.f;
#pragma unroll
        for (int i = 0; i < 8; ++i) x[i] = x[i] * c[i] + sg * o[i] * sn[i];
    }
}
__device__ __forceinline__ void rope_chunk(float (&x)[8], int chunk_in_head, const float* rp, int lane) {
    float o[8];
#pragma unroll
    for (int i = 0; i < 8; ++i) o[i] = __shfl_xor(x[i], 1);
    if (chunk_in_head < 2) {
        const float4 c0 = *(const float4*)rp, c1 = *(const float4*)(rp + 4), s0 = *(const float4*)(rp + 8), s1 = *(const float4*)(rp + 12);
        const float c[8] = {c0.x, c0.y, c0.z, c0.w, c1.x, c1.y, c1.z, c1.w}, sn[8] = {s0.x, s0.y, s0.z, s0.w, s1.x, s1.y, s1.z, s1.w};
        const float sg = chunk_in_head == 0 ? -1.f : 1.f;
#pragma unroll
        for (int i = 0; i < 8; ++i) x[i] = x[i] * c[i] + sg * o[i] * sn[i];
    }
}

__device__ __forceinline__ void ph_swa_pre(const Params& p, int j) {
    const int tidx = tid_opaque();
    const int lane = tidx & 63;
    const int wave = blockIdx.x * 4 + (tidx >> 6), nw = GRID_X * 4;
    for (int t = wave; t < T; t += nw) {
        int smp, seq, s; tok_info(t, smp, seq, s);
        const int pi = smp ? SEQ + s : s;
        const float* rp = p.rope + (size_t)pi * 16;
        const bf16_t* row = p.proj + (size_t)t * EVEN_LD;
        const float4 rc0 = *(const float4*)rp, rc1 = *(const float4*)(rp + 4), rs0 = *(const float4*)(rp + 8), rs1 = *(const float4*)(rp + 12);
        const uint4 qraw = *(const uint4*)(row + C_QB + lane * 8);
        const uint4 kvraw = *(const uint4*)(row + (((lane >> 4) & 1) ? C_VB : C_KB) + (lane & 15) * 8);
        __builtin_amdgcn_sched_barrier(0);
        {
            float x[8]; unpack8(qraw, x);
            rope_chunk_r(x, lane & 7, rc0, rc1, rs0, rs1);
            uint4 o; o.x = pack_bf16(x[0], x[1]); o.y = pack_bf16(x[2], x[3]); o.z = pack_bf16(x[4], x[5]); o.w = pack_bf16(x[6], x[7]);
            *(uint4*)(p.qr + (size_t)t * 512 + lane * 8) = o;
        }
        {
            const int l32 = lane & 31, isv = (lane >> 4) & 1, l16 = lane & 15;
            float x[8]; unpack8(kvraw, x);
            float xr[8];
#pragma unroll
            for (int i = 0; i < 8; ++i) xr[i] = x[i];
            rope_chunk_r(xr, l16 & 7, rc0, rc1, rs0, rs1);
            if (lane < 32) {
                const int kh = l16 >> 3, d0 = (l16 & 7) * 8;
                if (!isv) {
                    uint4 o; o.x = pack_bf16(xr[0], xr[1]); o.y = pack_bf16(xr[2], xr[3]); o.z = pack_bf16(xr[4], xr[5]); o.w = pack_bf16(xr[6], xr[7]);
                    if (!smp) *(uint4*)(p.krb + (size_t)t * 128 + l16 * 8) = o;
                    else *(uint4*)(p.kcat + (((size_t)seq * 2 + kh) * 144 + 128 + s) * 64 + d0) = o;
                }
                float src[8];
#pragma unroll
                for (int i = 0; i < 8; ++i) src[i] = isv ? x[i] : xr[i];
                float* dst = nullptr;
                if (!smp) { if (s >= SEQ - 128) dst = (isv ? p.wv_p : p.wk_p) + ((((size_t)j * NB + seq) * 128 + (s - (SEQ - 128))) * 2 + kh) * 64 + d0; }
                else dst = (isv ? p.wv_s : p.wk_s) + ((((size_t)j * NS + seq) * 128 + (120 + s)) * 2 + kh) * 64 + d0;
                if (dst) { *(float4*)dst = make_float4(src[0], src[1], src[2], src[3]); *(float4*)(dst + 4) = make_float4(src[4], src[5], src[6], src[7]); }
                (void)l32;
            }
        }
    }
    const size_t gtid = (size_t)blockIdx.x * 256 + tidx, gsz = (size_t)GRID_X * 256;
    {
        constexpr size_t NPC = (size_t)NS * 120 * 128 / 4;
#define SWA_SH_LOAD(u_, k_, v_, d_) size_t d_; float4 k_, v_; { size_t i_ = gtid + (u_) * gsz; i_ = i_ < NPC ? i_ : NPC - 1; \
            const int nn_ = (int)(i_ / (120 * 32)); const int rem_ = (int)(i_ % (120 * 32)) * 4; \
            const size_t src_ = ((size_t)j * NS + nn_) * 128 * 128 + 8 * 128 + rem_; d_ = ((size_t)j * NS + nn_) * 128 * 128 + rem_; \
            k_ = *(const float4*)(p.cache_k + src_); v_ = *(const float4*)(p.cache_v + src_); }
        SWA_SH_LOAD(0, k0, v0, d0) SWA_SH_LOAD(1, k1, v1, d1) SWA_SH_LOAD(2, k2, v2, d2) SWA_SH_LOAD(3, k3, v3, d3)
#undef SWA_SH_LOAD
        __builtin_amdgcn_sched_barrier(0);
        *(float4*)(p.wk_s + d0) = k0; *(float4*)(p.wv_s + d0) = v0; *(float4*)(p.wk_s + d1) = k1; *(float4*)(p.wv_s + d1) = v1;
        *(float4*)(p.wk_s + d2) = k2; *(float4*)(p.wv_s + d2) = v2; *(float4*)(p.wk_s + d3) = k3; *(float4*)(p.wv_s + d3) = v3;
    }
}
__device__ __forceinline__ void ph_swa_prep2(const Params& p, int j, char* smem) {
    const int tidx = tid_opaque();
    bf16_t* tile = (bf16_t*)smem;
    for (int item = blockIdx.x; item < NB * (SEQ / 64); item += GRID_X) {
        const int b = item / (SEQ / 64), pt = item % (SEQ / 64);
        const int t0 = b * SEQ + pt * 64;
        __syncthreads();
#pragma unroll
        for (int u = 0; u < 4; ++u) {
            const int cidx = tidx + 256 * u, tok = cidx >> 4, ch = cidx & 15;
            *(uint4*)(tile + tok * 128 + ch * 8) = *(const uint4*)(p.proj + (size_t)(t0 + tok) * EVEN_LD + C_VB + ch * 8);
        }
        __syncthreads();
#pragma unroll
        for (int u = 0; u < 8; ++u) {
            const int pidx = tidx + 256 * u;
            const int ln = pidx & 63, dt = (pidx >> 6) & 3, kvh = (pidx >> 8) & 1, Tl = pidx >> 9;
            const int n = ln & 15, q = ln >> 4;
            const int col = kvh * 64 + dt * 16 + n, tk = Tl * 16 + 4 * q;
            uint2 w;
            w.x = (unsigned)tile[tk * 128 + col] | ((unsigned)tile[(tk + 1) * 128 + col] << 16);
            w.y = (unsigned)tile[(tk + 2) * 128 + col] | ((unsigned)tile[(tk + 3) * 128 + col] << 16);
            *(uint2*)(p.vT + ((((size_t)(b * 2 + kvh) * 256 + pt * 4 + Tl) * 4 + dt) * 64 + ln) * 4) = w;
        }
    }
    for (int item = blockIdx.x; item < NS; item += GRID_X) {
        const int nn = item;
        __syncthreads();
        for (int e = tidx; e < 128 * 32; e += 256) {
            const int c = e >> 5, k4 = e & 31;
            const size_t src = (((size_t)j * NS + nn) * 128 + c) * 128 + k4 * 4;
            const float4 kv = *(const float4*)(p.cache_k + src), vv = *(const float4*)(p.cache_v + src);
            const int kvh = k4 >> 4, d0 = (k4 & 15) * 4;
            ushort4 ko; ko.x = f2bf(kv.x); ko.y = f2bf(kv.y); ko.z = f2bf(kv.z); ko.w = f2bf(kv.w);
            *(ushort4*)(p.kcat + (((size_t)nn * 2 + kvh) * 144 + c) * 64 + d0) = ko;
            bf16_t* tp_ = tile + c * 130 + k4 * 4;
            tp_[0] = f2bf(vv.x); tp_[1] = f2bf(vv.y); tp_[2] = f2bf(vv.z); tp_[3] = f2bf(vv.w);
        }
        for (int e = tidx; e < 8 * 128; e += 256) {
            const int c = e >> 7, kd = e & 127;
            tile[(128 + c) * 130 + kd] = p.proj[(size_t)(TP + nn * LS + c) * EVEN_LD + C_VB + kd];
            p.kcat[(((size_t)nn * 2 + (kd >> 6)) * 144 + 136 + c) * 64 + (kd & 63)] = 0;
        }
        __syncthreads();
        for (int pidx = tidx; pidx < 10 * 2 * 4 * 64; pidx += 256) {
            const int ln = pidx & 63, dt = (pidx >> 6) & 3, kvh = (pidx >> 8) & 1, Tl = pidx >> 9;
            const int n = ln & 15, q = ln >> 4;
            const int col = kvh * 64 + dt * 16 + n, tk = Tl * 16 + 4 * q;
            unsigned v4[4];
#pragma unroll
            for (int e = 0; e < 4; ++e) v4[e] = (tk + e < 136) ? (unsigned)tile[(tk + e) * 130 + col] : 0u;
            uint2 w; w.x = v4[0] | (v4[1] << 16); w.y = v4[2] | (v4[3] << 16);
            *(uint2*)(p.vTcat + ((((size_t)(nn * 2 + kvh) * 10 + Tl) * 4 + dt) * 64 + ln) * 4) = w;
        }
    }
}

__device__ __forceinline__ void ph_swa_attn2(const Params& p, int j, int bid, int nblk) {
    const int tidx = tid_opaque();
    const int lane = tidx & 63, n = lane & 15, q = lane >> 4;
    const int wave = bid * 4 + (tidx >> 6), nw = nblk * 4;
    const int nprompt = NB * (SEQ / 16) * 8;
    for (int item = wave; item < nprompt + NS * 8; item += nw) {
        int hq, qc0, tq0, kstride, kmax, vstride, vmax, nvalid;
        const bf16_t* Kb; const bf16_t* VTb;
        if (item < nprompt) {
            const int b = item / ((SEQ / 16) * 8), rem = item % ((SEQ / 16) * 8);
            hq = rem & 7; qc0 = (rem >> 3) * 16; tq0 = b * SEQ + qc0;
            Kb = p.krb + (size_t)b * SEQ * 128 + (hq >> 2) * 64; kstride = 128; kmax = SEQ - 1;
            VTb = p.vT + (size_t)(b * 2 + (hq >> 2)) * 256 * 4 * 64 * 4; vstride = 0; vmax = 255;
            nvalid = 16;
        } else {
            const int it2 = item - nprompt, nn = it2 >> 3;
            hq = it2 & 7; qc0 = 128; tq0 = TP + nn * LS;
            Kb = p.kcat + ((size_t)nn * 2 + (hq >> 2)) * 144 * 64; kstride = 64; kmax = 143;
            VTb = p.vTcat + (size_t)(nn * 2 + (hq >> 2)) * 10 * 4 * 64 * 4; vstride = 0; vmax = 9;
            nvalid = 8;
        }
        const int key0 = qc0 - 128;
        const int tq = tq0 + (n < nvalid ? n : nvalid - 1);
        bf16x8 qf[2];
        qf[0] = *(const bf16x8*)(p.qr + (size_t)tq * 512 + hq * 64 + 8 * q);
        qf[1] = *(const bf16x8*)(p.qr + (size_t)tq * 512 + hq * 64 + 32 + 8 * q);
        bf16x8 kf[20];
#pragma unroll
        for (int kt = 0; kt < 10; ++kt) {
            int kc = key0 + 16 * kt + n; kc = kc < 0 ? 0 : (kc > kmax ? kmax : kc);
            const bf16_t* kp = Kb + (size_t)kc * kstride + 8 * q;
            kf[2 * kt] = *(const bf16x8*)(kp); kf[2 * kt + 1] = *(const bf16x8*)(kp + 32);
        }
        uint2 vv[40];
#pragma unroll
        for (int k2 = 0; k2 < 5; ++k2) {
            int tA = (key0 >> 4) + 2 * k2, tB = tA + 1;
            tA = tA < 0 ? 0 : (tA > vmax ? vmax : tA); tB = tB < 0 ? 0 : (tB > vmax ? vmax : tB);
#pragma unroll
            for (int dt = 0; dt < 4; ++dt) {
                vv[(dt * 5 + k2) * 2] = *(const uint2*)(VTb + (((size_t)tA * 4 + dt) * 64 + lane) * 4);
                vv[(dt * 5 + k2) * 2 + 1] = *(const uint2*)(VTb + (((size_t)tB * 4 + dt) * 64 + lane) * 4);
            }
        }
        uint2 gg[4];
#pragma unroll
        for (int dt = 0; dt < 4; ++dt) gg[dt] = *(const uint2*)(p.proj + (size_t)tq * EVEN_LD + C_GB + hq * 64 + dt * 16 + 4 * q);
        const float sink = p.sinks[j * 8 + hq];
        __builtin_amdgcn_sched_barrier(0);
        f32x4 sc[10];
#pragma unroll
        for (int kt = 0; kt < 10; ++kt) {
            f32x4 a = {0.f, 0.f, 0.f, 0.f};
            a = __builtin_amdgcn_mfma_f32_16x16x32_bf16(kf[2 * kt], qf[0], a, 0, 0, 0);
            a = __builtin_amdgcn_mfma_f32_16x16x32_bf16(kf[2 * kt + 1], qf[1], a, 0, 0, 0);
            sc[kt] = a;
        }
        const int qc = qc0 + n;
        float mx = -1e30f;
#pragma unroll
        for (int kt = 0; kt < 10; ++kt)
#pragma unroll
            for (int rr = 0; rr < 4; ++rr) {
                const int kc = key0 + 16 * kt + 4 * q + rr, rel = qc - kc;
                const bool ok = (kc >= 0) && (rel >= 0) && (rel <= 128);
                const float sv = ok ? sc[kt][rr] * 0.125f : -1e30f;
                sc[kt][rr] = sv;
                mx = fmaxf(mx, sv);
            }
        mx = fmaxf(mx, __shfl_xor(mx, 16)); mx = fmaxf(mx, __shfl_xor(mx, 32));
        const float m = fmaxf(mx, sink);
        float sum = 0.f;
#pragma unroll
        for (int kt = 0; kt < 10; ++kt)
#pragma unroll
            for (int rr = 0; rr < 4; ++rr) {
                const float pv = (sc[kt][rr] > -1e29f) ? __expf(sc[kt][rr] - m) : 0.f;
                sc[kt][rr] = pv; sum += pv;
            }
        sum += __shfl_xor(sum, 16); sum += __shfl_xor(sum, 32);
        const float inv = 1.0f / (sum + __expf(sink - m));
        bf16x8 pf[5];
#pragma unroll
        for (int k2 = 0; k2 < 5; ++k2) {
            uint4 cu;
            cu.x = pack_bf16(sc[2 * k2][0], sc[2 * k2][1]); cu.y = pack_bf16(sc[2 * k2][2], sc[2 * k2][3]);
            cu.z = pack_bf16(sc[2 * k2 + 1][0], sc[2 * k2 + 1][1]); cu.w = pack_bf16(sc[2 * k2 + 1][2], sc[2 * k2 + 1][3]);
            pf[k2] = __builtin_bit_cast(bf16x8, cu);
        }
#pragma unroll
        for (int dt = 0; dt < 4; ++dt) {
            f32x4 o = {0.f, 0.f, 0.f, 0.f};
#pragma unroll
            for (int k2 = 0; k2 < 5; ++k2) {
                const uint2 va = vv[(dt * 5 + k2) * 2], vb = vv[(dt * 5 + k2) * 2 + 1];
                const bf16x8 vf = __builtin_bit_cast(bf16x8, make_uint4(va.x, va.y, vb.x, vb.y));
                o = __builtin_amdgcn_mfma_f32_16x16x32_bf16(vf, pf[k2], o, 0, 0, 0);
            }
            if (n < nvalid) {
                const int d0 = dt * 16 + 4 * q;
                const float4 g = unpack4(gg[dt]);
                uint2 w;
                w.x = pack_bf16(o[0] * inv * siluf_(g.x), o[1] * inv * siluf_(g.y));
                w.y = pack_bf16(o[2] * inv * siluf_(g.z), o[3] * inv * siluf_(g.w));
                *(uint2*)(p.qb + (size_t)tq * D + 512 + hq * 64 + d0) = w;
            }
        }
    }
}

__device__ __forceinline__ void ph_hg_rec(const Params& p, int j, int first_stream) {
    const int tidx = tid_opaque();
    const int lane = tidx & 63;
    const int wave = (tidx >> 6) * GRID_X + blockIdx.x, nw = GRID_X * 4;
    const int e = lane & 3, dg = lane >> 2;
    const int nitems = (NB + NS) * 8 * 32;
    for (int item = wave + first_stream * 8 * 32; item < nitems; item += nw) {
        const int es = item & 31, h = (item >> 5) & 7, st = item >> 8;
        const int smp = st >= NB, seq = smp ? st - NB : st;
        const int t0 = smp ? TP + seq * LS : seq * SEQ, len = smp ? LS : SEQ;
        const int ec = es * 4 + e;
        float lb[8];
#pragma unroll
        for (int i = 0; i < 8; ++i) {
            const int c = h * 128 + dg * 8 + i;
            if (j == 0) lb[i] = 0.f;
            else {
                const float r0 = p.lb_raw[c], r1 = p.lb_raw[D + c];
                const float mm = fmaxf(r0, r1);
                const float e0 = __expf(r0 - mm), e1 = __expf(r1 - mm);
                lb[i] = e1 / (e0 + e1);
            }
        }
        float S[8];
        if (smp) {
            const float* s0 = p.state_hgrn + (((size_t)j * NS + seq) * 8 + h) * 128 * 128;
#pragma unroll
            for (int i = 0; i < 8; ++i) S[i] = s0[(size_t)(dg * 8 + i) * 128 + ec];
        } else {
#pragma unroll
            for (int i = 0; i < 8; ++i) S[i] = 0.f;
        }
        for (int s = 0; s < len; ++s) {
            const int t = t0 + s;
            const bf16_t* row = p.proj + (size_t)t * ODD_LD;
            const bf16x8 qv = *(const bf16x8*)(row + h * 128 + dg * 8);
            const bf16x8 fv = *(const bf16x8*)(row + 1024 + h * 128 + dg * 8);
            const float v = bf2f(row[2048 + h * 128 + ec]);
            float o = 0.f;
#pragma unroll
            for (int i = 0; i < 8; ++i) {
                const float qq = siluf_(bf2f((bf16_t)qv[i])) * 0.08838834764831845f;
                const float z = bf2f((bf16_t)fv[i]);
                const float f = fmaxf(lb[i] + (1.0f - lb[i]) * sigmoidf_(z), 1e-30f);
                const float k = (1.0f - lb[i]) * sigmoidf_(-z);
                S[i] = f * S[i] + k * v;
                o += qq * S[i];
            }
            for (int off = 4; off < 64; off <<= 1) o += __shfl_xor(o, off);
            if (dg == 0) p.hgo[(size_t)t * D + h * 128 + ec] = o;
        }
        float* so = smp ? p.hg_s + (((size_t)j * NS + seq) * 8 + h) * 128 * 128 : p.hg_p + (((size_t)j * NB + seq) * 8 + h) * 128 * 128;
#pragma unroll
        for (int i = 0; i < 8; ++i) so[(size_t)(dg * 8 + i) * 128 + ec] = S[i];
    }
}


constexpr int REC_Q = 0, REC_KT = 8192, REC_A = 16384, REC_D = 18432, REC_BYTES = 18944, REC_SIZE = 19456, REC_V = 20480, HG_SLOT = 28672;

__device__ __forceinline__ void ph_hg_prep(const Params& p, int j, char* smem) {
    const int tidx = tid_opaque();
    const int lane = tidx & 63, wid = tidx >> 6;
    char* const smem0 = smem;
    const int d = tidx & 127, half = tidx >> 7;
    bf16_t rq[16], rz[16], rv[16];
#define HG_LOAD_RAW(it_) { const int st_ = (it_) >> 7, c_ = (it_) & 127; \
        const bf16_t* row_ = p.proj + (size_t)((st_ >> 3) * SEQ + c_ * 32 + half * 16) * ODD_LD + (st_ & 7) * 128 + d; \
        _Pragma("unroll") for (int ii = 0; ii < 16; ++ii) { rq[ii] = row_[(size_t)ii * ODD_LD]; rz[ii] = row_[(size_t)ii * ODD_LD + 1024]; rv[ii] = row_[(size_t)ii * ODD_LD + 2048]; } }
    if ((int)blockIdx.x < 32 * 128) HG_LOAD_RAW(blockIdx.x);
    for (int item = blockIdx.x; item < 32 * 128; item += GRID_X) {
        const int st = item >> 7, c = item & 127, b = st >> 3, h = st & 7;
        const int ch = h * 128 + d;
        float lb = 0.f;
        if (j != 0) {
            const float r0 = p.lb_raw[ch], r1 = p.lb_raw[D + ch];
            const float mm = fmaxf(r0, r1);
            const float e0 = __expf(r0 - mm), e1 = __expf(r1 - mm);
            lb = e1 / (e0 + e1);
        }
        char* rec = p.hgrec + (size_t)item * REC_SIZE;
        char* vrec = p.hgv + (size_t)item * 8192;
        char* smem = smem0;
        float* sQ = (float*)smem;
        float* sK = sQ + 32 * 132;
        float* sG = sK + 32 * 132;
        bf16_t* sQh = (bf16_t*)(sG + 32 * 132);
        bf16_t* sKh = sQh + 16 * 128;
        float* sA = (float*)(sKh + 16 * 128);
        float* sTot = sA + 32 * 33;
        __syncthreads();
        float qv[16], kv[16], gl_[16];
        unsigned vb[8];
        float gacc = 0.f;
#pragma unroll
        for (int ii = 0; ii < 16; ++ii) {
            const int i = half * 16 + ii;
            const float qraw = bf2f(rq[ii]), z = bf2f(rz[ii]);
            const unsigned vraw = rv[ii];
            if (ii & 1) vb[ii >> 1] |= vraw << 16; else vb[ii >> 1] = vraw;
            const float sg = sigmoidf_(z);
            const float f = fmaxf(lb + (1.0f - lb) * sg, 1e-30f);
            gacc += __logf(f);
            qv[ii] = siluf_(qraw) * 0.08838834764831845f;
            kv[ii] = (1.0f - lb) * (1.0f - sg);
            gl_[ii] = gacc;
            sQ[i * 132 + d] = qv[ii];
            sK[i * 132 + d] = kv[ii];
        }
        if (item + (int)GRID_X < 32 * 128) HG_LOAD_RAW(item + GRID_X);
        sTot[half * 128 + d] = gacc;
#pragma unroll
        for (int ii = 0; ii < 16; ++ii) {
            const int off = ii * 128 + ((((d >> 3) ^ (ii & 7)) << 3) | (d & 7));
            if (half) sQh[off] = f2bf(qv[ii] * __expf(gl_[ii]));
            else sKh[off] = f2bf(kv[ii] * __expf(gacc - gl_[ii]));
        }
        for (int e = tidx; e < 32 * 33; e += 256) sA[e] = 0.f;
        __syncthreads();
        const float tot0 = sTot[d], tot1 = sTot[128 + d];
        const float glv = tot0 + tot1, goff = half ? tot0 : 0.f;
#pragma unroll
        for (int ii = 0; ii < 16; ++ii) { gl_[ii] += goff; sG[(half * 16 + ii) * 132 + d] = gl_[ii] * 1.4426950408889634f; }
#pragma unroll
        for (int g = 0; g < 2; ++g) {
            const int kg = 2 * half + g;
            uint4 w;
            w.x = pack_bf16(kv[g * 8 + 0] * __expf(glv - gl_[g * 8 + 0]), kv[g * 8 + 1] * __expf(glv - gl_[g * 8 + 1]));
            w.y = pack_bf16(kv[g * 8 + 2] * __expf(glv - gl_[g * 8 + 2]), kv[g * 8 + 3] * __expf(glv - gl_[g * 8 + 3]));
            w.z = pack_bf16(kv[g * 8 + 4] * __expf(glv - gl_[g * 8 + 4]), kv[g * 8 + 5] * __expf(glv - gl_[g * 8 + 5]));
            w.w = pack_bf16(kv[g * 8 + 6] * __expf(glv - gl_[g * 8 + 6]), kv[g * 8 + 7] * __expf(glv - gl_[g * 8 + 7]));
            *(uint4*)(rec + REC_KT + (((d >> 4) * 64) + kg * 16 + (d & 15)) * 16) = w;
            uint4 vv; vv.x = vb[g * 4 + 0]; vv.y = vb[g * 4 + 1]; vv.z = vb[g * 4 + 2]; vv.w = vb[g * 4 + 3];
            *(uint4*)(vrec + ((((d >> 5) * 2 + ((d >> 4) & 1)) * 64) + kg * 16 + (d & 15)) * 16) = vv;
        }
        if (half == 0) *(float*)(rec + REC_D + d * 4) = __expf(glv);
        __syncthreads();
#pragma unroll
        for (int u = 0; u < 2; ++u) {
            const int sidx = tidx + 256 * u;
            const int mt = sidx >> 8, kk = (sidx >> 6) & 3, ln = sidx & 63, r = ln & 15, q = ln >> 4;
            const int i = mt * 16 + r, dA = kk * 32 + 4 * q, dB = dA + 16;
            const float4 qa = *(const float4*)(sQ + i * 132 + dA), ga = *(const float4*)(sG + i * 132 + dA);
            const float4 qb_ = *(const float4*)(sQ + i * 132 + dB), gb_ = *(const float4*)(sG + i * 132 + dB);
            uint4 w;
            w.x = pack_bf16(qa.x * __builtin_amdgcn_exp2f(ga.x), qa.y * __builtin_amdgcn_exp2f(ga.y));
            w.y = pack_bf16(qa.z * __builtin_amdgcn_exp2f(ga.z), qa.w * __builtin_amdgcn_exp2f(ga.w));
            w.z = pack_bf16(qb_.x * __builtin_amdgcn_exp2f(gb_.x), qb_.y * __builtin_amdgcn_exp2f(gb_.y));
            w.w = pack_bf16(qb_.z * __builtin_amdgcn_exp2f(gb_.z), qb_.w * __builtin_amdgcn_exp2f(gb_.w));
            *(uint4*)(rec + REC_Q + sidx * 16) = w;
        }
        if (wid == 0) {
            f32x4 acc = {0.f, 0.f, 0.f, 0.f};
            const int r = lane & 15, kg = lane >> 4;
#pragma unroll
            for (int kk = 0; kk < 4; ++kk) {
                const int chn = kk * 4 + kg;
                const bf16x8 a = *(const bf16x8*)(sQh + r * 128 + ((chn ^ (r & 7)) << 3));
                const bf16x8 bb = *(const bf16x8*)(sKh + r * 128 + ((chn ^ (r & 7)) << 3));
                acc = __builtin_amdgcn_mfma_f32_16x16x32_bf16(a, bb, acc, 0, 0, 0);
            }
#pragma unroll
            for (int rr = 0; rr < 4; ++rr) sA[(16 + 4 * kg + rr) * 33 + r] = acc[rr];
        }
        {
            const int sl = tidx & 7;
#pragma unroll 1
            for (int pidx = tidx >> 3; pidx < 272; pidx += 32) {
                const int blk2 = pidx >= 136, tt = pidx - (blk2 ? 136 : 0);
                int r = (int)((__builtin_sqrtf(8.0f * tt + 1.0f) - 1.0f) * 0.5f);
                if ((r + 1) * (r + 2) / 2 <= tt) ++r;
                if (r * (r + 1) / 2 > tt) --r;
                const int cidx = tt - r * (r + 1) / 2;
                const int i = blk2 * 16 + r, jr = blk2 * 16 + cidx;
                float sum = 0.f;
#pragma unroll
                for (int u = 0; u < 4; ++u) {
                    const float4 qa = *(const float4*)(sQ + i * 132 + sl * 16 + u * 4), gi = *(const float4*)(sG + i * 132 + sl * 16 + u * 4);
                    const float4 kq = *(const float4*)(sK + jr * 132 + sl * 16 + u * 4), g = *(const float4*)(sG + jr * 132 + sl * 16 + u * 4);
                    sum += qa.x * kq.x * __builtin_amdgcn_exp2f(gi.x - g.x);
                    sum += qa.y * kq.y * __builtin_amdgcn_exp2f(gi.y - g.y);
                    sum += qa.z * kq.z * __builtin_amdgcn_exp2f(gi.z - g.z);
                    sum += qa.w * kq.w * __builtin_amdgcn_exp2f(gi.w - g.w);
                }
                sum += __shfl_xor(sum, 1); sum += __shfl_xor(sum, 2); sum += __shfl_xor(sum, 4);
                if (sl == 0) sA[i * 33 + jr] = sum;
            }
        }
        __syncthreads();
        if (tidx < 128) {
            const int mt = tidx >> 6, ln = tidx & 63, r = ln & 15, kg = ln >> 4;
            const float* ap = sA + (mt * 16 + r) * 33 + kg * 8;
            uint4 w;
            w.x = pack_bf16(ap[0], ap[1]); w.y = pack_bf16(ap[2], ap[3]); w.z = pack_bf16(ap[4], ap[5]); w.w = pack_bf16(ap[6], ap[7]);
            *(uint4*)(rec + REC_A + tidx * 16) = w;
        }
    }
}

__device__ __forceinline__ void ph_hg_scan(const Params& p, int j, char* smem, int item0) {
    const int tidx = tid_opaque();
    const int lane = tidx & 63, wid = tidx >> 6, n = lane & 15, q = lane >> 4;
    const unsigned lbase = __builtin_amdgcn_readfirstlane(lds_base_addr() + wid * 1024);
    for (int item = item0; item < 64; item += GRID_X) {
        const int st = item >> 1, et = (item & 1) * 4 + wid;
        const int b = st >> 3, h = st & 7;
        f32x4 acc[8];
#pragma unroll
        for (int mt = 0; mt < 8; ++mt) acc[mt] = (f32x4){0.f, 0.f, 0.f, 0.f};
        const char* rec = p.hgrec + (size_t)st * 128 * REC_SIZE + tidx * 16;
        const char* vrec = p.hgv + (size_t)st * 128 * 8192 + tidx * 16;
        __syncthreads();
#pragma unroll
        for (int k = 0; k < 5; ++k) glds16_asm(rec + k * 4096, lbase + k * 4096);
#pragma unroll
        for (int k = 0; k < 2; ++k) glds16_asm(vrec + k * 4096, lbase + REC_V + k * 4096);
        asm volatile("s_waitcnt vmcnt(0)" ::: "memory");
        __syncthreads();
        f32x4 po[2];
        po[0] = (f32x4){0.f, 0.f, 0.f, 0.f}; po[1] = (f32x4){0.f, 0.f, 0.f, 0.f};
#pragma unroll 1
        for (int c = 0; c <= 128; ++c) {
            if (c > 0) {
                const int tc = b * SEQ + (c - 1) * 32;
#pragma unroll
                for (int mt = 0; mt < 2; ++mt)
#pragma unroll
                    for (int rr = 0; rr < 4; ++rr) p.hgo[(size_t)(tc + mt * 16 + 4 * q + rr) * D + h * 128 + et * 16 + n] = po[mt][rr];
            }
            if (c == 128) break;
            MEMFENCE();
            if (c + 1 < 128) {
                const unsigned dst = lbase + ((c + 1) & 1) * HG_SLOT;
#pragma unroll
                for (int k = 0; k < 5; ++k) glds16_asm(rec + (size_t)(c + 1) * REC_SIZE + k * 4096, dst + k * 4096);
#pragma unroll
                for (int k = 0; k < 2; ++k) glds16_asm(vrec + (size_t)(c + 1) * 8192 + k * 4096, dst + REC_V + k * 4096);
            }
            const char* slot = smem + (c & 1) * HG_SLOT;
            const bf16x8 vf = *(const bf16x8*)(slot + REC_V + et * 1024 + lane * 16);
            bf16x8 sB[4];
#pragma unroll
            for (int kk = 0; kk < 4; ++kk) {
                const f32x4 lo = acc[2 * kk], hi = acc[2 * kk + 1];
                uint4 cu;
                cu.x = pack_bf16(lo[0], lo[1]); cu.y = pack_bf16(lo[2], lo[3]); cu.z = pack_bf16(hi[0], hi[1]); cu.w = pack_bf16(hi[2], hi[3]);
                sB[kk] = __builtin_bit_cast(bf16x8, cu);
            }
#pragma unroll
            for (int mt = 0; mt < 2; ++mt) {
                const bf16x8 af = *(const bf16x8*)(slot + REC_A + (mt * 64 + lane) * 16);
                f32x4 o0 = {0.f, 0.f, 0.f, 0.f};
#pragma unroll
                for (int kk = 0; kk < 4; ++kk) {
                    const bf16x8 qf = *(const bf16x8*)(slot + REC_Q + ((mt * 4 + kk) * 64 + lane) * 16);
                    o0 = __builtin_amdgcn_mfma_f32_16x16x32_bf16(qf, sB[kk], o0, 0, 0, 0);
                }
                po[mt] = __builtin_amdgcn_mfma_f32_16x16x32_bf16(af, vf, o0, 0, 0, 0);
            }
#pragma unroll
            for (int mt = 0; mt < 8; ++mt) {
                const float4 dv = *(const float4*)(slot + REC_D + (mt * 16 + 4 * q) * 4);
                const bf16x8 kt = *(const bf16x8*)(slot + REC_KT + (mt * 64 + lane) * 16);
                f32x4 c0 = acc[mt];
                c0[0] *= dv.x; c0[1] *= dv.y; c0[2] *= dv.z; c0[3] *= dv.w;
                acc[mt] = __builtin_amdgcn_mfma_f32_16x16x32_bf16(kt, vf, c0, 0, 0, 0);
            }
            asm volatile("s_waitcnt vmcnt(0) lgkmcnt(0)" ::: "memory");
            __builtin_amdgcn_s_barrier();
            MEMFENCE();
        }
        float* so = p.hg_p + (((size_t)j * NB + b) * 8 + h) * 128 * 128;
#pragma unroll
        for (int mt = 0; mt < 8; ++mt)
#pragma unroll
            for (int rr = 0; rr < 4; ++rr) so[(size_t)(mt * 16 + 4 * q + rr) * 128 + et * 16 + n] = acc[mt][rr];
    }
}


__device__ __forceinline__ void ph_hg_rec2(const Params& p, int j, char* smem, int bid, int nblk) {
    const int tidx = tid_opaque();
    const int lane = tidx & 63, wid = tidx >> 6;
    float* sb = (float*)(smem + wid * 2048);
    const int wave = wid * nblk + bid, nw = nblk * 4;
    __syncthreads();
    for (int item = wave; item < NS * 8 * 2; item += nw) {
        const int hf = item & 1, h = (item >> 1) & 7, nn = item >> 4;
        const int e = hf * 64 + lane;
        float lb0 = 0.f, lb1 = 0.f;
        if (j != 0) {
            const int c0 = h * 128 + lane, c1 = c0 + 64;
            { const float r0 = p.lb_raw[c0], r1 = p.lb_raw[D + c0], mm = fmaxf(r0, r1), e0 = __expf(r0 - mm), e1 = __expf(r1 - mm); lb0 = e1 / (e0 + e1); }
            { const float r0 = p.lb_raw[c1], r1 = p.lb_raw[D + c1], mm = fmaxf(r0, r1), e0 = __expf(r0 - mm), e1 = __expf(r1 - mm); lb1 = e1 / (e0 + e1); }
        }
        const float* s0 = p.state_hgrn + (((size_t)j * NS + nn) * 8 + h) * 128 * 128 + e;
        float S[128];
#pragma unroll
        for (int d = 0; d < 128; ++d) S[d] = s0[(size_t)d * 128];
        for (int st = 0; st < LS; ++st) {
            const int t = TP + nn * LS + st;
            const bf16_t* row = p.proj + (size_t)t * ODD_LD + h * 128;
            {
                const float q0 = bf2f(row[lane]), q1 = bf2f(row[lane + 64]);
                const float z0 = bf2f(row[1024 + lane]), z1 = bf2f(row[1024 + lane + 64]);
                const float g0 = sigmoidf_(z0), g1 = sigmoidf_(z1);
                sb[lane] = siluf_(q0) * 0.08838834764831845f; sb[lane + 64] = siluf_(q1) * 0.08838834764831845f;
                sb[128 + lane] = fmaxf(lb0 + (1.0f - lb0) * g0, 1e-30f); sb[128 + lane + 64] = fmaxf(lb1 + (1.0f - lb1) * g1, 1e-30f);
                sb[256 + lane] = (1.0f - lb0) * (1.0f - g0); sb[256 + lane + 64] = (1.0f - lb1) * (1.0f - g1);
            }
            const float v = bf2f(row[2048 + e]);
            float o = 0.f;
#pragma unroll
            for (int d4 = 0; d4 < 32; ++d4) {
                const float4 qv = *(const float4*)(sb + d4 * 4), fv = *(const float4*)(sb + 128 + d4 * 4), kv = *(const float4*)(sb + 256 + d4 * 4);
                S[d4 * 4] = fv.x * S[d4 * 4] + kv.x * v; o += qv.x * S[d4 * 4];
                S[d4 * 4 + 1] = fv.y * S[d4 * 4 + 1] + kv.y * v; o += qv.y * S[d4 * 4 + 1];
                S[d4 * 4 + 2] = fv.z * S[d4 * 4 + 2] + kv.z * v; o += qv.z * S[d4 * 4 + 2];
                S[d4 * 4 + 3] = fv.w * S[d4 * 4 + 3] + kv.w * v; o += qv.w * S[d4 * 4 + 3];
                if ((d4 & 3) == 3) asm volatile("" : "+v"(o) :: "memory");
            }
            p.hgo[(size_t)t * D + h * 128 + e] = o;
        }
        float* so = p.hg_s + (((size_t)j * NS + nn) * 8 + h) * 128 * 128 + e;
#pragma unroll
        for (int d = 0; d < 128; ++d) so[(size_t)d * 128] = S[d];
    }
}

__device__ __forceinline__ void ph_dn_rec2(const Params& p, int j, char* smem, int bid, int nblk) {
    const int tidx = tid_opaque();
    const int lane = tidx & 63, wid = tidx >> 6;
    float* sb = (float*)(smem + wid * 2048);
    const int wave = wid * nblk + bid, nw = nblk * 4;
    for (int item = wave; item < NS * 4 * 2; item += nw) {
        const int hf = item & 1, h = (item >> 1) & 3, nn = item >> 3;
        const int e = hf * 64 + lane;
        const float* s0 = p.state_delta + (((size_t)j * NS + nn) * 4 + h) * 128 * 128 + e;
        float S[128];
#pragma unroll
        for (int d = 0; d < 128; ++d) S[d] = s0[(size_t)d * 128];
        for (int st = 0; st < LS; ++st) {
            const int ts = nn * LS + st;
            const bf16_t* row = p.dnqkv + (size_t)ts * CONV_CH + h * 128;
            const float q0 = bf2f(row[lane]), q1 = bf2f(row[lane + 64]), k0 = bf2f(row[512 + lane]), k1 = bf2f(row[512 + lane + 64]);
            sb[lane] = q0; sb[lane + 64] = q1; sb[128 + lane] = k0; sb[128 + lane + 64] = k1;
            float qk = q0 * k0 + q1 * k1;
            for (int off = 32; off > 0; off >>= 1) qk += __shfl_xor(qk, off);
            const float v = bf2f(row[1024 + e]);
            const float g = p.dngb[(size_t)ts * 8 + h], beta = p.dngb[(size_t)ts * 8 + 4 + h];
            float kS = 0.f, qS = 0.f;
#pragma unroll
            for (int d4 = 0; d4 < 32; ++d4) {
                const float4 qv = *(const float4*)(sb + d4 * 4), kv = *(const float4*)(sb + 128 + d4 * 4);
                kS += kv.x * S[d4 * 4] + kv.y * S[d4 * 4 + 1] + kv.z * S[d4 * 4 + 2] + kv.w * S[d4 * 4 + 3];
                qS += qv.x * S[d4 * 4] + qv.y * S[d4 * 4 + 1] + qv.z * S[d4 * 4 + 2] + qv.w * S[d4 * 4 + 3];
                if ((d4 & 3) == 3) asm volatile("" : "+v"(kS), "+v"(qS) :: "memory");
            }
            const float a = __expf(g);
            const float vn = beta * (v - a * kS);
            p.dno[(size_t)ts * 512 + h * 128 + e] = 0.08838834764831845f * (a * qS + qk * vn);
#pragma unroll
            for (int d4 = 0; d4 < 32; ++d4) {
                const float4 kv = *(const float4*)(sb + 128 + d4 * 4);
                S[d4 * 4] = a * S[d4 * 4] + kv.x * vn; S[d4 * 4 + 1] = a * S[d4 * 4 + 1] + kv.y * vn;
                S[d4 * 4 + 2] = a * S[d4 * 4 + 2] + kv.z * vn; S[d4 * 4 + 3] = a * S[d4 * 4 + 3] + kv.w * vn;
                if ((d4 & 3) == 3) asm volatile("" : "+v"(S[d4 * 4 + 3]) :: "memory");
            }
        }
        float* so = p.delta_s + (((size_t)j * NS + nn) * 4 + h) * 128 * 128 + e;
#pragma unroll
        for (int d = 0; d < 128; ++d) so[(size_t)d * 128] = S[d];
    }
}

__device__ __forceinline__ void ph_hg_post(const Params& p, int j) {
    const int tidx = tid_opaque();
    const int lane = tidx & 63, grp = lane >> 4, l16 = lane & 15;
    const int wave = blockIdx.x * 4 + (tidx >> 6), nw = GRID_X * 4;
    const float4 nc0 = *(const float4*)(p.norm_c + j * 128 + l16 * 8), nc1 = *(const float4*)(p.norm_c + j * 128 + l16 * 8 + 4);
    for (int it2 = wave; it2 < T; it2 += nw) {
        const int itA = 2 * it2, itB = itA + 1;
        const int itemA = itA * 4 + grp, tA = itemA >> 3, hA = itemA & 7;
        const int itemB = itB * 4 + grp, tB = itemB >> 3, hB = itemB & 7;
        const float* opA = p.hgo + (size_t)tA * D + hA * 128 + l16 * 8;
        const float* opB = p.hgo + (size_t)tB * D + hB * 128 + l16 * 8;
        const float4 xa0 = *(const float4*)opA, xa1 = *(const float4*)(opA + 4);
        const float4 ya0 = *(const float4*)opB, ya1 = *(const float4*)(opB + 4);
        const uint4 xg = *(const uint4*)(p.proj + (size_t)tA * ODD_LD + 3072 + hA * 128 + l16 * 8);
        const uint4 yg = *(const uint4*)(p.proj + (size_t)tB * ODD_LD + 3072 + hB * 128 + l16 * 8);
        __builtin_amdgcn_sched_barrier(0);
#define HGP_FIN(A0, A1, GV, TT, HH) { float ss = A0.x * A0.x + A0.y * A0.y + A0.z * A0.z + A0.w * A0.w + A1.x * A1.x + A1.y * A1.y + A1.z * A1.z + A1.w * A1.w; \
        ss += __shfl_xor(ss, 1); ss += __shfl_xor(ss, 2); ss += __shfl_xor(ss, 4); ss += __shfl_xor(ss, 8); \
        const float r = rsqrtf(ss * (1.0f / 128.0f) + EPS); \
        const float4 g0 = unpack4(make_uint2(GV.x, GV.y)), g1 = unpack4(make_uint2(GV.z, GV.w)); \
        uint4 o; \
        o.x = pack_bf16(A0.x * r * nc0.x * siluf_(g0.x), A0.y * r * nc0.y * siluf_(g0.y)); \
        o.y = pack_bf16(A0.z * r * nc0.z * siluf_(g0.z), A0.w * r * nc0.w * siluf_(g0.w)); \
        o.z = pack_bf16(A1.x * r * nc1.x * siluf_(g1.x), A1.y * r * nc1.y * siluf_(g1.y)); \
        o.w = pack_bf16(A1.z * r * nc1.z * siluf_(g1.z), A1.w * r * nc1.w * siluf_(g1.w)); \
        *(uint4*)(p.qb + (size_t)TT * D + HH * 128 + l16 * 8) = o; }
        HGP_FIN(xa0, xa1, xg, tA, hA) HGP_FIN(ya0, ya1, yg, tB, hB)
#undef HGP_FIN
    }
}

#define XB_TMO      128
#define XB_XCNT(j)  (256  + 64 * (j))
#define XB_XSUB(j)  (1280 + 64 * (j))
#define XB_XGEN(j)  (2304 + 64 * (j))
#define XB_TOP      3328
#define XB_TOPGEN   3392
#define XB_CUCNT    3456
#define XB_CUIDX    7552
#define XB_NA       11648
#define XB_BAD      11649
#define XCD_BAR_WORDS 11712
#define XB_SPIN_CAP (1u << 20)
__device__ __forceinline__ unsigned xb_ld(unsigned* p)              { return __hip_atomic_load(p, __ATOMIC_RELAXED, __HIP_MEMORY_SCOPE_AGENT); }
__device__ __forceinline__ unsigned xb_add(unsigned* p, unsigned v) { return __hip_atomic_fetch_add(p, v, __ATOMIC_RELAXED, __HIP_MEMORY_SCOPE_AGENT); }
__device__ __forceinline__ unsigned xb_xcc_id() { return (unsigned)__builtin_amdgcn_s_getreg((3 << 11) | 20) & 0xFu; }
#define XB_SPIN(cond, bar) do { unsigned _sp = 0; while (cond) { __builtin_amdgcn_s_sleep(1); \
    if ((++_sp & 255u) == 0u) { if (xb_ld(&(bar)[XB_TMO])) break; if (_sp > XB_SPIN_CAP) { atomicAdd(&(bar)[XB_TMO], 1u); break; } } } } while (0)
__device__ __forceinline__ unsigned xb_cu_key() { return (unsigned)__builtin_amdgcn_s_getreg((7 << 11) | (8 << 6) | 4) & 0xFFu; }
struct XcdBarrier { unsigned* bar; unsigned x, nloc, nx, rank, even, cukey; int dn_item, dn_bid, hg_item, hg_bid, hg_nbk; };

__device__ __forceinline__ XcdBarrier xcd_setup(unsigned* bar, char* smem) {
    XcdBarrier b; b.bar = bar; b.x = xb_xcc_id();
    volatile unsigned* st = (volatile unsigned*)smem;
    if (threadIdx.x == 0) {
        {
            const unsigned key = b.x * 256u + xb_cu_key();
            const unsigned r = xb_add(&bar[XB_CUCNT + key], 1u);
            if (r == 0u) { const unsigned ia = xb_add(&bar[XB_NA], 1u); xb_add(&bar[XB_CUIDX + key], ia + 1u); }
            else if (r >= 2u) xb_add(&bar[XB_BAD], 1u);
            st[4] = key; st[5] = r;
        }
        st[2] = xb_add(&bar[XB_XCNT(b.x)], 1u);
        const unsigned G = GRID_X;
        unsigned sum, cnt, mine, sp = 0u;
        for (;;) {
            sum = 0u; cnt = 0u; mine = 0u;
#pragma unroll
            for (unsigned jx = 0; jx < 16; ++jx) { const unsigned c = xb_ld(&bar[XB_XCNT(jx)]); sum += c; cnt += (c > 0u) ? 1u : 0u; mine = (jx == b.x) ? c : mine; }
            if (sum == G) break;
            __builtin_amdgcn_s_sleep(1);
            if ((++sp & 255u) == 0u) { if (xb_ld(&bar[XB_TMO])) break; if (sp > XB_SPIN_CAP) { atomicAdd(&bar[XB_TMO], 1u); break; } }
        }
        st[0] = mine > 0u ? mine : 1u; st[1] = cnt > 0u ? cnt : 1u;
        unsigned ev = (sum == G && cnt == 8u) ? 1u : 0u;
#pragma unroll
        for (unsigned jx = 0; jx < 16; ++jx) { const unsigned c = xb_ld(&bar[XB_XCNT(jx)]); if (c != 0u && c * 8u != G) ev = 0u; }
        st[3] = ev;
    }
    __syncthreads();
    b.nloc = __builtin_amdgcn_readfirstlane(st[0]); b.nx = __builtin_amdgcn_readfirstlane(st[1]); b.rank = __builtin_amdgcn_readfirstlane(st[2]); b.even = __builtin_amdgcn_readfirstlane(st[3]);
    b.cukey = __builtin_amdgcn_readfirstlane(st[4]) | (__builtin_amdgcn_readfirstlane(st[5]) << 16);
    b.dn_item = b.dn_bid = b.hg_item = b.hg_bid = b.hg_nbk = 0;
    __syncthreads();
    return b;
}

__device__ __forceinline__ void xcd_barrier(const XcdBarrier& b) {
    asm volatile("s_waitcnt vmcnt(0)" ::: "memory");
    __syncthreads();
    if (threadIdx.x == 0) {
        unsigned* bar = b.bar;
        __builtin_amdgcn_s_waitcnt(0);
        const unsigned nloc = b.nloc, nx = b.nx;
        const unsigned old = xb_add(&bar[XB_XSUB(b.x)], 1u);
        const unsigned gen = old / nloc;
        if (old + 1u == (gen + 1u) * nloc) {
            __builtin_amdgcn_fence(__ATOMIC_RELEASE, "agent");
            asm volatile("s_waitcnt vmcnt(0)" ::: "memory");
            const unsigned og = xb_add(&bar[XB_TOP], 1u);
            const unsigned tg = og / nx;
            if (og + 1u == (tg + 1u) * nx) xb_add(&bar[XB_TOPGEN], 1u);
            else XB_SPIN(xb_ld(&bar[XB_TOPGEN]) == tg, bar);
            __builtin_amdgcn_fence(__ATOMIC_ACQUIRE, "agent");
            xb_add(&bar[XB_XGEN(b.x)], 1u);
            asm volatile("s_waitcnt vmcnt(0)" ::: "memory");
        } else {
            XB_SPIN(xb_ld(&bar[XB_XGEN(b.x)]) == gen, bar);
            __builtin_amdgcn_fence(__ATOMIC_ACQUIRE, "agent");
            asm volatile("s_waitcnt vmcnt(0)" ::: "memory");
        }
    }
    __syncthreads();
}

__device__ __forceinline__ void xcd_roles(XcdBarrier& b, char* smem) {
    volatile unsigned* st = (volatile unsigned*)smem;
    const unsigned key = b.cukey & 0xFFFFu, r = b.cukey >> 16;
    if (threadIdx.x == 0) { st[0] = xb_ld(&b.bar[XB_CUIDX + key]); st[1] = xb_ld(&b.bar[XB_NA]); st[2] = xb_ld(&b.bar[XB_BAD]); }
    __syncthreads();
    const int ia = (int)__builtin_amdgcn_readfirstlane(st[0]) - 1, nA = (int)__builtin_amdgcn_readfirstlane(st[1]), bad = (int)__builtin_amdgcn_readfirstlane(st[2]);
    __syncthreads();
    const int G = GRID_X;
    const bool paired = (bad == 0) && (nA * 2 == G) && (nA >= 64) && (ia >= 0) && (r < 2u);
    if (paired) {
        b.dn_item = (r == 0u && ia < 32) ? ia : -1; b.dn_bid = (r != 0u) ? ia : nA + (ia - 32);
        b.hg_item = (r == 0u && ia < 64) ? ia : -1; b.hg_bid = (ia < 64) ? -1 : ((r == 0u) ? ia - 64 : (nA - 64) + (ia - 64));
        b.hg_nbk = G - 128;
    } else {
        b.dn_item = ((int)blockIdx.x < 32) ? (int)blockIdx.x : -1; b.dn_bid = (int)blockIdx.x - 32;
        b.hg_item = ((int)blockIdx.x < 64) ? (int)blockIdx.x : -1; b.hg_bid = (int)blockIdx.x - 64; b.hg_nbk = G - 64;
    }
    b.dn_item = __builtin_amdgcn_readfirstlane(b.dn_item); b.dn_bid = __builtin_amdgcn_readfirstlane(b.dn_bid);
    b.hg_item = __builtin_amdgcn_readfirstlane(b.hg_item); b.hg_bid = __builtin_amdgcn_readfirstlane(b.hg_bid); b.hg_nbk = __builtin_amdgcn_readfirstlane(b.hg_nbk);
}

template <int LAYER>
__device__ __forceinline__ void run_layer(const Params& p, const XcdBarrier& xb, const TileCtx& tc, char* smem) {
    constexpr int layer = LAYER;
    constexpr int j = LAYER >> 1;
        if constexpr ((LAYER & 1) == 0) {
            ph_gemm_in192<0>(p, p.xb, p.wt_in_even + (size_t)j * EVEN_LD * D, EVEN_LD, D, layer, smem);
            ph_conv_p(p, layer);
            xcd_barrier(xb);
            ph_dn_prep(p, j, smem);
            ph_dn_pre(p, j);
            ph_swa_pre(p, j);
            ph_swa_prep2(p, j, smem);
            xcd_barrier(xb);
            if (xb.dn_item >= 0) ph_dn_scan(p, j, smem, xb.dn_item);
            else { const int bid = __builtin_amdgcn_readfirstlane(xb.dn_bid), nbk = __builtin_amdgcn_readfirstlane((int)GRID_X - 32); ph_dn_rec2(p, j, smem, bid, nbk); ph_swa_attn2(p, j, bid, nbk);
                   TileCtx ts; ts.x = -1; ts.lb = bid; ts.nlb = nbk;
                   ph_gemm<3>(p, ts, p.pb, p.wt_proj + (size_t)layer * D * PLE, D, PLE, layer, smem);
                   if (LAYER == 0) ph_weights(p, 1, smem, bid, nbk); }
            xcd_barrier(xb);
            ph_dn_out(p, j);
            ph_dn_post(p, j);
            xcd_barrier(xb);
            ph_gemm_n1024<2>(p, tc, p.qb, p.wt_out_even + (size_t)j * D * D, D, layer, smem);
        } else {
            ph_gemm_in192<1>(p, p.xb, p.wt_in_odd + (size_t)j * ODD_LD * D, ODD_LD, D, layer, smem);
            ph_conv_p(p, layer);
            xcd_barrier(xb);
            ph_hg_prep(p, j, smem);
            xcd_barrier(xb);
            if (xb.hg_item >= 0) ph_hg_scan(p, j, smem, xb.hg_item);
            else if (xb.hg_bid >= 0) {
                const int bid = __builtin_amdgcn_readfirstlane(xb.hg_bid), nbk = __builtin_amdgcn_readfirstlane(xb.hg_nbk);
                TileCtx ts; ts.x = -1; ts.lb = bid; ts.nlb = nbk;
                ph_hg_rec2(p, j, smem, bid, nbk);
                ph_gemm<3>(p, ts, p.pb, p.wt_proj + (size_t)layer * D * PLE, D, PLE, layer, smem);
                if (LAYER == 1) { ph_weights(p, 2, smem, bid, nbk); ph_weights(p, 3, smem, bid, nbk); }
            }
            xcd_barrier(xb);
            ph_hg_post(p, j);
            xcd_barrier(xb);
            ph_gemm_n1024<2>(p, tc, p.qb, p.wt_out_odd + (size_t)j * D * D, D, layer, smem);
        }
        xcd_barrier(xb);
        ph_layernorm(p, layer, smem);
        xcd_barrier(xb);
        ph_gemm_n1024<4>(p, tc, p.qb, p.wt_gate + (size_t)layer * D * D, D, layer, smem);
        if (layer < 3) xcd_barrier(xb);
}

__global__ void __launch_bounds__(256, 2) mega(Params p) {
    char* smem = g_smem;
    XcdBarrier xb = xcd_setup(p.bar, smem);
    ph_weights(p, 0, smem, blockIdx.x, GRID_X);
    ph_prep_act(p);
    xcd_barrier(xb);
    xcd_roles(xb, smem);
    TileCtx tc;
    if (xb.even) { tc.x = (int)xb.x; tc.lb = (int)xb.rank; tc.nlb = (int)xb.nloc; }
    else { tc.x = blockIdx.x & 7; tc.lb = blockIdx.x >> 3; tc.nlb = GRID_X >> 3; }
    run_layer<0>(p, xb, tc, smem);
    run_layer<1>(p, xb, tc, smem);
    run_layer<2>(p, xb, tc, smem);
    run_layer<3>(p, xb, tc, smem);
}

static inline size_t align_up(size_t x) { return (x + 255) & ~(size_t)255; }

extern "C" void kernel_launch(void* const* d_in, const int* in_sizes, int n_in, void* d_out, int out_size, void* d_ws, size_t ws_size, hipStream_t stream) {
    Params p{};
    p.x_prompt = (const float*)d_in[0]; p.x_sample = (const float*)d_in[1]; p.state_conv = (const float*)d_in[2]; p.state_delta = (const float*)d_in[3];
    p.cache_k = (const float*)d_in[4]; p.cache_v = (const float*)d_in[5]; p.state_hgrn = (const float*)d_in[6]; p.p_prompt = (const float*)d_in[7]; p.p_sample = (const float*)d_in[8];
    p.w_in_even = (const float*)d_in[9]; p.conv_w = (const float*)d_in[10]; p.a_log = (const float*)d_in[11]; p.dt_bias = (const float*)d_in[12]; p.norm_a = (const float*)d_in[13];
    p.sinks = (const float*)d_in[14]; p.w_out_even = (const float*)d_in[15]; p.w_in_odd = (const float*)d_in[16]; p.lb_raw = (const float*)d_in[17]; p.norm_c = (const float*)d_in[18];
    p.w_out_odd = (const float*)d_in[19]; p.ln_g = (const float*)d_in[20]; p.ln_b = (const float*)d_in[21]; p.w_ple_proj = (const float*)d_in[22]; p.w_ple_gate = (const float*)d_in[23];
    float* o = (float*)d_out;
    p.y_prompt = o; o += (size_t)TP * D;
    p.y_sample = o; o += (size_t)TS * D;
    p.conv_p = o; o += (size_t)2 * NB * 3 * CONV_CH;
    p.conv_s = o; o += (size_t)2 * NS * 3 * CONV_CH;
    p.delta_p = o; o += (size_t)2 * NB * 4 * 128 * 128;
    p.delta_s = o; o += (size_t)2 * NS * 4 * 128 * 128;
    p.wk_p = o; o += (size_t)2 * NB * 128 * 128;
    p.wk_s = o; o += (size_t)2 * NS * 128 * 128;
    p.wv_p = o; o += (size_t)2 * NB * 128 * 128;
    p.wv_s = o; o += (size_t)2 * NS * 128 * 128;
    p.hg_p = o; o += (size_t)2 * NB * 8 * 128 * 128;
    p.hg_s = o; o += (size_t)2 * NS * 8 * 128 * 128;

    char* w = (char*)d_ws; size_t off = 0;
    auto carve = [&](size_t bytes) { char* r = w + off; off += align_up(bytes); return r; };
    p.wt_in_even = (bf16_t*)carve((size_t)2 * EVEN_LD * D * 2);
    p.wt_out_even = (bf16_t*)carve((size_t)2 * D * D * 2);
    p.wt_in_odd = (bf16_t*)carve((size_t)2 * ODD_LD * D * 2);
    p.wt_out_odd = (bf16_t*)carve((size_t)2 * D * D * 2);
    p.wt_gate = (bf16_t*)carve((size_t)4 * D * D * 2);
    p.wt_proj = (bf16_t*)carve((size_t)4 * D * PLE * 2);
    p.p2 = (bf16_t*)carve((size_t)T * D * 2);
    p.xb = (bf16_t*)carve((size_t)T * D * 2);
    p.qb = (bf16_t*)carve((size_t)T * D * 2);
    p.pb = (bf16_t*)carve((size_t)T * PLE * 2);
    p.proj = (bf16_t*)carve((size_t)T * ODD_LD * 2);
    p.aux = (float*)carve((size_t)T * 8 * 4);
    p.rope = (float*)carve((size_t)(SEQ + LS) * 16 * 4);
    p.bar = (unsigned*)carve((size_t)XCD_BAR_WORDS * 4);
    char* scr = w + off;
    {
        size_t o2 = 0;
        auto c2 = [&](size_t bytes) { char* r = scr + o2; o2 += align_up(bytes); return r; };
        p.dnqkv = (bf16_t*)c2((size_t)TS * CONV_CH * 2);
        p.dngb = (float*)c2((size_t)TS * 8 * 4);
        p.dno = (float*)c2((size_t)TS * 512 * 4);
        p.qr = (bf16_t*)c2((size_t)T * 512 * 2);
        p.dnrec = c2((size_t)16 * 64 * DR_SIZE);
        p.dnsp = c2((size_t)16 * 64 * 32768);
        p.dngl = (float*)c2((size_t)16 * 64 * 4);
        p.krb = (bf16_t*)c2((size_t)TP * 128 * 2);
        p.vT = (bf16_t*)c2((size_t)NB * 128 * SEQ * 2);
        p.kcat = (bf16_t*)c2((size_t)NS * 2 * 144 * 64 * 2);
        p.vTcat = (bf16_t*)c2((size_t)NS * 128 * 160 * 2);
    }
    p.hgo = (float*)scr;
    p.hgrec = scr + align_up((size_t)T * D * 4);
    p.hgv = p.hgrec + (size_t)32 * 128 * REC_SIZE;

    static int grid_blocks = 0;
    if (!grid_blocks) {
        int dev = 0, cus = 0, per_cu = 0;
        hipGetDevice(&dev);
        hipDeviceGetAttribute(&cus, hipDeviceAttributeMultiprocessorCount, dev);
        hipOccupancyMaxActiveBlocksPerMultiprocessor(&per_cu, mega, 256, 0);
        if (per_cu > 2) per_cu = 2;
        grid_blocks = cus * per_cu;
    }
    hipMemsetAsync(p.bar, 0, (size_t)XCD_BAR_WORDS * 4, stream);
    void* args[] = {&p};
    hipError_t e = hipLaunchCooperativeKernel((void*)mega, dim3(grid_blocks), dim3(256), args, 0, stream);
    if (e != hipSuccess) fprintf(stderr, "cooperative launch failed: %s (grid %d)\n", hipGetErrorString(e), grid_blocks);
}
```
